# Optimizing an MI355X kernel written in HIP

```python
import math
import jax
import jax.numpy as jnp
from jax import lax
import numpy as np

D_MODEL = 1024
BATCH = 2
SEQ = 8192
DEPTH = 2

GRID_W = 64
CTX_LEN = 256
HEAD_DIM = 64
D_MIX = D_MODEL
A_HEADS = D_MIX // (2 * HEAD_DIM)
A_DIM = A_HEADS * HEAD_DIM
B_Q_HEADS = D_MIX // (2 * HEAD_DIM)
B_KV_HEADS = max(1, B_Q_HEADS // 4)
B_Q_DIM = B_Q_HEADS * HEAD_DIM
B_KV_DIM = B_KV_HEADS * HEAD_DIM
C_HEADS = D_MIX // HEAD_DIM
C_DIM = C_HEADS * HEAD_DIM
EVEN_SPLITS = (3 * A_DIM, A_DIM, A_HEADS, A_HEADS, A_HEADS, A_HEADS, B_Q_DIM, B_KV_DIM, B_KV_DIM)
IN_EVEN = sum(EVEN_SPLITS)
IN_ODD = 3 * C_DIM
SHORT_CONV = 3
DELTA_CHUNK = 64
Q_BLOCK = 128
NA_ROWS_MAX = 8
NA_COLS = 16
ROPE_THETA = 10000.0
N_EXPERTS = 16
EXPERT_FF = D_MODEL
EC_CAPACITY = 2
N_EVEN = (DEPTH + 1) // 2
N_ODD = DEPTH // 2
EPS = 1e-6
F32 = jnp.float32

kernel_name = 'hybrid_deltanet_gqa_natten_ecmoe_dit'


def rms_norm(x, g):
    xf = x.astype(F32)
    y = xf * lax.rsqrt(jnp.mean(xf * xf, axis=-1, keepdims=True) + EPS)
    return (y * g.astype(F32)).astype(x.dtype)


def l2_norm(x):
    return x * lax.rsqrt(jnp.sum(x * x, axis=-1, keepdims=True) + EPS)


def split_cols(p, sizes):
    return jnp.split(p, np.cumsum(sizes)[:-1].tolist(), axis=-1)


def modulate(x, g, shift, scale):
    return rms_norm(x, g) * (1 + scale) + shift


def axial_rope(n, dh):
    t = jnp.arange(n)
    rows = (t // GRID_W).astype(F32)
    cols = (t % GRID_W).astype(F32)
    n_freq = dh // 4
    inv = ROPE_THETA ** (-jnp.arange(n_freq, dtype=F32) / n_freq)
    ang = jnp.concatenate([rows[:, None] * inv, cols[:, None] * inv], axis=-1)
    return jnp.cos(ang), jnp.sin(ang)


def apply_rope(x, cos, sin):
    xf = x.astype(F32)
    x1, x2 = jnp.split(xf, 2, axis=-1)
    c, s = cos[:, None, :], sin[:, None, :]
    return jnp.concatenate([x1 * c - x2 * s, x1 * s + x2 * c], axis=-1).astype(x.dtype)


def short_conv(x, w):
    pad = w.shape[0] // 2
    return lax.conv_general_dilated(x, w[:, None, :].astype(x.dtype), (1,), [(pad, pad)],
                                    dimension_numbers=('NWC', 'WIO', 'NWC'),
                                    feature_group_count=x.shape[-1])


def deltanet_prep(qkv, a_f, b_f, a_b, b_b, conv_w, a_log, dt_bias):
    bn, n, _ = qkv.shape
    qkv = jax.nn.silu(short_conv(qkv, conv_w)).astype(F32)
    q, k, v = jnp.split(qkv, 3, axis=-1)
    q = l2_norm(q.reshape(bn, n, A_HEADS, HEAD_DIM)) * HEAD_DIM ** -0.5
    k = l2_norm(k.reshape(bn, n, A_HEADS, HEAD_DIM))
    v = v.reshape(bn, n, A_HEADS, HEAD_DIM)
    dirs = []
    for d, (a_in, b_in) in enumerate(((a_f, b_f), (a_b, b_b))):
        log_a = -jnp.exp(a_log[d].astype(F32)) * jax.nn.softplus(a_in.astype(F32) + dt_bias[d].astype(F32))
        beta = jax.nn.sigmoid(b_in.astype(F32))
        dirs.append((log_a, beta))
    return q, k, v, dirs


def delta_rule_chunked(q, k, v, log_a, beta, s0):
    bn, n, h, dk = q.shape
    dv = v.shape[-1]
    L = DELTA_CHUNK
    nc = n // L
    chunk = lambda t: t.reshape(bn, nc, L, h, t.shape[-1]).transpose(1, 0, 3, 2, 4)
    qc, kc, vc = chunk(q), chunk(k), chunk(v)
    g = jnp.cumsum(log_a.reshape(bn, nc, L, h).transpose(1, 0, 3, 2), axis=-1)
    bc = beta.reshape(bn, nc, L, h).transpose(1, 0, 3, 2)
    tri = np.tril(np.ones((L, L), dtype=bool))
    strict = np.tril(np.ones((L, L), dtype=bool), -1)
    gam = jnp.exp(jnp.where(tri, g[..., :, None] - g[..., None, :], -jnp.inf))
    kb = kc * bc[..., None]
    m = jnp.where(strict, jnp.einsum('nbhid,nbhjd->nbhij', kb, kc) * gam, 0.0)
    t_mat = m + jnp.eye(L, dtype=m.dtype)
    rhs = jnp.concatenate([vc * bc[..., None], kb * jnp.exp(g)[..., None]], axis=-1)
    sol = lax.linalg.triangular_solve(t_mat, rhs, left_side=True, lower=True, unit_diagonal=True)
    u, w = sol[..., :dv], sol[..., dv:]
    a_qk = jnp.einsum('nbhid,nbhjd->nbhij', qc, kc) * gam

    def step(s, inp):
        q_i, k_i, u_i, w_i, g_i, a_i = inp
        v_new = u_i - jnp.einsum('bhld,bhdv->bhlv', w_i, s)
        o_i = (jnp.einsum('bhld,bhdv->bhlv', q_i * jnp.exp(g_i)[..., None], s)
               + jnp.einsum('bhij,bhjv->bhiv', a_i, v_new))
        g_last = g_i[..., -1:]
        s = (s * jnp.exp(g_last)[..., None]
             + jnp.einsum('bhld,bhlv->bhdv', k_i * jnp.exp(g_last - g_i)[..., None], v_new))
        return s, o_i

    s_fin, o = lax.scan(step, s0, (qc, kc, u, w, g, a_qk))
    return s_fin, o.transpose(1, 0, 3, 2, 4).reshape(bn, n, h, dv)


def bidir_deltanet(lat, ctx_s):
    q_l, k_l, v_l, d_l = lat
    q_c, k_c, v_c, d_c = ctx_s
    s0 = jnp.zeros((q_l.shape[0], A_HEADS, HEAD_DIM, HEAD_DIM), F32)
    o_lat = jnp.zeros_like(v_l)
    o_ctx = jnp.zeros_like(v_c)
    for d in range(2):
        f = (lambda t: jnp.flip(t, axis=1)) if d == 1 else (lambda t: t)
        s_ctx, oc = delta_rule_chunked(f(q_c), f(k_c), f(v_c), f(d_c[d][0]), f(d_c[d][1]), s0)
        _, ol = delta_rule_chunked(f(q_l), f(k_l), f(v_l), f(d_l[d][0]), f(d_l[d][1]), s_ctx)
        o_lat = o_lat + f(ol)
        o_ctx = o_ctx + f(oc)
    return o_lat, o_ctx


def gated_out(o, z, g):
    bn, n, _ = z.shape
    y = rms_norm(o.astype(z.dtype), g) * jax.nn.silu(z.reshape(bn, n, A_HEADS, HEAD_DIM))
    return y.reshape(bn, n, A_DIM)


def attend_gqa(q, keys, vals):
    s = jnp.einsum('bqhgd,bkhd->bhgqk', q, keys).astype(F32)
    p = jax.nn.softmax(s, axis=-1).astype(vals.dtype)
    return jnp.einsum('bhgqk,bkhd->bqhgd', p, vals)


def gqa_latent(q, k, v, k_ctx, v_ctx):
    bn, n, hq, dh = q.shape
    hkv = k.shape[2]
    keys = jnp.concatenate([k_ctx, k], axis=1)
    vals = jnp.concatenate([v_ctx, v], axis=1)
    qb = q.reshape(bn, n // Q_BLOCK, Q_BLOCK, hkv, hq // hkv, dh).transpose(1, 0, 2, 3, 4, 5)
    o = lax.map(lambda q_blk: attend_gqa(q_blk, keys, vals), qb)
    return o.transpose(1, 0, 2, 3, 4, 5).reshape(bn, n, hq * dh)


def gqa_context(q, k, v):
    bn, n, hq, dh = q.shape
    hkv = k.shape[2]
    o = attend_gqa(q.reshape(bn, n, hkv, hq // hkv, dh), k, v)
    return o.reshape(bn, n, hq * dh)


def neighbourhood_latent(q, k, v, k_ctx, v_ctx, rpb):
    bn, n, h, dh = q.shape
    n_ctx = k_ctx.shape[1]
    rows = n // GRID_W
    wr = min(NA_ROWS_MAX, rows)
    r = np.arange(rows)
    row_start = np.clip(r - wr // 2, 0, rows - wr)
    row_off = row_start[:, None] + np.arange(wr)[None, :] - r[:, None]
    col = np.arange(GRID_W)
    col_idx = np.clip(col - NA_COLS // 2, 0, GRID_W - NA_COLS)[:, None] + np.arange(NA_COLS)[None, :]
    col_off = col_idx - col[:, None]
    k_grid = k.reshape(bn, rows, GRID_W, h, dh)
    v_grid = v.reshape(bn, rows, GRID_W, h, dh)
    q_rows = q.reshape(bn, rows, GRID_W, h, dh).transpose(1, 0, 2, 3, 4)

    def row_block(inp):
        q_r, r_start, r_off = inp
        k_band = lax.dynamic_slice_in_dim(k_grid, r_start, wr, axis=1)[:, :, col_idx]
        v_band = lax.dynamic_slice_in_dim(v_grid, r_start, wr, axis=1)[:, :, col_idx]
        bias = rpb[:, r_off[None, :, None] + (NA_ROWS_MAX - 1), col_off[:, None, :] + (NA_COLS - 1)]
        s_loc = jnp.einsum('bqhd,brqchd->bhqrc', q_r, k_band).astype(F32) + bias.astype(F32)[None]
        s_ctx = jnp.einsum('bqhd,bkhd->bhqk', q_r, k_ctx).astype(F32)
        s = jnp.concatenate([s_ctx, s_loc.reshape(bn, h, GRID_W, wr * NA_COLS)], axis=-1)
        p = jax.nn.softmax(s, axis=-1).astype(v.dtype)
        p_ctx = p[..., :n_ctx]
        p_loc = p[..., n_ctx:].reshape(bn, h, GRID_W, wr, NA_COLS)
        return (jnp.einsum('bhqk,bkhd->bqhd', p_ctx, v_ctx)
                + jnp.einsum('bhqrc,brqchd->bqhd', p_loc, v_band))

    o = lax.map(row_block, (q_rows, jnp.asarray(row_start, jnp.int32), jnp.asarray(row_off, jnp.int32)))
    return o.transpose(1, 0, 2, 3, 4).reshape(bn, n, h * dh)


def even_mixer(a_lat, a_ctx, w_in, conv_w, a_log, dt_bias, out_norm_g, q_norm_g, k_norm_g, w_out,
               cos, sin, need_ctx):
    pl = split_cols(a_lat @ w_in, EVEN_SPLITS)
    pc = split_cols(a_ctx @ w_in, EVEN_SPLITS)
    lat_a = deltanet_prep(pl[0], *pl[2:6], conv_w, a_log, dt_bias)
    ctx_a = deltanet_prep(pc[0], *pc[2:6], conv_w, a_log, dt_bias)
    o_lat_a, o_ctx_a = bidir_deltanet(lat_a, ctx_a)

    def qkv_b(p):
        bn, n, _ = p[6].shape
        q = rms_norm(p[6].reshape(bn, n, B_Q_HEADS, HEAD_DIM), q_norm_g) * HEAD_DIM ** -0.5
        k = rms_norm(p[7].reshape(bn, n, B_KV_HEADS, HEAD_DIM), k_norm_g)
        v = p[8].reshape(bn, n, B_KV_HEADS, HEAD_DIM)
        return q, k, v

    q_l, k_l, v_l = qkv_b(pl)
    q_c, k_c, v_c = qkv_b(pc)
    o_lat_b = gqa_latent(apply_rope(q_l, cos, sin), apply_rope(k_l, cos, sin), v_l, k_c, v_c)
    y_lat = jnp.concatenate([gated_out(o_lat_a, pl[1], out_norm_g), o_lat_b], axis=-1) @ w_out
    if not need_ctx:
        return y_lat, None
    o_ctx_b = gqa_context(q_c, k_c, v_c)
    y_ctx = jnp.concatenate([gated_out(o_ctx_a, pc[1], out_norm_g), o_ctx_b], axis=-1) @ w_out
    return y_lat, y_ctx


def odd_mixer(a_lat, a_ctx, w_in, rpb, w_out, need_ctx):
    def qkv_c(a):
        bn, n, _ = a.shape
        p = (a @ w_in).reshape(bn, n, 3, C_HEADS, HEAD_DIM)
        return p[:, :, 0] * HEAD_DIM ** -0.5, p[:, :, 1], p[:, :, 2]

    q_l, k_l, v_l = qkv_c(a_lat)
    q_c, k_c, v_c = qkv_c(a_ctx)
    y_lat = neighbourhood_latent(q_l, k_l, v_l, k_c, v_c, rpb) @ w_out
    if not need_ctx:
        return y_lat, None
    y_ctx = gqa_context(q_c, k_c, v_c) @ w_out
    return y_lat, y_ctx


def expert_choice_ffn(h, w_router, w_gate, w_up, w_down):
    bn, t, d = h.shape
    cap = max(1, EC_CAPACITY * t // N_EXPERTS)
    aff = jax.nn.softmax((h @ w_router).astype(F32), axis=-1)
    gate, idx = lax.top_k(jnp.swapaxes(aff, 1, 2), cap)
    xs = jax.vmap(lambda hb, ib: hb[ib])(h, idx)
    hid = jax.nn.silu(jnp.einsum('becd,edf->becf', xs, w_gate)) * jnp.einsum('becd,edf->becf', xs, w_up)
    y = jnp.einsum('becf,efd->becd', hid, w_down) * gate[..., None].astype(h.dtype)
    return jax.vmap(lambda yb, ib: jnp.zeros((t, d), yb.dtype).at[ib.reshape(-1)].add(yb.reshape(-1, d)))(y, idx)


def setup_inputs(seed: int = 0) -> dict:
    key = jax.random.key(seed)
    ks = jax.random.split(key, 26)

    def nrm(k, shape, scale):
        return jax.random.normal(k, shape, F32) * scale

    def gain(k, shape):
        return 1.0 + 0.02 * jax.random.normal(k, shape, F32)

    dt = jnp.exp(jax.random.uniform(ks[9], (N_EVEN, 2, A_HEADS), F32, math.log(1e-3), math.log(1e-1)))
    return {
        'x': nrm(ks[0], (BATCH, SEQ, D_MODEL), 1.0),
        'c': nrm(ks[1], (BATCH, D_MODEL), 1.0),
        'ctx': nrm(ks[2], (BATCH, CTX_LEN, D_MODEL), 1.0),
        'c_ctx': nrm(ks[3], (D_MODEL,), 1.0),
        'ada_w': nrm(ks[4], (DEPTH, D_MODEL, 6 * D_MODEL), 0.5 * D_MODEL ** -0.5),
        'ada_b': nrm(ks[5], (DEPTH, 6 * D_MODEL), 0.02),
        'ln1_g': gain(ks[6], (DEPTH, D_MODEL)),
        'ln2_g': gain(ks[7], (DEPTH, D_MODEL)),
        'even_w_in': nrm(ks[8], (N_EVEN, D_MODEL, IN_EVEN), D_MODEL ** -0.5),
        'even_conv_w': nrm(ks[10], (N_EVEN, SHORT_CONV, 3 * A_DIM), SHORT_CONV ** -0.5),
        'even_a_log': jnp.log(jax.random.uniform(ks[11], (N_EVEN, 2, A_HEADS), F32, 1.0, 16.0)),
        'even_dt_bias': dt + jnp.log(-jnp.expm1(-dt)),
        'even_out_norm_g': gain(ks[12], (N_EVEN, HEAD_DIM)),
        'even_q_norm_g': gain(ks[13], (N_EVEN, HEAD_DIM)),
        'even_k_norm_g': gain(ks[14], (N_EVEN, HEAD_DIM)),
        'even_w_out': nrm(ks[15], (N_EVEN, D_MIX, D_MODEL), D_MIX ** -0.5),
        'odd_w_in': nrm(ks[16], (N_ODD, D_MODEL, IN_ODD), D_MODEL ** -0.5),
        'odd_rpb': nrm(ks[17], (N_ODD, C_HEADS, 2 * NA_ROWS_MAX - 1, 2 * NA_COLS - 1), 0.2),
        'odd_w_out': nrm(ks[18], (N_ODD, C_DIM, D_MODEL), C_DIM ** -0.5),
        'router_w': nrm(ks[19], (DEPTH, D_MODEL, N_EXPERTS), D_MODEL ** -0.5),
        'expert_w_gate': nrm(ks[20], (DEPTH, N_EXPERTS, D_MODEL, EXPERT_FF), D_MODEL ** -0.5),
        'expert_w_up': nrm(ks[21], (DEPTH, N_EXPERTS, D_MODEL, EXPERT_FF), D_MODEL ** -0.5),
        'expert_w_down': nrm(ks[22], (DEPTH, N_EXPERTS, EXPERT_FF, D_MODEL), EXPERT_FF ** -0.5),
        'final_norm_g': gain(ks[23], (D_MODEL,)),
    }


def reference(x, c, ctx, c_ctx, ada_w, ada_b, ln1_g, ln2_g, even_w_in, even_conv_w, even_a_log,
              even_dt_bias, even_out_norm_g, even_q_norm_g, even_k_norm_g, even_w_out, odd_w_in,
              odd_rpb, odd_w_out, router_w, expert_w_gate, expert_w_up, expert_w_down, final_norm_g):
    cos, sin = axial_rope(x.shape[1], HEAD_DIM)
    h, hc = x, ctx
    s_lat = jax.nn.silu(c)
    s_ctx = jax.nn.silu(c_ctx)[None]
    for layer in range(DEPTH):
        need_ctx = layer < DEPTH - 1
        i = layer // 2
        mod_l = jnp.split((s_lat @ ada_w[layer] + ada_b[layer])[:, None, :], 6, axis=-1)
        mod_c = jnp.split((s_ctx @ ada_w[layer] + ada_b[layer])[:, None, :], 6, axis=-1)
        a_lat = modulate(h, ln1_g[layer], mod_l[0], mod_l[1])
        a_ctx = modulate(hc, ln1_g[layer], mod_c[0], mod_c[1])
        if layer % 2 == 0:
            y_lat, y_ctx = even_mixer(a_lat, a_ctx, even_w_in[i], even_conv_w[i], even_a_log[i],
                                      even_dt_bias[i], even_out_norm_g[i], even_q_norm_g[i],
                                      even_k_norm_g[i], even_w_out[i], cos, sin, need_ctx)
        else:
            y_lat, y_ctx = odd_mixer(a_lat, a_ctx, odd_w_in[i], odd_rpb[i], odd_w_out[i], need_ctx)
        moe = (router_w[layer], expert_w_gate[layer], expert_w_up[layer], expert_w_down[layer])
        h = h + mod_l[2] * y_lat
        h = h + mod_l[5] * expert_choice_ffn(modulate(h, ln2_g[layer], mod_l[3], mod_l[4]), *moe)
        if need_ctx:
            hc = hc + mod_c[2] * y_ctx
            hc = hc + mod_c[5] * expert_choice_ffn(modulate(hc, ln2_g[layer], mod_c[3], mod_c[4]), *moe)
    return rms_norm(h, final_norm_g)
```

```cpp
#include <hip/hip_runtime.h>
#include <hip/hip_cooperative_groups.h>
#include <cstdio>
#include <cstdint>
namespace cg = cooperative_groups;

typedef unsigned short bf16_t;
typedef short bf16x8 __attribute__((ext_vector_type(8)));
typedef float f32x2 __attribute__((ext_vector_type(2)));
typedef float f32x4 __attribute__((ext_vector_type(4)));
typedef float f32x16 __attribute__((ext_vector_type(16)));
typedef unsigned u32x2 __attribute__((ext_vector_type(2)));
typedef unsigned u32x4 __attribute__((ext_vector_type(4)));
typedef __bf16 bf16x2_t __attribute__((ext_vector_type(2)));

constexpr int NT = 512, NWV = 8;
constexpr int LDS_BYTES = 155648;
constexpr int DM = 1024, SEQ = 8192, NCTX = 256;
constexpr int MLAT = 2 * SEQ;
constexpr int NR = MLAT + 2 * NCTX;
constexpr int PROJ_LD = 3072;
constexpr int NKEY = NCTX + SEQ;
constexpr int SLOTS = 2112;
constexpr int NCHUNK = NR / 64;
constexpr float LOG2E = 1.4426950408889634f;
constexpr float EPS = 1e-6f;

constexpr size_t MB = 1u << 20;
constexpr size_t WS_CTL = 0;
constexpr size_t WS_MOD = 64 * 1024;
constexpr size_t WS_ROPE = 1 * MB;
constexpr size_t WS_AFF = 3 * MB;
constexpr size_t WS_INV = 5 * MB;
constexpr size_t WS_IDX = 7 * MB;
constexpr size_t WS_GATEV = 7 * MB + 512 * 1024;
constexpr size_t WS_GATES = 8 * MB;
constexpr size_t WS_EGDEC = 11 * MB;
constexpr size_t WS_HC = 14 * MB;
constexpr size_t WS_WEI = 16 * MB;
constexpr size_t WS_WEO = 23 * MB;
constexpr size_t WS_WOI = 25 * MB;
constexpr size_t WS_WOO = 32 * MB;
constexpr size_t WS_WEXP = 34 * MB;
constexpr size_t WS_A = 136 * MB;
constexpr size_t WS_R = 172 * MB;
constexpr size_t WS_PROJ = WS_R;
constexpr size_t WS_MIX = WS_R + 104 * MB;
constexpr size_t WS_O1 = WS_R + 139 * MB;
constexpr size_t WS_QB = WS_R + 157 * MB;
constexpr size_t WS_KB = WS_R + 175 * MB;
constexpr size_t WS_VT = WS_R + 180 * MB;
constexpr size_t WS_QN = WS_R + 185 * MB;
constexpr size_t WS_KNT = WS_R + 203 * MB;
constexpr size_t WS_WUA = WS_R + 221 * MB;
constexpr size_t WS_WEXP1 = WS_R + (221ull << 20);
constexpr size_t WS_XS = WS_R;
constexpr size_t WS_HIDL = WS_R + 64 * MB;
constexpr size_t WS_YL = WS_R + 128 * MB;
constexpr size_t WS_HIDC = WS_R + 192 * MB;
constexpr size_t WS_YC = WS_R + 194 * MB;
constexpr size_t WS_END = WS_R + 326 * MB;
constexpr size_t EXPW = (size_t)3072 * 1024;

struct Params {
  const float* x; const float* c; const float* ctx; const float* c_ctx; const float* ada_w; const float* ada_b;
  const float* ln1_g; const float* ln2_g; const float* even_w_in; const float* even_conv_w; const float* even_a_log;
  const float* even_dt_bias; const float* even_out_norm_g; const float* even_q_norm_g; const float* even_k_norm_g;
  const float* even_w_out; const float* odd_w_in; const float* odd_rpb; const float* odd_w_out; const float* router_w;
  const float* w_gate; const float* w_up; const float* w_down; const float* final_g;
  float* out; unsigned char* ws;
};

__device__ __forceinline__ unsigned pk2(float lo, float hi) { f32x2 v = {lo, hi}; bf16x2_t b = __builtin_convertvector(v, bf16x2_t); return __builtin_bit_cast(unsigned, b); }
__device__ __forceinline__ float bflo(unsigned u) { return __uint_as_float(u << 16); }
__device__ __forceinline__ float bfhi(unsigned u) { return __uint_as_float(u & 0xffff0000u); }
__device__ __forceinline__ float bf1(bf16_t b) { return __uint_as_float(((unsigned)b) << 16); }
__device__ __forceinline__ bf16_t f2bf(float f) { return (bf16_t)(pk2(f, 0.f) & 0xffffu); }
__device__ __forceinline__ float wave_sum(float v) {
  v += __int_as_float(__builtin_amdgcn_mov_dpp(__float_as_int(v), 0xB1, 0xF, 0xF, true));
  v += __int_as_float(__builtin_amdgcn_mov_dpp(__float_as_int(v), 0x4E, 0xF, 0xF, true));
  v += __int_as_float(__builtin_amdgcn_mov_dpp(__float_as_int(v), 0x141, 0xF, 0xF, true));
  v += __int_as_float(__builtin_amdgcn_mov_dpp(__float_as_int(v), 0x140, 0xF, 0xF, true));
  const float r0 = __int_as_float(__builtin_amdgcn_readlane(__float_as_int(v), 0)), r1 = __int_as_float(__builtin_amdgcn_readlane(__float_as_int(v), 16));
  const float r2 = __int_as_float(__builtin_amdgcn_readlane(__float_as_int(v), 32)), r3 = __int_as_float(__builtin_amdgcn_readlane(__float_as_int(v), 48));
  return (r0 + r1) + (r2 + r3);
}
__device__ __forceinline__ float silu_f(float v) { return v / (1.f + __expf(-v)); }
__device__ __forceinline__ float sigmoid_f(float v) { return 1.f / (1.f + __expf(-v)); }
__device__ __forceinline__ float softplus_f(float v) { return fmaxf(v, 0.f) + log1pf(__expf(-fabsf(v))); }
__device__ __forceinline__ int row_sel(int r) { return r >= MLAT ? 2 : (r >> 13); }
__device__ __forceinline__ float* hrow_ptr(const Params& p, int r) { return r < MLAT ? p.out + (size_t)r * DM : (float*)(p.ws + WS_HC) + (size_t)(r - MLAT) * DM; }

__device__ __forceinline__ void sincos_d(float af, float& sn, float& cs) {
  const double a = (double)af;
  const double k = rint(a * 0.63661977236758134308);
  const double r = (a - k * 1.57079632679489655800) - k * 6.12323399573676603587e-17;
  const double r2 = r * r;
  double s = r * (1.0 + r2 * (-1.0 / 6 + r2 * (1.0 / 120 + r2 * (-1.0 / 5040 + r2 * (1.0 / 362880 + r2 * (-1.0 / 39916800 + r2 * (1.0 / 6227020800.0)))))));
  double c = 1.0 + r2 * (-0.5 + r2 * (1.0 / 24 + r2 * (-1.0 / 720 + r2 * (1.0 / 40320 + r2 * (-1.0 / 3628800 + r2 * (1.0 / 479001600.0 + r2 * (-1.0 / 87178291200.0)))))));
  const int q = ((int)k) & 3;
  double ss = (q & 1) ? c : s, cc = (q & 1) ? s : c;
  if (q == 1) cc = -cc; else if (q == 2) { ss = -ss; cc = -cc; } else if (q == 3) ss = -ss;
  sn = (float)ss; cs = (float)cc;
}

__device__ __forceinline__ float dpp_xor1(float v) { return __int_as_float(__builtin_amdgcn_mov_dpp(__float_as_int(v), 0xB1, 0xF, 0xF, true)); }
__device__ __forceinline__ float dpp_xor2(float v) { return __int_as_float(__builtin_amdgcn_mov_dpp(__float_as_int(v), 0x4E, 0xF, 0xF, true)); }
__device__ __forceinline__ unsigned wave_incl_scan_u(unsigned v, int lane) {
#pragma unroll
  for (int o = 1; o < 64; o <<= 1) { const unsigned t = __shfl_up(v, o); if (lane >= o) v += t; }
  return v;
}
__device__ __forceinline__ float wave_incl_scan_f(float v, int lane) {
#pragma unroll
  for (int o = 1; o < 64; o <<= 1) { const float t = __shfl_up(v, o); if (lane >= o) v += t; }
  return v;
}

__device__ __forceinline__ int ltid() { int t = threadIdx.x; asm volatile("" : "+v"(t)); return t; }

__device__ __forceinline__ float tred32(float (&a)[32], int lane) {
  float b[16], c[8], d[4], e[2];
  const bool h5 = lane & 32, h4 = lane & 16, h3 = lane & 8, h2 = lane & 4, h1 = lane & 2;
#pragma unroll
  for (int j = 0; j < 16; ++j) { const float keep = h5 ? a[16 + j] : a[j], send = h5 ? a[j] : a[16 + j]; b[j] = keep + __shfl_xor(send, 32); }
#pragma unroll
  for (int j = 0; j < 8; ++j) { const float keep = h4 ? b[8 + j] : b[j], send = h4 ? b[j] : b[8 + j]; c[j] = keep + __shfl_xor(send, 16); }
#pragma unroll
  for (int j = 0; j < 4; ++j) { const float keep = h3 ? c[4 + j] : c[j], send = h3 ? c[j] : c[4 + j]; d[j] = keep + __shfl_xor(send, 8); }
#pragma unroll
  for (int j = 0; j < 2; ++j) { const float keep = h2 ? d[2 + j] : d[j], send = h2 ? d[j] : d[2 + j]; e[j] = keep + __shfl_xor(send, 4); }
  const float keep = h1 ? e[1] : e[0], send = h1 ? e[0] : e[1];
  float v = keep + __shfl_xor(send, 2);
  v += __shfl_xor(v, 1);
  return v;
}
__device__ __forceinline__ float tred16(float (&a)[16], int lane) {
  float c[8], d[4], e[2];
  const bool h5 = lane & 32, h4 = lane & 16, h3 = lane & 8, h2 = lane & 4;
#pragma unroll
  for (int j = 0; j < 8; ++j) { const float keep = h5 ? a[8 + j] : a[j], send = h5 ? a[j] : a[8 + j]; c[j] = keep + __shfl_xor(send, 32); }
#pragma unroll
  for (int j = 0; j < 4; ++j) { const float keep = h4 ? c[4 + j] : c[j], send = h4 ? c[j] : c[4 + j]; d[j] = keep + __shfl_xor(send, 16); }
#pragma unroll
  for (int j = 0; j < 2; ++j) { const float keep = h3 ? d[2 + j] : d[j], send = h3 ? d[j] : d[2 + j]; e[j] = keep + __shfl_xor(send, 8); }
  const float keep = h2 ? e[1] : e[0], send = h2 ? e[0] : e[1];
  float v = keep + __shfl_xor(send, 4);
  v += __shfl_xor(v, 2); v += __shfl_xor(v, 1);
  return v;
}
namespace pg8 {
#define PG8_LAS __attribute__((address_space(3)))
typedef unsigned short bf16_t;
typedef short bf16x8 __attribute__((ext_vector_type(8)));
typedef float f32x4 __attribute__((ext_vector_type(4)));
typedef unsigned u32x4 __attribute__((ext_vector_type(4)));
constexpr int BM = 256, BK = 64, HALF = 128, HTB = HALF * BK * 2  , STAGE_BYTES = 8 * HTB, NXCD = 8, WGM = 8;

__host__ __device__ __forceinline__ int lds_byte(int r, int c) { const int st = (r >> 4) * 2 + (c >> 5), rr = r & 15, cc = c & 31, ob = rr * 64 + cc * 2; return st * 1024 + (ob ^ (((ob >> 9) & 1) << 5)); }
__host__ __device__ __forceinline__ void stage_rc(int b, int& R, int& C) { const int st = b / 1024, sb = b % 1024, swz = sb ^ (((sb >> 9) & 1) << 5); R = (st >> 1) * 16 + swz / 64; C = (st & 1) * 32 + (swz % 64) / 2; }
__host__ __device__ __forceinline__ int perm32(int rho) { const int n = rho >> 4, i = rho & 15; return 8 * (i >> 2) + 4 * n + (i & 3); }

struct Unit { int pm, pn; };
struct Gemm { const bf16_t* A; const bf16_t* Bt; int M, N, K; int mpe; size_t bgroup; };

struct StaticOrder {
    int nM, nN, nwg, G, c;
    __host__ __device__ void init(int M, int N, int G_, int c_) { nM = M / BM; nN = N / BM; nwg = nM * nN; G = G_; c = c_; }
    __host__ __device__ bool next(int i, Unit& u) const {
        const long L = (long)i * G + c; if (L >= nwg) return false;
        int wgid = (int)L; { const int q = nwg / NXCD, r = nwg % NXCD, xcd = wgid % NXCD, off = wgid / NXCD; wgid = (xcd < r ? xcd * (q + 1) : r * (q + 1) + (xcd - r) * q) + off; }
        const int nig = WGM * nN, gid = wgid / nig, fm = gid * WGM, gsz = (nM - fm) < WGM ? (nM - fm) : WGM;
        u.pm = fm + ((wgid % nig) % gsz); u.pn = (wgid % nig) / gsz; return true;
    }
    __device__ __forceinline__ void a_ready(const Unit&) const {}
    __device__ __forceinline__ void done(const Unit&) const {}
};


template <class Epi, class Sched, bool ALIGN_EPI = false, bool SP2 = false, bool GATHER = false>
__device__ __forceinline__ void gemm_phase(PG8_LAS unsigned char* lds, const Gemm g, const Sched& S, const Epi& E, const PG8_LAS unsigned* gtab = nullptr) {
    const int tid = threadIdx.x, wid = __builtin_amdgcn_readfirstlane(tid >> 6), lane = tid & 63, wr = wid >> 2, wc = wid & 3, fr = lane & 15, fq = lane >> 4;
    const int K = g.K, nt = K / BK;
    unsigned voffA[2], voffB[2];
#pragma unroll
    for (int i = 0; i < 2; ++i) { int R, C; stage_rc(tid * 16 + i * 8192, R, C); const int Rb = Epi::PERM ? ((R & ~31) + perm32(R & 31)) : R;
        voffA[i] = (unsigned)(R * K + C) * 2u; voffB[i] = (unsigned)(Rb * K + C) * 2u; }
    int gR0; unsigned gC; { int R, C; stage_rc(tid * 16, R, C); gR0 = R; gC = (unsigned)C * 2u; }
    unsigned go[2][2], ngo[2][2];
    const size_t kstep = (size_t)(BK * 2);
    const size_t hstep = (size_t)HALF * K * 2;
    const size_t tstep = 2 * hstep;
    const unsigned ldsw = (unsigned)wid * 1024u;
    const int aoff = lds_byte(wr * 64 + fr, fq * 8), boff = lds_byte(wc * 32 + fr, fq * 8);
#define PG8_SA(b, h) (((b) * 2 + (h)) * HTB)
#define PG8_SB(b, h) ((4 + (b) * 2 + (h)) * HTB)
#define PG8_STAGE(bufoff, gbase, voff) do { _Pragma("unroll") for (int _i = 0; _i < 2; ++_i) \
        __builtin_amdgcn_global_load_lds((const unsigned*)((const char*)(gbase) + (voff)[_i]), (PG8_LAS unsigned*)(lds + (bufoff) + ldsw + _i * 8192), 16, 0, 0); } while (0)
#define PG8_STAGE_A(bufoff, ptr_ng, kb, h, OFFS) do { if constexpr (GATHER) { PG8_STAGE(bufoff, (const char*)g.A + (kb), OFFS[h]); } else { PG8_STAGE(bufoff, (ptr_ng) + (h) * hstep, voffA); } } while (0)
#define PG8_LDA(dst, b, h) do { _Pragma("unroll") for (int m = 0; m < 4; ++m) _Pragma("unroll") for (int k = 0; k < 2; ++k) dst[m][k] = *(const PG8_LAS bf16x8*)(lds + PG8_SA(b, h) + aoff + m * 2048 + k * 1024); } while (0)
#define PG8_LDB(dst, b, h) do { _Pragma("unroll") for (int n = 0; n < 2; ++n) _Pragma("unroll") for (int k = 0; k < 2; ++k) dst[n][k] = *(const PG8_LAS bf16x8*)(lds + PG8_SB(b, h) + boff + n * 2048 + k * 1024); } while (0)
#define PG8_MMA(ai, bj, At, Bt) do { __builtin_amdgcn_s_setprio(1); _Pragma("unroll") for (int m = 0; m < 4; ++m) _Pragma("unroll") for (int n = 0; n < 2; ++n) _Pragma("unroll") for (int k = 0; k < 2; ++k) \
        acc[ai][bj][m][n] = __builtin_amdgcn_mfma_f32_16x16x32_bf16(Bt[n][k], At[m][k], acc[ai][bj][m][n], 0, 0, 0); __builtin_amdgcn_s_setprio(0); } while (0)
#define PG8_WAIT_V(n) asm volatile("s_waitcnt vmcnt(" #n ")" ::: "memory")
#define PG8_WAIT_L(n) asm volatile("s_waitcnt lgkmcnt(" #n ")" ::: "memory")
#define PG8_BAR __builtin_amdgcn_s_barrier()
#define PG8_SCHED __builtin_amdgcn_sched_barrier(0)
    Unit cur, nxt; int ui = 0;
    if (!S.next(0, cur)) return;
    f32x4 acc[2][2][4][2];
#pragma unroll
    for (int a = 0; a < 2; ++a)
#pragma unroll
        for (int b = 0; b < 2; ++b)
#pragma unroll
            for (int m = 0; m < 4; ++m)
#pragma unroll
                for (int n = 0; n < 2; ++n) acc[a][b][m][n] = (f32x4){0.f, 0.f, 0.f, 0.f};
    bf16x8 At[4][2], B0[2][2], B1[2][2];
    const char* cA = (const char*)g.A + (size_t)cur.pm * tstep; const char* cB = (const char*)g.Bt + (g.mpe ? (size_t)(cur.pm / g.mpe) * g.bgroup : (size_t)0) + (size_t)cur.pn * tstep;
    S.a_ready(cur);
    if constexpr (GATHER) {
#pragma unroll
        for (int h = 0; h < 2; ++h)
#pragma unroll
            for (int i = 0; i < 2; ++i) go[h][i] = gtab[h * 128 + gR0 + 64 * i] + gC;
    }
    if constexpr (SP2) {
        PG8_STAGE(PG8_SB(0, 0), cB, voffB); PG8_STAGE(PG8_SB(0, 1), cB + hstep, voffB); PG8_STAGE_A(PG8_SA(0, 0), cA, 0, 0, go); PG8_STAGE_A(PG8_SA(0, 1), cA, 0, 1, go);
        if (wr == 1) PG8_BAR;
        PG8_WAIT_V(2); PG8_BAR;
        PG8_STAGE(PG8_SB(1, 0), cB + kstep, voffB); PG8_STAGE_A(PG8_SA(1, 0), cA + kstep, kstep, 0, go); PG8_STAGE(PG8_SB(1, 1), cB + hstep + kstep, voffB);
        PG8_WAIT_V(6); PG8_BAR;
    } else {
        PG8_STAGE(PG8_SB(0, 0), cB, voffB); PG8_STAGE(PG8_SA(0, 0), cA, voffA); PG8_STAGE(PG8_SB(0, 1), cB + hstep, voffB); PG8_STAGE(PG8_SA(0, 1), cA + hstep, voffA);
        if (wr == 1) PG8_BAR;
        PG8_WAIT_V(4); PG8_BAR;
        PG8_STAGE(PG8_SB(1, 0), cB + kstep, voffB); PG8_STAGE(PG8_SA(1, 0), cA + kstep, voffA); PG8_STAGE(PG8_SB(1, 1), cB + hstep + kstep, voffB);
        PG8_WAIT_V(6); PG8_BAR;
    }
    for (;;) {
        const bool has_next = S.next(ui + 1, nxt);
        if constexpr (GATHER) {
#pragma unroll
            for (int h = 0; h < 2; ++h)
#pragma unroll
                for (int i = 0; i < 2; ++i) ngo[h][i] = has_next ? gtab[(ui + 1) * 256 + h * 128 + gR0 + 64 * i] + gC : go[h][i];
        }
        const char* nA = has_next ? (const char*)g.A + (size_t)nxt.pm * tstep : cA; const char* nB = has_next ? (const char*)g.Bt + (g.mpe ? (size_t)(nxt.pm / g.mpe) * g.bgroup : (size_t)0) + (size_t)nxt.pn * tstep : cB;
        for (int t = 0; t < nt; t += 2) {
            const bool last = (t == nt - 2);
            const char* a1 = cA + (size_t)(t + 1) * kstep;
            const char* a2 = last ? nA : cA + (size_t)(t + 2) * kstep; const char* b2 = last ? nB : cB + (size_t)(t + 2) * kstep;
            const char* a3 = a2 + kstep; const char* b3 = b2 + kstep;
            if (last && has_next) S.a_ready(nxt);
            unsigned s2[2][2]; size_t kb1 = 0, kb2 = 0;
            if constexpr (GATHER) {
#pragma unroll
                for (int h = 0; h < 2; ++h)
#pragma unroll
                    for (int i = 0; i < 2; ++i) s2[h][i] = last ? ngo[h][i] : go[h][i];
                kb1 = (size_t)(t + 1) * kstep; kb2 = last ? (size_t)0 : (size_t)(t + 2) * kstep;
            }
            if constexpr (SP2) {
            PG8_LDB(B0, 0, 0); PG8_LDB(B1, 0, 1); PG8_SCHED; PG8_LDA(At, 0, 0); PG8_STAGE_A(PG8_SA(1, 1), a1, kb1, 1, go);
            PG8_WAIT_V(8); PG8_WAIT_L(0); PG8_BAR; PG8_MMA(0, 0, At, B0); PG8_MMA(0, 1, At, B1); PG8_BAR; PG8_SCHED;
            PG8_LDA(At, 0, 1); PG8_STAGE(PG8_SB(0, 0), b2, voffB); PG8_STAGE(PG8_SB(0, 1), b2 + hstep, voffB); PG8_STAGE_A(PG8_SA(0, 0), a2, kb2, 0, s2);
            PG8_WAIT_V(8); PG8_WAIT_L(0); PG8_BAR; PG8_MMA(1, 0, At, B0); PG8_MMA(1, 1, At, B1); PG8_BAR; PG8_SCHED;
            PG8_LDB(B0, 1, 0); PG8_LDB(B1, 1, 1); PG8_SCHED; PG8_LDA(At, 1, 0); PG8_STAGE_A(PG8_SA(0, 1), a2, kb2, 1, s2);
            PG8_WAIT_V(8); PG8_WAIT_L(0); PG8_BAR; PG8_MMA(0, 0, At, B0); PG8_MMA(0, 1, At, B1); PG8_BAR; PG8_SCHED;
            PG8_LDA(At, 1, 1); PG8_STAGE(PG8_SB(1, 0), b3, voffB); PG8_STAGE(PG8_SB(1, 1), b3 + hstep, voffB); PG8_STAGE_A(PG8_SA(1, 0), a3, kb2 + kstep, 0, s2);
            PG8_WAIT_V(8); PG8_WAIT_L(0); PG8_BAR; PG8_MMA(1, 0, At, B0); PG8_MMA(1, 1, At, B1); PG8_BAR; PG8_SCHED;
            } else {
            PG8_LDB(B0, 0, 0); PG8_SCHED; PG8_LDA(At, 0, 0); PG8_STAGE(PG8_SA(1, 1), a1 + hstep, voffA);
            PG8_WAIT_L(8); PG8_BAR; PG8_WAIT_L(0); PG8_MMA(0, 0, At, B0); PG8_BAR; PG8_SCHED;
            PG8_LDB(B1, 0, 1); PG8_STAGE(PG8_SB(0, 0), b2, voffB);
            PG8_BAR; PG8_WAIT_L(0); PG8_MMA(0, 1, At, B1); PG8_BAR;
            PG8_LDA(At, 0, 1); PG8_STAGE(PG8_SA(0, 0), a2, voffA);
            PG8_BAR; PG8_WAIT_L(0); PG8_MMA(1, 0, At, B0); PG8_BAR; PG8_SCHED;
            PG8_STAGE(PG8_SB(0, 1), b2 + hstep, voffB);
            PG8_WAIT_V(6); PG8_BAR; PG8_MMA(1, 1, At, B1); PG8_BAR;
            PG8_LDB(B0, 1, 0); PG8_SCHED; PG8_LDA(At, 1, 0); PG8_STAGE(PG8_SA(0, 1), a2 + hstep, voffA);
            PG8_WAIT_L(8); PG8_BAR; PG8_WAIT_L(0); PG8_MMA(0, 0, At, B0); PG8_BAR; PG8_SCHED;
            PG8_LDB(B1, 1, 1); PG8_STAGE(PG8_SB(1, 0), b3, voffB);
            PG8_BAR; PG8_WAIT_L(0); PG8_MMA(0, 1, At, B1); PG8_BAR;
            PG8_LDA(At, 1, 1); PG8_STAGE(PG8_SA(1, 0), a3, voffA);
            PG8_BAR; PG8_WAIT_L(0); PG8_MMA(1, 0, At, B0); PG8_BAR; PG8_SCHED;
            PG8_STAGE(PG8_SB(1, 1), b3 + hstep, voffB);
            PG8_WAIT_V(6); PG8_BAR; PG8_MMA(1, 1, At, B1); PG8_BAR;
            }
        }
        if constexpr (ALIGN_EPI) { if (wr == 0) PG8_BAR; }
        if constexpr (!Epi::AFTER_DRAIN) { E(acc, cur, wr, wc, fr, fq); S.done(cur); }
        if (!has_next) break;
#pragma unroll
        for (int a = 0; a < 2; ++a)
#pragma unroll
            for (int b = 0; b < 2; ++b)
#pragma unroll
                for (int m = 0; m < 4; ++m)
#pragma unroll
                    for (int n = 0; n < 2; ++n) acc[a][b][m][n] = (f32x4){0.f, 0.f, 0.f, 0.f};
        cur = nxt; cA = nA; cB = nB; ++ui;
        if constexpr (GATHER) {
#pragma unroll
            for (int h = 0; h < 2; ++h)
#pragma unroll
                for (int i = 0; i < 2; ++i) go[h][i] = ngo[h][i];
        }
        if constexpr (ALIGN_EPI) { if (wr == 1) PG8_BAR; }
    }
    PG8_WAIT_V(0);
    if constexpr (!ALIGN_EPI) { if (wr == 0) PG8_BAR; }
    PG8_BAR;
    if constexpr (Epi::AFTER_DRAIN) { E.fused(acc, cur, wr, wc, fr, fq, lds, wid, lane); S.done(cur); }
#undef PG8_SA
#undef PG8_SB
#undef PG8_STAGE
#undef PG8_STAGE_A
#undef PG8_LDA
#undef PG8_LDB
#undef PG8_MMA
#undef PG8_WAIT_V
#undef PG8_WAIT_L
#undef PG8_BAR
#undef PG8_SCHED
}
}

using pg8::Unit;
struct EpiStoreBf16 {
  static constexpr bool PERM = true, AFTER_DRAIN = false;
  bf16_t* O; int ldc; const float* rowscale;
  __device__ __forceinline__ void operator()(const f32x4 (&acc)[2][2][4][2], const Unit& u, int wr, int wc, int fr, int fq) const {
    const int row0 = u.pm * 256 + wr * 64 + fr, col0 = u.pn * 256 + wc * 32 + 8 * fq;
#pragma unroll
    for (int ai = 0; ai < 2; ++ai)
#pragma unroll
      for (int m = 0; m < 4; ++m) {
        const int row = row0 + ai * 128 + m * 16;
        const float sc = rowscale ? rowscale[(row >> 11) * SLOTS + (row & 2047)] : 1.f;
#pragma unroll
        for (int bj = 0; bj < 2; ++bj) {
          const f32x4 v0 = acc[ai][bj][m][0] * sc, v1 = acc[ai][bj][m][1] * sc;
          u32x4 w; w.x = pk2(v0.x, v0.y); w.y = pk2(v0.z, v0.w); w.z = pk2(v1.x, v1.y); w.w = pk2(v1.z, v1.w);
          *(u32x4*)(O + (size_t)row * ldc + col0 + bj * 128) = w;
        }
      }
  }
};
struct EpiResid {
  static constexpr bool PERM = true, AFTER_DRAIN = false;
  const float* Hin; float* H; const float* G1;
  __device__ __forceinline__ void operator()(const f32x4 (&acc)[2][2][4][2], const Unit& u, int wr, int wc, int fr, int fq) const {
    const int row0 = u.pm * 256 + wr * 64 + fr, col0 = u.pn * 256 + wc * 32 + 8 * fq;
    const float* g1 = G1 + ((u.pm * 256) >> 13) * 6144;
#pragma unroll
    for (int bj = 0; bj < 2; ++bj) {
      const int col = col0 + bj * 128;
      const f32x4 g0 = *(const f32x4*)(g1 + col), g4 = *(const f32x4*)(g1 + col + 4);
#pragma unroll
      for (int ai = 0; ai < 2; ++ai)
#pragma unroll
        for (int m = 0; m < 4; ++m) {
          const size_t ho = (size_t)(row0 + ai * 128 + m * 16) * DM + col;
          f32x4 h0 = *(const f32x4*)(Hin + ho), h1 = *(const f32x4*)(Hin + ho + 4);
          h0 += g0 * acc[ai][bj][m][0]; h1 += g4 * acc[ai][bj][m][1];
          *(f32x4*)(H + ho) = h0; *(f32x4*)(H + ho + 4) = h1;
        }
    }
  }
};
struct EpiMoe1 {
  static constexpr bool PERM = true, AFTER_DRAIN = false;
  bf16_t* HID;
  __device__ __forceinline__ void operator()(const f32x4 (&acc)[2][2][4][2], const Unit& u, int wr, int wc, int fr, int fq) const {
    const int row0 = u.pm * 256 + wr * 64 + fr, f0 = u.pn * 128 + wc * 32 + 8 * fq;
#pragma unroll
    for (int ai = 0; ai < 2; ++ai)
#pragma unroll
      for (int m = 0; m < 4; ++m) {
        const f32x4 g0 = acc[ai][0][m][0], g1 = acc[ai][0][m][1], u0 = acc[ai][1][m][0], u1 = acc[ai][1][m][1];
        u32x4 o; o.x = pk2(silu_f(g0.x) * u0.x, silu_f(g0.y) * u0.y); o.y = pk2(silu_f(g0.z) * u0.z, silu_f(g0.w) * u0.w);
        o.z = pk2(silu_f(g1.x) * u1.x, silu_f(g1.y) * u1.y); o.w = pk2(silu_f(g1.z) * u1.z, silu_f(g1.w) * u1.w);
        *(u32x4*)(HID + (size_t)(row0 + ai * 128 + m * 16) * DM + f0) = o;
      }
  }
};
template <class Epi>
__device__ __forceinline__ void big_gemm(char* lds, const bf16_t* A, const bf16_t* Bt, int M, int N, int mpe, size_t bgroup, const Epi& E) {
  pg8::Gemm g{A, Bt, M, N, DM, mpe, bgroup};
  pg8::StaticOrder S; S.init(M, N, (int)gridDim.x, (int)blockIdx.x);
  pg8::gemm_phase<Epi, pg8::StaticOrder, true, true>((PG8_LAS unsigned char*)lds, g, S, E);
}

template <class Epi>
__device__ __forceinline__ void big_gemm_gather(char* lds, const bf16_t* A, const int* IDX, const bf16_t* Bt, int M, int N, int mpe, size_t bgroup, const Epi& E) {
  pg8::Gemm g{A, Bt, M, N, DM, mpe, bgroup};
  pg8::StaticOrder S; S.init(M, N, (int)gridDim.x, (int)blockIdx.x);
  unsigned* gtab = (unsigned*)(lds + pg8::STAGE_BYTES);
  for (int i = ltid(); i < 1024; i += NT) {
    pg8::Unit u;
    if (S.next(i >> 8, u)) { const int r = u.pm * 256 + (i & 255); gtab[i] = (unsigned)IDX[(r >> 11) * SLOTS + (r & 2047)] * (unsigned)(DM * 2); }
  }
  __syncthreads();
  pg8::gemm_phase<Epi, pg8::StaticOrder, true, true, true>((PG8_LAS unsigned char*)lds, g, S, E, (const PG8_LAS unsigned*)(lds + pg8::STAGE_BYTES));
}

template <class Op>
__device__ __forceinline__ void gemm_tile_h(const Op& op, int tile, char* lds_all) {
  const int half = ltid() >> 8;
  char* lds = lds_all + half * 65536;
  const int tid = ltid() & 255, lane = tid & 63, wid = tid >> 6, wr = wid >> 1, wc = wid & 1, fr = lane & 15, fq = lane >> 4;
  const int lrow = tid >> 3, lc = tid & 7;
  const bf16_t* ap[4]; const bf16_t* bp[4];
#pragma unroll
  for (int i = 0; i < 4; ++i) { ap[i] = op.arow(tile, lrow + 32 * i) + lc * 8 + half * 512; bp[i] = op.brow(tile, lrow + 32 * i) + lc * 8 + half * 512; }
  const int woff = lrow * 128 + ((lc ^ ((lrow >> 1) & 7)) << 4);
  char* As = lds; char* Bs = lds + 32768;
  f32x4 acc[4][4];
#pragma unroll
  for (int m = 0; m < 4; ++m)
#pragma unroll
    for (int n = 0; n < 4; ++n) acc[m][n] = (f32x4){0.f, 0.f, 0.f, 0.f};
  u32x4 ra0[4], rb0[4], ra1[4], rb1[4];
#define GT_LOAD(R, KT) do { const int k_ = (KT) < 8 ? (KT) : 7; _Pragma("unroll") for (int i = 0; i < 4; ++i) { ra##R[i] = *(const u32x4*)(ap[i] + k_ * 64); rb##R[i] = *(const u32x4*)(bp[i] + k_ * 64); } } while (0)
#define GT_STORE(R, BUF) do { const int nb_ = (BUF) * 16384; _Pragma("unroll") for (int i = 0; i < 4; ++i) { *(u32x4*)(As + nb_ + woff + i * 4096) = ra##R[i]; *(u32x4*)(Bs + nb_ + woff + i * 4096) = rb##R[i]; } } while (0)
#define GT_COMPUTE(BUF) do { const char* A_ = As + (BUF) * 16384; const char* B_ = Bs + (BUF) * 16384; \
    _Pragma("unroll") for (int ks = 0; ks < 2; ++ks) { bf16x8 af[4], bfr[4]; const int co = ((ks * 4 + fq) ^ sw) << 4; \
      _Pragma("unroll") for (int m = 0; m < 4; ++m) af[m] = *(const bf16x8*)(A_ + arow0 + m * 2048 + co); \
      _Pragma("unroll") for (int n = 0; n < 4; ++n) bfr[n] = *(const bf16x8*)(B_ + brow0 + n * 2048 + co); \
      _Pragma("unroll") for (int m = 0; m < 4; ++m) _Pragma("unroll") for (int n = 0; n < 4; ++n) acc[m][n] = __builtin_amdgcn_mfma_f32_16x16x32_bf16(bfr[n], af[m], acc[m][n], 0, 0, 0); } } while (0)
  const int sw = (fr >> 1) & 7;
  const int arow0 = (wr * 64 + fr) * 128, brow0 = (wc * 64 + fr) * 128;
  GT_LOAD(0, 0); GT_LOAD(1, 1);
  __syncthreads();
  GT_STORE(0, 0);
  GT_LOAD(0, 2);
  __syncthreads();
  for (int kt = 0; kt < 8; kt += 2) {
    GT_COMPUTE(0); GT_STORE(1, 1); GT_LOAD(1, kt + 3); __syncthreads();
    GT_COMPUTE(1); GT_STORE(0, 0); GT_LOAD(0, kt + 4); __syncthreads();
  }
#undef GT_LOAD
#undef GT_STORE
#undef GT_COMPUTE
  f32x4* red = (f32x4*)(lds_all + 65536) + tid;
  if (half == 1) {
#pragma unroll
    for (int m = 0; m < 4; ++m)
#pragma unroll
      for (int n = 0; n < 4; ++n) red[(m * 4 + n) * 256] = acc[m][n];
  }
  __syncthreads();
  if (half == 0) {
#pragma unroll
    for (int m = 0; m < 4; ++m)
#pragma unroll
      for (int n = 0; n < 4; ++n) acc[m][n] += red[(m * 4 + n) * 256];
    op.epilogue(tile, acc, wr, wc, fr, fq);
  }
}
template <class Op>
__device__ __forceinline__ void gemm_small_phase(const Op& op, char* lds) {
  for (int t = (int)gridDim.x - 1 - (int)blockIdx.x; t < op.ntiles; t += gridDim.x) gemm_tile_h(op, t, lds);
}
template <int LAYER>
struct OpInProjCtx {
  const bf16_t* A; const bf16_t* W; bf16_t* PROJ; int ntiles;
  static constexpr int NTN = (LAYER == 0) ? 23 : 16, NOFF = (LAYER == 0) ? 0 : 8;
  __device__ __forceinline__ const bf16_t* arow(int t, int i) const { return A + (size_t)(MLAT + (t / NTN) * 128 + i) * DM; }
  __device__ __forceinline__ const bf16_t* brow(int t, int i) const { return W + (size_t)((t % NTN + NOFF) * 128 + i) * DM; }
  __device__ __forceinline__ void epilogue(int t, const f32x4 (&acc)[4][4], int wr, int wc, int fr, int fq) const {
    const int row0 = MLAT + (t / NTN) * 128 + wr * 64 + fr, col0 = (t % NTN + NOFF) * 128 + wc * 64 + fq * 4;
#pragma unroll
    for (int m = 0; m < 4; ++m)
#pragma unroll
      for (int n = 0; n < 4; ++n) { const f32x4 v = acc[m][n]; u32x2 o; o.x = pk2(v.x, v.y); o.y = pk2(v.z, v.w); *(u32x2*)(PROJ + (size_t)(row0 + m * 16) * PROJ_LD + col0 + n * 16) = o; }
  }
};
struct OpOutProjCtx {
  const bf16_t* MIX; const bf16_t* W; const float* G1; float* hc; int ntiles;
  __device__ __forceinline__ const bf16_t* arow(int t, int i) const { return MIX + (size_t)(MLAT + (t >> 3) * 128 + i) * DM; }
  __device__ __forceinline__ const bf16_t* brow(int t, int i) const { return W + (size_t)((t & 7) * 128 + i) * DM; }
  __device__ __forceinline__ void epilogue(int t, const f32x4 (&acc)[4][4], int wr, int wc, int fr, int fq) const {
    const int row0 = (t >> 3) * 128 + wr * 64 + fr, col0 = (t & 7) * 128 + wc * 64 + fq * 4;
#pragma unroll
    for (int m = 0; m < 4; ++m)
#pragma unroll
      for (int n = 0; n < 4; ++n) { const int col = col0 + n * 16; float* hp = hc + (size_t)(row0 + m * 16) * DM + col; const f32x4 g = *(const f32x4*)(G1 + col); f32x4 h = *(const f32x4*)hp; h += g * acc[m][n]; *(f32x4*)hp = h; }
  }
};
__device__ __forceinline__ int gu_row(int f, int which) { return 256 * (f >> 7) + 128 * which + (f & 127); }
struct OpMoe1Ctx {
  const bf16_t* A; const bf16_t* WEXP; const int* IDX; bf16_t* HIDC; int ntiles;
  __device__ __forceinline__ const bf16_t* arow(int t, int i) const { const int e = t >> 4; const int row = (i < 64) ? IDX[e * SLOTS + 2048 + i] : MLAT; return A + (size_t)row * DM; }
  __device__ __forceinline__ const bf16_t* brow(int t, int i) const {
    const int e = t >> 4, nt = t & 15, wc = i >> 6, n = (i >> 4) & 3, fr = i & 15;
    const int f = nt * 64 + wc * 32 + (n & 1) * 16 + fr;
    return WEXP + (size_t)e * EXPW + (size_t)gu_row(f, n >> 1) * DM;
  }
  __device__ __forceinline__ void epilogue(int t, const f32x4 (&acc)[4][4], int wr, int wc, int fr, int fq) const {
    const int e = t >> 4, nt = t & 15;
    if (wr == 0) {
#pragma unroll
      for (int m = 0; m < 4; ++m) {
        const int slot = m * 16 + fr;
#pragma unroll
        for (int nn = 0; nn < 2; ++nn) {
          const f32x4 g = acc[m][nn], u = acc[m][nn + 2]; const int f = nt * 64 + wc * 32 + nn * 16 + fq * 4;
          u32x2 o; o.x = pk2(silu_f(g.x) * u.x, silu_f(g.y) * u.y); o.y = pk2(silu_f(g.z) * u.z, silu_f(g.w) * u.w);
          *(u32x2*)(HIDC + (size_t)(e * 64 + slot) * DM + f) = o;
        }
      }
    }
  }
};
struct OpMoe2Ctx {
  const bf16_t* HIDC; const bf16_t* WEXP; const float* GATEV; bf16_t* YC; int ntiles;
  __device__ __forceinline__ const bf16_t* arow(int t, int i) const { const int e = t >> 3; return HIDC + (size_t)(e * 64 + (i & 63)) * DM; }
  __device__ __forceinline__ const bf16_t* brow(int t, int i) const { const int e = t >> 3, nt = t & 7; return WEXP + (size_t)e * EXPW + (size_t)(2048 + nt * 128 + i) * DM; }
  __device__ __forceinline__ void epilogue(int t, const f32x4 (&acc)[4][4], int wr, int wc, int fr, int fq) const {
    const int e = t >> 3, nt = t & 7;
    if (wr == 0) {
#pragma unroll
      for (int m = 0; m < 4; ++m) {
        const int slot = m * 16 + fr; const float gv = GATEV[e * SLOTS + 2048 + slot];
#pragma unroll
        for (int n = 0; n < 4; ++n) { const f32x4 v = acc[m][n] * gv; u32x2 o; o.x = pk2(v.x, v.y); o.y = pk2(v.z, v.w); *(u32x2*)(YC + (size_t)(e * 64 + slot) * DM + nt * 128 + wc * 64 + n * 16 + fq * 4) = o; }
      }
    }
  }
};

__device__ __forceinline__ void transpose_item(const float* W, int N, int k0, int n0, bf16_t* dst, int drow0, float* scr, int lane) {
  f32x4 tv[8];
#pragma unroll
  for (int i = 0; i < 8; ++i) { const int kk = 8 * i + (lane >> 3); tv[i] = *(const f32x4*)(W + (size_t)(k0 + kk) * N + n0 + 4 * (lane & 7)); }
#pragma unroll
  for (int i = 0; i < 8; ++i) { const int kk = 8 * i + (lane >> 3); float* d = scr + kk * 33 + 4 * (lane & 7); d[0] = tv[i].x; d[1] = tv[i].y; d[2] = tv[i].z; d[3] = tv[i].w; }
  __builtin_amdgcn_s_waitcnt(0); __builtin_amdgcn_wave_barrier();
  const int c = lane & 7;
#pragma unroll
  for (int j = 0; j < 4; ++j) {
    const int n = (lane >> 3) + 8 * j; const float* s = scr + (8 * c) * 33 + n;
    u32x4 o; o.x = pk2(s[0], s[33]); o.y = pk2(s[66], s[99]); o.z = pk2(s[132], s[165]); o.w = pk2(s[198], s[231]);
    *(u32x4*)(dst + (size_t)(drow0 + n) * 1024 + k0 + 8 * c) = o;
  }
  __builtin_amdgcn_s_waitcnt(0); __builtin_amdgcn_wave_barrier();
}
__device__ __forceinline__ int even_col_map(int c) {
  if (c < 2048) return c;
  if (c < 2080) return 2816 + (c - 2048);
  if (c < 2592) return 2048 + (c - 2080);
  if (c < 2720) return 2560 + (c - 2592);
  return 2688 + (c - 2720);
}
__device__ __forceinline__ void convert_experts(const Params& p, int layer, char* lds, bf16_t* dstb, int it0, int it1, int gw, int ngw) {
  const int lane = ltid() & 63, wave = ltid() >> 6;
  float* scr = (float*)lds + wave * (64 * 33);
  constexpr int SPM = 16 * 8;
  for (int it = it0 + gw; it < it1; it += ngw) {
    const int mat = it / SPM, r = it % SPM, e = mat / 3, which = mat % 3;
    const float* src = (which == 0 ? p.w_gate : which == 1 ? p.w_up : p.w_down) + ((size_t)layer * 16 + e) * 1024 * 1024;
    const int k0 = (r >> 3) * 64, ns = (r & 7) * 128;
    bf16_t* dst = dstb + (size_t)e * EXPW;
    f32x4 tv[4][8];
#pragma unroll
    for (int sb = 0; sb < 4; ++sb)
#pragma unroll
      for (int i = 0; i < 8; ++i) { const int kk = 8 * i + (lane >> 3); tv[sb][i] = *(const f32x4*)(src + (size_t)(k0 + kk) * 1024 + ns + sb * 32 + 4 * (lane & 7)); }
#pragma unroll
    for (int sb = 0; sb < 4; ++sb) {
      const int n0 = ns + sb * 32;
      const int drow = (which == 2) ? 2048 + n0 : gu_row(n0, which);
#pragma unroll
      for (int i = 0; i < 8; ++i) { const int kk = 8 * i + (lane >> 3); float* d = scr + kk * 33 + 4 * (lane & 7); d[0] = tv[sb][i].x; d[1] = tv[sb][i].y; d[2] = tv[sb][i].z; d[3] = tv[sb][i].w; }
      __builtin_amdgcn_s_waitcnt(0xc07f); __builtin_amdgcn_wave_barrier();
      const int c = lane & 7;
#pragma unroll
      for (int j = 0; j < 4; ++j) {
        const int n = (lane >> 3) + 8 * j; const float* sp = scr + (8 * c) * 33 + n;
        u32x4 o; o.x = pk2(sp[0], sp[33]); o.y = pk2(sp[66], sp[99]); o.z = pk2(sp[132], sp[165]); o.w = pk2(sp[198], sp[231]);
        *(u32x4*)(dst + (size_t)(drow + n) * 1024 + k0 + 8 * c) = o;
      }
      __builtin_amdgcn_s_waitcnt(0xc07f); __builtin_amdgcn_wave_barrier();
    }
  }
}
__device__ __forceinline__ void phase0(const Params& p, char* lds) {
  const int tid = ltid(), lane = tid & 63, wave = tid >> 6;
  const int gw = blockIdx.x * NWV + wave, ngw = gridDim.x * NWV;
  const int gt = blockIdx.x * NT + tid, ngt = gridDim.x * NT;
  if (blockIdx.x == 0 && tid < 64) ((unsigned*)(p.ws + WS_CTL))[tid] = 0u;
  {
    float* rc = (float*)(p.ws + WS_ROPE); float* rs = rc + 8192 * 32;
    for (int i = gt; i < 8192 * 32; i += ngt) {
      const int t = i >> 5, f = i & 31;
      const float pos = (f < 16) ? (float)(t >> 6) : (float)(t & 63);
      const float inv = powf(10000.f, -(float)(f & 15) * (1.f / 16.f));
      float sn, cs; sincos_d(pos * inv, sn, cs);
      rc[i] = cs; rs[i] = sn;
    }
  }
  if (blockIdx.x < 192) {
    float* sv = (float*)lds;
    float* red = sv + 3072;
    for (int i = tid; i < 3072; i += NT) { const int v = i >> 10, k = i & 1023; const float cv = (v < 2) ? p.c[v * 1024 + k] : p.c_ctx[k]; sv[i] = silu_f(cv); }
    __syncthreads();
    for (int task = blockIdx.x; task < 192; task += gridDim.x) {
      const int l = task / 96, col = (task % 96) * 64 + lane;
      const float* W = p.ada_w + (size_t)l * 1024 * 6144 + col;
      float a0 = 0.f, a1 = 0.f, a2 = 0.f;
      const int kb = wave * 128;
#pragma unroll 16
      for (int k = 0; k < 128; ++k) { const float w = W[(size_t)(kb + k) * 6144]; a0 += sv[kb + k] * w; a1 += sv[1024 + kb + k] * w; a2 += sv[2048 + kb + k] * w; }
      red[(wave * 3 + 0) * 64 + lane] = a0; red[(wave * 3 + 1) * 64 + lane] = a1; red[(wave * 3 + 2) * 64 + lane] = a2;
      __syncthreads();
      if (wave < 3) {
        float s = 0.f;
#pragma unroll
        for (int w8 = 0; w8 < 8; ++w8) s += red[(w8 * 3 + wave) * 64 + lane];
        ((float*)(p.ws + WS_MOD))[(l * 3 + wave) * 6144 + col] = s + p.ada_b[l * 6144 + col];
      }
      __syncthreads();
    }
  }
  __syncthreads();
  {
    float* scr = (float*)lds + wave * (64 * 33);
    for (int it = gw; it < 16 * 89; it += ngw) { const int kb = it / 89, nb = it % 89; transpose_item(p.even_w_in, 2848, kb * 64, nb * 32, (bf16_t*)(p.ws + WS_WEI), even_col_map(nb * 32), scr, lane); }
    for (int i = gt; i < 224 * 1024 / 8; i += ngt) ((u32x4*)((bf16_t*)(p.ws + WS_WEI) + (size_t)2848 * 1024))[i] = (u32x4){0u, 0u, 0u, 0u};
    for (int it = gw; it < 16 * 32; it += ngw) transpose_item(p.even_w_out, 1024, (it / 32) * 64, (it % 32) * 32, (bf16_t*)(p.ws + WS_WEO), (it % 32) * 32, scr, lane);
    for (int it = gw; it < 16 * 96; it += ngw) transpose_item(p.odd_w_in, 3072, (it / 96) * 64, (it % 96) * 32, (bf16_t*)(p.ws + WS_WOI), (it % 96) * 32, scr, lane);
    for (int it = gw; it < 16 * 32; it += ngw) transpose_item(p.odd_w_out, 1024, (it / 32) * 64, (it % 32) * 32, (bf16_t*)(p.ws + WS_WOO), (it % 32) * 32, scr, lane);
  }
}

template <int LAYER, bool FINAL>
__device__ __forceinline__ void rowpass_a(const Params& p, char* lds) {
  const int tid = ltid(), lane = tid & 63, wave = tid >> 6;
  const int gw = blockIdx.x * NWV + wave, ngw = gridDim.x * NWV;
  const float* MOD = (const float*)(p.ws + WS_MOD);
  const int* INV = (const int*)(p.ws + WS_INV);
  const bf16_t* YL = (const bf16_t*)(p.ws + WS_YL);
  const bf16_t* YC = (const bf16_t*)(p.ws + WS_YC);
  bf16_t* A = (bf16_t*)(p.ws + WS_A);
  float* GATES = (float*)(p.ws + WS_GATES);
  float* wg = (float*)lds;
  const int nrows = FINAL ? MLAT : NR;
  auto srcrow = [&](int r) -> const float* {
    if (LAYER == 0 && !FINAL) return (r < MLAT) ? p.x + (size_t)r * DM : p.ctx + (size_t)(r - MLAT) * DM;
    return hrow_ptr(p, r);
  };
  int vcur = -1, vcur2 = -1; f32x4 mg[4], ms[4], mg2[4], fg[4];
#pragma unroll
  for (int j = 0; j < 4; ++j) { mg[j] = (f32x4){0.f, 0.f, 0.f, 0.f}; ms[j] = mg[j]; mg2[j] = mg[j]; fg[j] = FINAL ? ((const f32x4*)p.final_g)[lane + 64 * j] : mg[j]; }
  constexpr bool COMB = !(LAYER == 0 && !FINAL);
  constexpr int PL = FINAL ? 1 : (LAYER > 0 ? LAYER - 1 : 0);
  f32x4 nx[4]; int cinv = -1, ainv = -1; u32x2 ny[4][4]; float nw[4] = {0.f, 0.f, 0.f, 0.f}; unsigned nrest = 0u;
#pragma unroll
  for (int k = 0; k < 4; ++k)
#pragma unroll
    for (int j = 0; j < 4; ++j) ny[k][j] = (u32x2){0u, 0u};
  auto yptr = [&](int e, int sl) -> const bf16_t* { return (sl < 2048) ? YL + ((size_t)e * 2048 + sl) * DM : YC + ((size_t)e * 64 + (sl - 2048)) * DM; };
#define RPA_ISSUE_Y(INVREG) do { unsigned m_ = (unsigned)__ballot((INVREG) >= 0) & 0xFFFFu; const bf16_t* yp_[4]; \
    _Pragma("unroll") for (int k = 0; k < 4; ++k) { \
      if (m_) { const int e_ = __ffs(m_) - 1; m_ &= m_ - 1u; yp_[k] = yptr(e_, __builtin_amdgcn_readlane((INVREG), e_)); nw[k] = 1.f; } \
      else { yp_[k] = k ? yp_[0] : YL; nw[k] = 0.f; } } \
    nrest = m_; \
    _Pragma("unroll") for (int k = 0; k < 4; ++k) _Pragma("unroll") for (int j = 0; j < 4; ++j) ny[k][j] = *(const u32x2*)(yp_[k] + 4 * (lane + 64 * j)); } while (0)
  if (gw < nrows) {
    const float* s0 = srcrow(gw);
#pragma unroll
    for (int j = 0; j < 4; ++j) nx[j] = ((const f32x4*)s0)[lane + 64 * j];
    if (COMB) {
      cinv = INV[gw * 16 + (lane & 15)];
      const int r1 = (gw + ngw < nrows) ? gw + ngw : gw;
      ainv = INV[r1 * 16 + (lane & 15)];
      RPA_ISSUE_Y(cinv);
    }
  }
  for (int r = gw; r < nrows; r += ngw) {
    const int v = row_sel(r);
    float* hp = hrow_ptr(p, r);
    f32x4 hv[4]; u32x2 cy[4][4]; float cw[4]; const unsigned crest = nrest; const int myinv = cinv;
#pragma unroll
    for (int j = 0; j < 4; ++j) hv[j] = nx[j];
    if (COMB) {
#pragma unroll
      for (int k = 0; k < 4; ++k) { cw[k] = nw[k];
#pragma unroll
        for (int j = 0; j < 4; ++j) cy[k][j] = ny[k][j]; }
    }
    {
      const int rn = (r + ngw < nrows) ? r + ngw : r;
      const float* s1 = srcrow(rn);
#pragma unroll
      for (int j = 0; j < 4; ++j) nx[j] = ((const f32x4*)s1)[lane + 64 * j];
      if (COMB) {
        const int rn2 = (rn + ngw < nrows) ? rn + ngw : rn;
        cinv = ainv;
        RPA_ISSUE_Y(cinv);
        ainv = INV[rn2 * 16 + (lane & 15)];
      }
    }
    if (!COMB) {
#pragma unroll
      for (int j = 0; j < 4; ++j) ((f32x4*)hp)[lane + 64 * j] = hv[j];
    } else {
      f32x4 acc[4];
#pragma unroll
      for (int j = 0; j < 4; ++j) acc[j] = (f32x4){0.f, 0.f, 0.f, 0.f};
#pragma unroll
      for (int k = 0; k < 4; ++k)
#pragma unroll
        for (int j = 0; j < 4; ++j) { const u32x2 w = cy[k][j]; acc[j].x += cw[k] * bflo(w.x); acc[j].y += cw[k] * bfhi(w.x); acc[j].z += cw[k] * bflo(w.y); acc[j].w += cw[k] * bfhi(w.y); }
      for (unsigned m = crest; m; m &= m - 1u) {
        const int e = __ffs(m) - 1;
        const bf16_t* yr = yptr(e, __builtin_amdgcn_readlane(myinv, e));
#pragma unroll
        for (int j = 0; j < 4; ++j) { const u32x2 w = *(const u32x2*)(yr + 4 * (lane + 64 * j)); acc[j].x += bflo(w.x); acc[j].y += bfhi(w.x); acc[j].z += bflo(w.y); acc[j].w += bfhi(w.y); }
      }
      if (v != vcur2) {
        vcur2 = v;
        const float* g2 = MOD + (PL * 3 + v) * 6144 + 5 * 1024;
#pragma unroll
        for (int j = 0; j < 4; ++j) mg2[j] = ((const f32x4*)g2)[lane + 64 * j];
      }
#pragma unroll
      for (int j = 0; j < 4; ++j) hv[j] += mg2[j] * acc[j];
      if (!FINAL) {
#pragma unroll
        for (int j = 0; j < 4; ++j) ((f32x4*)hp)[lane + 64 * j] = hv[j];
      }
    }
#undef RPA_ISSUE_Y
    float ss = 0.f;
#pragma unroll
    for (int j = 0; j < 4; ++j) ss += hv[j].x * hv[j].x + hv[j].y * hv[j].y + hv[j].z * hv[j].z + hv[j].w * hv[j].w;
    ss = wave_sum(ss);
    const float rs = rsqrtf(ss * (1.f / DM) + EPS);
    if (FINAL) {
#pragma unroll
      for (int j = 0; j < 4; ++j) ((f32x4*)hp)[lane + 64 * j] = hv[j] * rs * fg[j];
    } else {
      if (v != vcur) {
        vcur = v;
        const float* lg = p.ln1_g + LAYER * DM;
        const float* sh = MOD + (LAYER * 3 + v) * 6144;
        const float* sc = sh + 1024;
#pragma unroll
        for (int j = 0; j < 4; ++j) { mg[j] = ((const f32x4*)lg)[lane + 64 * j] * (1.f + ((const f32x4*)sc)[lane + 64 * j]); ms[j] = ((const f32x4*)sh)[lane + 64 * j]; }
      }
#pragma unroll
      for (int j = 0; j < 4; ++j) {
        hv[j] = (hv[j] * rs) * mg[j] + ms[j];
        u32x2 o; o.x = pk2(hv[j].x, hv[j].y); o.y = pk2(hv[j].z, hv[j].w);
        *(u32x2*)(A + (size_t)r * DM + 4 * (lane + 64 * j)) = o;
      }
    }
  }
}

template <int LAYER>
__device__ __forceinline__ void rowpass_b(const Params& p, char* lds) {
  const int tid = ltid(), lane = tid & 63, wave = tid >> 6;
  const int gw = blockIdx.x * NWV + wave, ngw = gridDim.x * NWV;
  float* wt = (float*)lds;
  const float* rw = p.router_w + (size_t)LAYER * 1024 * 16;
  for (int i = tid; i < 16384; i += NT) { const int k = i >> 4, e = i & 15; wt[e * 1024 + k] = rw[i]; }
  __syncthreads();
  const float* MOD = (const float*)(p.ws + WS_MOD);
  float* AFF = (float*)(p.ws + WS_AFF);
  int* INV = (int*)(p.ws + WS_INV);
  bf16_t* A = (bf16_t*)(p.ws + WS_A);
  const int nrows = (LAYER == 0) ? NR : MLAT;
  f32x4 nx[4];
  if (gw < nrows) {
    const float* s0 = hrow_ptr(p, gw);
#pragma unroll
    for (int j = 0; j < 4; ++j) nx[j] = ((const f32x4*)s0)[lane + 64 * j];
  }
  int vcur = -1; f32x4 mg[4], ms[4];
#pragma unroll
  for (int j = 0; j < 4; ++j) { mg[j] = (f32x4){0.f, 0.f, 0.f, 0.f}; ms[j] = mg[j]; }
  for (int r = gw; r < nrows; r += ngw) {
    const int v = row_sel(r);
    f32x4 hv[4];
#pragma unroll
    for (int j = 0; j < 4; ++j) hv[j] = nx[j];
    {
      const float* s1 = hrow_ptr(p, (r + ngw < nrows) ? r + ngw : r);
#pragma unroll
      for (int j = 0; j < 4; ++j) nx[j] = ((const f32x4*)s1)[lane + 64 * j];
    }
    float ss = 0.f;
#pragma unroll
    for (int j = 0; j < 4; ++j) ss += hv[j].x * hv[j].x + hv[j].y * hv[j].y + hv[j].z * hv[j].z + hv[j].w * hv[j].w;
    ss = wave_sum(ss);
    const float rs = rsqrtf(ss * (1.f / DM) + EPS);
    if (v != vcur) {
      vcur = v;
      const float* lg = p.ln2_g + LAYER * DM;
      const float* sh = MOD + (LAYER * 3 + v) * 6144 + 3 * 1024;
      const float* sc = sh + 1024;
#pragma unroll
      for (int j = 0; j < 4; ++j) { mg[j] = ((const f32x4*)lg)[lane + 64 * j] * (1.f + ((const f32x4*)sc)[lane + 64 * j]); ms[j] = ((const f32x4*)sh)[lane + 64 * j]; }
    }
#pragma unroll
    for (int j = 0; j < 4; ++j) {
      hv[j] = (hv[j] * rs) * mg[j] + ms[j];
      u32x2 o; o.x = pk2(hv[j].x, hv[j].y); o.y = pk2(hv[j].z, hv[j].w);
      *(u32x2*)(A + (size_t)r * DM + 4 * (lane + 64 * j)) = o;
    }
    float la[16];
#pragma unroll
    for (int e = 0; e < 16; ++e) {
      float a = 0.f;
#pragma unroll
      for (int j = 0; j < 4; ++j) { const f32x4 w = *(const f32x4*)(wt + e * 1024 + 4 * (lane + 64 * j)); a += hv[j].x * w.x + hv[j].y * w.y + hv[j].z * w.z + hv[j].w * w.w; }
      la[e] = a;
      if ((e & 3) == 3) asm volatile("" ::: "memory");
    }
    const float mylog = tred16(la, lane);
    float mx = mylog;
    mx = fmaxf(mx, __shfl_xor(mx, 4)); mx = fmaxf(mx, __shfl_xor(mx, 8)); mx = fmaxf(mx, __shfl_xor(mx, 16)); mx = fmaxf(mx, __shfl_xor(mx, 32));
    const float ex = expf(mylog - mx);
    float sum = ex;
    sum += __shfl_xor(sum, 4); sum += __shfl_xor(sum, 8); sum += __shfl_xor(sum, 16); sum += __shfl_xor(sum, 32);
    const float mine = ex / sum;
    if ((lane & 3) == 0) { AFF[(size_t)(lane >> 2) * NR + r] = mine; INV[r * 16 + (lane >> 2)] = -1; }
  }
}

__device__ __forceinline__ unsigned block_incl_scan(unsigned v, unsigned* tmp, unsigned& total) {
  const int lane = ltid() & 63, wave = ltid() >> 6;
  const unsigned inc = wave_incl_scan_u(v, lane);
  __syncthreads();
  if (lane == 63) tmp[wave] = inc;
  __syncthreads();
  unsigned off = 0u, tot = 0u;
#pragma unroll
  for (int w = 0; w < 8; ++w) { const unsigned t = tmp[w]; off += (w < wave) ? t : 0u; tot += t; }
  total = tot;
  return inc + off;
}
template <int LAYER>
__device__ __forceinline__ void topk_phase(const Params& p, char* lds) {
  const int tid = ltid(), lane = tid & 63, wave = tid >> 6;
  unsigned* keys = (unsigned*)lds;
  unsigned* hist = keys + 8192;
  unsigned* misc = hist + 256;
  unsigned* tmp = misc + 8;
  int* srow = (int*)(tmp + 8);
  const float* AFF = (const float*)(p.ws + WS_AFF);
  int* INV = (int*)(p.ws + WS_INV);
  int* IDX = (int*)(p.ws + WS_IDX);
  float* GATEV = (float*)(p.ws + WS_GATEV);
  const bf16_t* A = (const bf16_t*)(p.ws + WS_A);
  bf16_t* XS = (bf16_t*)(p.ws + WS_XS);
  const int ntask = (LAYER == 0) ? 64 : 32;
  for (int task = blockIdx.x; task < ntask; task += gridDim.x) {
    const bool isctx = task >= 32;
    const int be = task & 31, b = be >> 4, e = be & 15;
    const int n = isctx ? NCTX : SEQ, cap = isctx ? 32 : 1024;
    const int base = isctx ? MLAT + b * NCTX : b * SEQ;
    const int slotbase = isctx ? 2048 + b * 32 : b * 1024;
    __syncthreads();
    for (int i = tid; i < n; i += NT) keys[i] = __float_as_uint(AFF[(size_t)e * NR + base + i]);
    if (tid == 0) { misc[0] = 0u; misc[1] = 0u; misc[2] = (unsigned)cap; }
    __syncthreads();
    for (int pass = 3; pass >= 0; --pass) {
      if (tid < 256) hist[tid] = 0u;
      __syncthreads();
      const unsigned prefix = misc[0], mask = misc[1], kk = misc[2];
      for (int i = tid; i < n; i += NT) { const unsigned k = keys[i]; if ((k & mask) == prefix) atomicAdd(&hist[(k >> (8 * pass)) & 255u], 1u); }
      __syncthreads();
      const unsigned hc = (tid < 256) ? hist[tid] : 0u;
      unsigned total; const unsigned inc = block_incl_scan(hc, tmp, total);
      const unsigned above = total - inc;
      if (tid < 256 && hc > 0u && above < kk && kk <= above + hc) { misc[0] = prefix | ((unsigned)tid << (8 * pass)); misc[1] = mask | (255u << (8 * pass)); misc[2] = kk - above; }
      __syncthreads();
    }
    const unsigned T = misc[0]; const unsigned need = misc[2];
    const unsigned ngt_total = (unsigned)cap - need;
    const int per = (n + NT - 1) / NT, i0 = tid * per;
    unsigned cg_ = 0u, ce_ = 0u;
    for (int i = 0; i < per; ++i) { if (i0 + i < n) { const unsigned k = keys[i0 + i]; cg_ += (k > T) ? 1u : 0u; ce_ += (k == T) ? 1u : 0u; } }
    unsigned tg, te;
    const unsigned ig = block_incl_scan(cg_, tmp, tg);
    const unsigned ie = block_incl_scan(ce_, tmp, te);
    unsigned og = ig - cg_, oe = ie - ce_;
    for (int i = 0; i < per; ++i) {
      if (i0 + i < n) {
        const unsigned k = keys[i0 + i]; int slot = -1;
        if (k > T) slot = (int)(og++);
        else if (k == T) { if (oe < need) slot = (int)(ngt_total + oe); ++oe; }
        if (slot >= 0) {
          const int row = base + i0 + i;
          IDX[e * SLOTS + slotbase + slot] = row; GATEV[e * SLOTS + slotbase + slot] = __uint_as_float(k); INV[(size_t)row * 16 + e] = slotbase + slot;
        }
      }
    }
  }
}
__device__ __forceinline__ void gather_phase(const Params& p) {
  const int lane = ltid() & 63, wave = ltid() >> 6;
  const int gw = blockIdx.x * NWV + wave, ngw = gridDim.x * NWV;
  const int* IDX = (const int*)(p.ws + WS_IDX);
  const bf16_t* A = (const bf16_t*)(p.ws + WS_A);
  bf16_t* XS = (bf16_t*)(p.ws + WS_XS);
  for (int s = gw * 4; s < 16 * 2048; s += ngw * 4) {
    const int e = s >> 11, sl = s & 2047;
    u32x4 v0[4], v1[4];
#pragma unroll
    for (int j = 0; j < 4; ++j) { const u32x4* src = (const u32x4*)(A + (size_t)IDX[e * SLOTS + sl + j] * DM); v0[j] = src[lane]; v1[j] = src[lane + 64]; }
#pragma unroll
    for (int j = 0; j < 4; ++j) { u32x4* dst = (u32x4*)(XS + (size_t)(s + j) * DM); dst[lane] = v0[j]; dst[lane + 64] = v1[j]; }
  }
}

__device__ __forceinline__ int cperm(int c) { return (c & 32) + 8 * ((c & 15) >> 2) + 4 * ((c >> 4) & 1) + (c & 3); }
__device__ __forceinline__ bool seq_start(int r) { return r < MLAT ? ((r & (SEQ - 1)) == 0) : (((r - MLAT) & (NCTX - 1)) == 0); }

constexpr int CONVW_OFF = 147456;
struct ConvIn { u32x4 xm[4], xl[4], xr[4]; bf16_t a_in, b_in; };
__device__ __forceinline__ void dn_conv_w(const Params& p, int h, char* lds_all) {
  const int tid = ltid();
  if (tid < 24 * 6) {
    const int sc24 = tid / 6, part = tid % 6, seg = sc24 >> 3, ch = sc24 & 7;
    *(f32x4*)(lds_all + CONVW_OFF + (sc24 * 24 + part * 4) * 4) = *(const f32x4*)(p.even_conv_w + (part >> 1) * 1536 + seg * 512 + h * 64 + ch * 8 + (part & 1) * 4);
  }
}
__device__ __forceinline__ void dn_conv_load(const Params& p, int cid, int h, ConvIn& R) {
  const int tid = ltid(), dir = tid >> 8, lt = tid & 255, lane = lt & 63;
  const bf16_t* PROJ = (const bf16_t*)(p.ws + WS_PROJ);
  const int r0 = cid * 64;
  if (lt < 192) {
    const int sc24 = lt % 24, tg = lt / 24, seg = sc24 >> 3, ch = sc24 & 7;
    const int col = seg * 512 + h * 64 + ch * 8;
#pragma unroll
    for (int k4 = 0; k4 < 4; ++k4) {
      const int i = tg + 8 * (4 * dir + k4), r = r0 + i;
      const bool hasl = !seq_start(r), hasr = (r + 1 < NR) && !seq_start(r + 1);
      R.xm[k4] = *(const u32x4*)(PROJ + (size_t)r * PROJ_LD + col);
      R.xl[k4] = *(const u32x4*)(PROJ + (size_t)(hasl ? r - 1 : r) * PROJ_LD + col);
      R.xr[k4] = *(const u32x4*)(PROJ + (size_t)(hasr ? r + 1 : r) * PROJ_LD + col);
    }
  } else {
    const int i = dir ? 63 - lane : lane;
    R.a_in = PROJ[(size_t)(r0 + i) * PROJ_LD + 2816 + dir * 16 + h]; R.b_in = PROJ[(size_t)(r0 + i) * PROJ_LD + 2816 + dir * 16 + 8 + h];
  }
}
__device__ __forceinline__ void dn_prep_task(const Params& p, int cid, int h, char* lds_all, ConvIn& R, int ncid, int nh) {
  const int tid = ltid(), dir = tid >> 8, lt = tid & 255, lane = lt & 63, wv = lt >> 6;
  char* lds = lds_all + dir * 73728;
  float* Qf = (float*)lds;
  float* Kf = Qf + 64 * 72;
  float* Vf = Kf + 64 * 72;
  char* Qb = lds + 55296;
  char* Kb = Qb + 8192;
  float* G = (float*)(lds + 71680);
  float* BE = G + 64;
  float* SC = BE + 64;
  float* MP = Qf;
  const bf16_t* PROJ = (const bf16_t*)(p.ws + WS_PROJ);
  const float* GATES = (const float*)(p.ws + WS_GATES);
  const int r0 = cid * 64;
  __syncthreads();
  if (lt < 192) {
    const int sc24 = lt % 24, tg = lt / 24, seg = sc24 >> 3, ch = sc24 & 7;
    const f32x4* cwt = (const f32x4*)(lds_all + CONVW_OFF + sc24 * 96);
    const f32x4 w0a = cwt[0], w0b = cwt[1], w1a = cwt[2], w1b = cwt[3], w2a = cwt[4], w2b = cwt[5];
    const float wl[8] = {w0a.x, w0a.y, w0a.z, w0a.w, w0b.x, w0b.y, w0b.z, w0b.w}, wm[8] = {w1a.x, w1a.y, w1a.z, w1a.w, w1b.x, w1b.y, w1b.z, w1b.w}, wr_[8] = {w2a.x, w2a.y, w2a.z, w2a.w, w2b.x, w2b.y, w2b.z, w2b.w};
    float* dbase = (float*)lds_all + seg * (64 * 72) + ch * 8;
#pragma unroll
    for (int k4 = 0; k4 < 4; ++k4) {
      const int i = tg + 8 * (4 * dir + k4), r = r0 + i;
      const bool hasl = !seq_start(r), hasr = (r + 1 < NR) && !seq_start(r + 1);
      const u32x4 z4 = (u32x4){0u, 0u, 0u, 0u};
      const u32x4 xm = R.xm[k4], xl = hasl ? R.xl[k4] : z4, xr = hasr ? R.xr[k4] : z4;
      const unsigned xmv[4] = {xm.x, xm.y, xm.z, xm.w}, xlv[4] = {xl.x, xl.y, xl.z, xl.w}, xrv[4] = {xr.x, xr.y, xr.z, xr.w};
      float y[8];
#pragma unroll
      for (int q = 0; q < 4; ++q) {
        y[2 * q] = silu_f(wl[2 * q] * bflo(xlv[q]) + wm[2 * q] * bflo(xmv[q]) + wr_[2 * q] * bflo(xrv[q]));
        y[2 * q + 1] = silu_f(wl[2 * q + 1] * bfhi(xlv[q]) + wm[2 * q + 1] * bfhi(xmv[q]) + wr_[2 * q + 1] * bfhi(xrv[q]));
      }
      float ssq = 0.f;
#pragma unroll
      for (int q = 0; q < 8; ++q) ssq += y[q] * y[q];
      ssq += __shfl_xor(ssq, 1); ssq += __shfl_xor(ssq, 2); ssq += __shfl_xor(ssq, 4);
      const float scl = seg == 2 ? 1.f : rsqrtf(ssq + EPS) * (seg == 0 ? 0.125f : 1.f);
#pragma unroll
      for (int q = 0; q < 8; ++q) y[q] *= scl;
      if (seg != 0) {
        float* dst = dbase + i * 72;
        *(f32x4*)dst = (f32x4){y[0], y[1], y[2], y[3]}; *(f32x4*)(dst + 4) = (f32x4){y[4], y[5], y[6], y[7]};
        *(f32x4*)(dst + 73728 / 4) = (f32x4){y[0], y[1], y[2], y[3]}; *(f32x4*)(dst + 73728 / 4 + 4) = (f32x4){y[4], y[5], y[6], y[7]};
      }
      if (seg != 2) {
        u32x4 w; w.x = pk2(y[0], y[1]); w.y = pk2(y[2], y[3]); w.z = pk2(y[4], y[5]); w.w = pk2(y[6], y[7]);
        char* tb = lds_all + 55296 + seg * 8192 + i * 128 + ((ch ^ ((i >> 1) & 7)) << 4);
        *(u32x4*)tb = w; *(u32x4*)(tb + 73728) = w;
        if (seg == 0) { bf16_t* QN = (bf16_t*)(p.ws + WS_QN) + (size_t)(cid * 8 + h) * 4096; *(u32x2*)(QN + i * 64 + cperm(ch * 8)) = (u32x2){w.x, w.y}; *(u32x2*)(QN + i * 64 + cperm(ch * 8 + 4)) = (u32x2){w.z, w.w}; }
      }
    }
  } else {
    const int i = dir ? 63 - lane : lane;
    const float a_in = bf1(R.a_in), b_in = bf1(R.b_in);
    float v = -__expf(p.even_a_log[dir * 8 + h]) * softplus_f(a_in + p.even_dt_bias[dir * 8 + h]);
    v = wave_incl_scan_f(v, lane);
    G[i] = v;
    BE[i] = sigmoid_f(b_in);
  }
  __syncthreads();
  if (nh != h) dn_conv_w(p, nh, lds_all);
  dn_conv_load(p, ncid, nh, R);
  {
    float* EGD = (float*)(p.ws + WS_EGDEC);
    if (lt < 64) {
      const float gl = dir ? G[0] : G[63];
      float* o = EGD + ((size_t)((cid * 8 + h) * 2 + dir)) * 128;
      o[lt] = __expf(G[lt]); o[64 + lt] = __expf(gl - G[lt]);
    }
    if (dir == 0) {
      bf16_t* KNT = (bf16_t*)(p.ws + WS_KNT) + (size_t)(cid * 8 + h) * 4096;
      for (int u = lt; u < 64 * 16; u += 256) {
        const int i = u >> 4, c4 = (u & 15) * 4;
        u32x2 o2; o2.x = pk2(Kf[c4 * 72 + i], Kf[(c4 + 1) * 72 + i]); o2.y = pk2(Kf[(c4 + 2) * 72 + i], Kf[(c4 + 3) * 72 + i]);
        *(u32x2*)(KNT + i * 64 + cperm(c4)) = o2;
      }
    }
    const int fr = lane & 15, fq = lane >> 4, sw = (fr >> 1) & 7;
    f32x4 kk[4], qk[4];
#pragma unroll
    for (int n = 0; n < 4; ++n) { kk[n] = (f32x4){0.f, 0.f, 0.f, 0.f}; qk[n] = kk[n]; }
#pragma unroll
    for (int ks = 0; ks < 2; ++ks) {
      const int co = ((ks * 4 + fq) ^ sw) << 4;
      const bf16x8 ak = *(const bf16x8*)(Kb + (16 * wv + fr) * 128 + co), aq = *(const bf16x8*)(Qb + (16 * wv + fr) * 128 + co);
#pragma unroll
      for (int n = 0; n < 4; ++n) {
        const bf16x8 bk = *(const bf16x8*)(Kb + (16 * n + fr) * 128 + co);
        kk[n] = __builtin_amdgcn_mfma_f32_16x16x32_bf16(bk, ak, kk[n], 0, 0, 0);
        qk[n] = __builtin_amdgcn_mfma_f32_16x16x32_bf16(bk, aq, qk[n], 0, 0, 0);
      }
    }
    __syncthreads();
    char* Mb = Qb;
    bf16_t* AQ = (bf16_t*)(p.ws + WS_WUA) + ((size_t)((cid * 8 + h) * 2 + dir) * 3 + 1) * 4096;
    const int i = 16 * wv + fr; const float gi = G[i], bei = BE[i];
    const int ppi = dir ? 63 - i : i;
#pragma unroll
    for (int n = 0; n < 4; ++n) {
      float v0[4], mv[4];
#pragma unroll
      for (int q = 0; q < 4; ++q) {
        const int j = 16 * n + 4 * fq + q;
        const float e0 = __expf(fminf(gi - G[j], 0.f));
        const bool inc = dir ? (j >= i) : (j <= i);
        v0[q] = inc ? qk[n][q] * e0 : 0.f;
        const bool strict = dir ? (j > i) : (j < i);
        mv[q] = strict ? bei * kk[n][q] * e0 : 0.f;
        if (strict && n == wv) { const int pq = dir ? 63 - j : j; MP[((ppi >> 2) * 64 + pq) * 4 + (ppi & 3)] = mv[q]; }
      }
      u32x2 o; o.x = pk2(v0[0], v0[1]); o.y = pk2(v0[2], v0[3]); *(u32x2*)(AQ + i * 64 + cperm(16 * n + 4 * fq)) = o;
      {
        const int pq0 = dir ? 60 - 16 * n - 4 * fq : 16 * n + 4 * fq;
        u32x2 mo; mo.x = dir ? pk2(mv[3], mv[2]) : pk2(mv[0], mv[1]); mo.y = dir ? pk2(mv[1], mv[0]) : pk2(mv[2], mv[3]);
        *(u32x2*)(Mb + ppi * 128 + (((pq0 >> 3) ^ ((ppi >> 1) & 7)) << 4) + (pq0 & 7) * 2) = mo;
      }
    }
  }
  __syncthreads();
  for (int u = lt; u < 64 * 16; u += 256) {
    const int a = u >> 4, c4 = (u & 15) * 4; const float be = BE[a], bk = be * __expf(G[a]);
    *(f32x4*)(Vf + a * 72 + c4) = *(const f32x4*)(Vf + a * 72 + c4) * be; *(f32x4*)(Kf + a * 72 + c4) = *(const f32x4*)(Kf + a * 72 + c4) * bk;
  }
  float* TL = (float*)Kb;
  {
    const int j = lane & 15, g = lane >> 4;
    const f32x4* mblk = (const f32x4*)MP + (4 * wv) * 64 + 16 * wv;
    float t[16];
#pragma unroll
    for (int i = 0; i < 16; ++i) {
      float sacc = (i == j) ? 1.f : 0.f;
#pragma unroll
      for (int k = 0; k < i; ++k) { const f32x4 m4 = mblk[(i >> 2) * 64 + k]; const float mik = (i & 3) == 0 ? m4.x : (i & 3) == 1 ? m4.y : (i & 3) == 2 ? m4.z : m4.w; sacc -= mik * t[k]; }
      t[i] = sacc;
    }
#pragma unroll
    for (int i = 0; i < 16; ++i) if ((i & 3) == g) TL[wv * 256 + i * 16 + j] = t[i];
  }
  __syncthreads();
  {
    const char* Mb = Qb;
    const int fr = lane & 15, fq = lane >> 4;
    unsigned xb[2][4][2];
#pragma unroll
    for (int I = 0; I < 4; ++I) {
      const int mrow = 16 * I + fr, msw = (mrow >> 1) & 7;
      u32x2 m0lo = (u32x2){0u, 0u}, m0hi = m0lo, m1lo = m0lo;
      if (I >= 1) m0lo = *(const u32x2*)(Mb + mrow * 128 + (((0 + (fq >> 1)) ^ msw) << 4) + (fq & 1) * 8);
      if (I >= 2) m0hi = *(const u32x2*)(Mb + mrow * 128 + (((2 + (fq >> 1)) ^ msw) << 4) + (fq & 1) * 8);
      if (I >= 3) m1lo = *(const u32x2*)(Mb + mrow * 128 + (((4 + (fq >> 1)) ^ msw) << 4) + (fq & 1) * 8);
      const f32x4 tq = *(const f32x4*)(TL + I * 256 + fr * 16 + 4 * fq);
#pragma unroll
      for (int tsel = 0; tsel < 2; ++tsel) {
        float* Xa = (tsel ? Kf : Vf) + 16 * wv + fr;
        f32x4 acc = (f32x4){0.f, 0.f, 0.f, 0.f};
        if (I >= 1) {
          const bf16x8 af = __builtin_bit_cast(bf16x8, (u32x4){m0lo.x, m0lo.y, m0hi.x, m0hi.y});
          const bf16x8 bfv = __builtin_bit_cast(bf16x8, (u32x4){xb[tsel][0][0], xb[tsel][0][1], I >= 2 ? xb[tsel][1][0] : 0u, I >= 2 ? xb[tsel][1][1] : 0u});
          acc = __builtin_amdgcn_mfma_f32_16x16x32_bf16(af, bfv, acc, 0, 0, 0);
        }
        if (I >= 3) {
          const bf16x8 af = __builtin_bit_cast(bf16x8, (u32x4){m1lo.x, m1lo.y, 0u, 0u});
          const bf16x8 bfv = __builtin_bit_cast(bf16x8, (u32x4){xb[tsel][2][0], xb[tsel][2][1], 0u, 0u});
          acc = __builtin_amdgcn_mfma_f32_16x16x32_bf16(af, bfv, acc, 0, 0, 0);
        }
        float z[4];
#pragma unroll
        for (int r4 = 0; r4 < 4; ++r4) { const int pp = 16 * I + 4 * fq + r4; z[r4] = Xa[(dir ? 63 - pp : pp) * 72]; }
        z[0] -= acc.x; z[1] -= acc.y; z[2] -= acc.z; z[3] -= acc.w;
        f32x4 x = (f32x4){0.f, 0.f, 0.f, 0.f};
        x = __builtin_amdgcn_mfma_f32_16x16x4f32(tq.x, z[0], x, 0, 0, 0);
        x = __builtin_amdgcn_mfma_f32_16x16x4f32(tq.y, z[1], x, 0, 0, 0);
        x = __builtin_amdgcn_mfma_f32_16x16x4f32(tq.z, z[2], x, 0, 0, 0);
        x = __builtin_amdgcn_mfma_f32_16x16x4f32(tq.w, z[3], x, 0, 0, 0);
        const float xv[4] = {x.x, x.y, x.z, x.w};
#pragma unroll
        for (int r4 = 0; r4 < 4; ++r4) { const int pp = 16 * I + 4 * fq + r4; Xa[(dir ? 63 - pp : pp) * 72] = xv[r4]; }
        xb[tsel][I][0] = pk2(xv[0], xv[1]); xb[tsel][I][1] = pk2(xv[2], xv[3]);
      }
    }
  }
  __syncthreads();
  {
    bf16_t* WUA = (bf16_t*)(p.ws + WS_WUA) + (size_t)((cid * 8 + h) * 2 + dir) * 3 * 4096;
    for (int u = lt; u < 64 * 16; u += 256) {
      const int i = u >> 4, c4 = (u & 15) * 4;
      const f32x4 kv = *(const f32x4*)(Kf + i * 72 + c4);
      u32x2 o; o.x = pk2(kv.x, kv.y); o.y = pk2(kv.z, kv.w);
      *(u32x2*)(WUA + i * 64 + cperm(c4)) = o;
      u32x2 o2; o2.x = pk2(Vf[c4 * 72 + i], Vf[(c4 + 1) * 72 + i]); o2.y = pk2(Vf[(c4 + 2) * 72 + i], Vf[(c4 + 3) * 72 + i]);
      *(u32x2*)(WUA + 2 * 4096 + i * 64 + 16 * ((c4 & 15) >> 2) + 4 * (c4 >> 4)) = o2;
    }
  }
}

__device__ __forceinline__ void gqa_prep_task(const Params& p, int cid, char* lds) {
  const int tid = ltid(), lane = tid & 63, wave = tid >> 6;
  const bf16_t* PROJ = (const bf16_t*)(p.ws + WS_PROJ);
  bf16_t* QB = (bf16_t*)(p.ws + WS_QB);
  bf16_t* KB = (bf16_t*)(p.ws + WS_KB);
  bf16_t* VT = (bf16_t*)(p.ws + WS_VT);
  const float* rc = (const float*)(p.ws + WS_ROPE); const float* rsn = rc + 8192 * 32;
  const int r0 = cid * 64;
  const bool isctx = r0 >= MLAT;
  const int b = isctx ? (r0 - MLAT) / NCTX : r0 / SEQ;
  const int key0 = isctx ? (r0 - MLAT) % NCTX : NCTX + (r0 % SEQ);
  bf16_t* vt_lds = (bf16_t*)lds;
  __syncthreads();
  for (int u = tid; u < 64 * 16; u += NT) {
    const int i = u >> 4, ch = u & 15;
    const u32x4 v = *(const u32x4*)(PROJ + (size_t)(r0 + i) * PROJ_LD + 2688 + ch * 8);
    unsigned* d = (unsigned*)(vt_lds + i * 130 + ch * 8);
    d[0] = v.x; d[1] = v.y; d[2] = v.z; d[3] = v.w;
  }
  for (int i = wave * 8; i < wave * 8 + 8; ++i) {
    const int r = r0 + i; const int t = r & (SEQ - 1);
    const int d0 = 8 * (lane & 7), f0 = 8 * (lane & 3);
    f32x4 c0 = (f32x4){1.f, 1.f, 1.f, 1.f}, c1 = c0, s0 = (f32x4){0.f, 0.f, 0.f, 0.f}, s1 = s0;
    if (!isctx) { c0 = *(const f32x4*)(rc + t * 32 + f0); c1 = *(const f32x4*)(rc + t * 32 + f0 + 4); s0 = *(const f32x4*)(rsn + t * 32 + f0); s1 = *(const f32x4*)(rsn + t * 32 + f0 + 4); }
    const float cs[8] = {c0.x, c0.y, c0.z, c0.w, c1.x, c1.y, c1.z, c1.w}, sn[8] = {s0.x, s0.y, s0.z, s0.w, s1.x, s1.y, s1.z, s1.w};
    const bool lowhalf = (lane & 7) < 4;
#pragma unroll
    for (int pass = 0; pass < 2; ++pass) {
      const int lsrc = pass == 0 ? lane : (lane & 15);
      const u32x4 raw = *(const u32x4*)(PROJ + (size_t)r * PROJ_LD + (pass == 0 ? 2048 : 2560) + lsrc * 8);
      float xv[8] = {bflo(raw.x), bfhi(raw.x), bflo(raw.y), bfhi(raw.y), bflo(raw.z), bfhi(raw.z), bflo(raw.w), bfhi(raw.w)};
      float ss = 0.f;
#pragma unroll
      for (int q = 0; q < 8; ++q) ss += xv[q] * xv[q];
      ss += __shfl_xor(ss, 1); ss += __shfl_xor(ss, 2); ss += __shfl_xor(ss, 4);
      const float rs = rsqrtf(ss * (1.f / 64.f) + EPS) * (pass == 0 ? 0.125f * LOG2E : 1.f);
      const float* g = (pass == 0 ? p.even_q_norm_g : p.even_k_norm_g) + d0;
      float o[8];
#pragma unroll
      for (int q = 0; q < 8; ++q) {
        const float mine = xv[q] * rs * g[q];
        const float other = __shfl_xor(mine, 4);
        o[q] = lowhalf ? (mine * cs[q] - other * sn[q]) : (other * sn[q] + mine * cs[q]);
      }
      u32x4 w; w.x = pk2(o[0], o[1]); w.y = pk2(o[2], o[3]); w.z = pk2(o[4], o[5]); w.w = pk2(o[6], o[7]);
      if (pass == 0) *(u32x4*)(QB + (size_t)r * 512 + lane * 8) = w;
      else if (lane < 16) *(u32x4*)(KB + ((size_t)(b * 2 + (lane >> 3)) * NKEY + key0 + i) * 64 + d0) = w;
    }
  }
  __syncthreads();
  {
    const int d = tid >> 2, kh = (tid & 3) * 16;
    bf16_t* dst = VT + ((size_t)(b * 2 + (d >> 6)) * 64 + (d & 63)) * NKEY + key0 + kh;
#pragma unroll
    for (int c8 = 0; c8 < 2; ++c8) {
      unsigned w[4];
#pragma unroll
      for (int q = 0; q < 4; ++q) { const unsigned lo = vt_lds[(kh + c8 * 8 + 2 * q) * 130 + d], hi = vt_lds[(kh + c8 * 8 + 2 * q + 1) * 130 + d]; w[q] = lo | (hi << 16); }
      *(u32x4*)(dst + c8 * 8) = (u32x4){w[0], w[1], w[2], w[3]};
    }
  }
}
__device__ __forceinline__ void prep_even(const Params& p, char* lds) {
  {
    ConvIn R;
    int t = blockIdx.x;
    __syncthreads();
    dn_conv_w(p, t & 7, lds);
    dn_conv_load(p, (t < NCHUNK * 8) ? t >> 3 : 0, t & 7, R);
    for (; t < NCHUNK * 8; t += gridDim.x) {
      const int tn = (t + (int)gridDim.x < NCHUNK * 8) ? t + (int)gridDim.x : t;
      dn_prep_task(p, t >> 3, t & 7, lds, R, tn >> 3, tn & 7);
    }
  }
  const int nb = (NCHUNK * 8) % (int)gridDim.x;
  if ((int)blockIdx.x >= nb) for (int g = (int)blockIdx.x - nb; g < NCHUNK; g += (int)gridDim.x - nb) gqa_prep_task(p, g, lds);
}

__device__ __forceinline__ bf16x8 ldfrag136(const char* tile, int row, int s, int q) {
  const char* a = tile + row * 136 + (32 * s + 4 * q) * 2;
  const u32x2 lo = *(const u32x2*)a, hi = *(const u32x2*)(a + 32);
  return __builtin_bit_cast(bf16x8, (u32x4){lo.x, lo.y, hi.x, hi.y});
}
__device__ __forceinline__ bf16x8 pack_acc2(const f32x4& a, const f32x4& b) {
  return __builtin_bit_cast(bf16x8, (u32x4){pk2(a.x, a.y), pk2(a.z, a.w), pk2(b.x, b.y), pk2(b.z, b.w)});
}
#define SCAN_LOAD(B, ST) do { const int cid_ = step_cid(ST); const size_t cd_ = (size_t)((cid_ * 8 + h) * 2 + dir); const bf16_t* wua_ = WUA + cd_ * 3 * 4096; \
    _Pragma("unroll") for (int mt = 0; mt < 4; ++mt) _Pragma("unroll") for (int s2 = 0; s2 < 2; ++s2) Wf##B[mt][s2] = *(const bf16x8*)(wua_ + foff + mt * 1024 + s2 * 32); \
    Uf##B[0] = *(const u32x4*)(wua_ + 8192 + uoff); Uf##B[1] = *(const u32x4*)(wua_ + 8192 + uoff + 8); } while (0)
#define SCAN_LOADK(ST) do { const int cid_ = step_cid(ST); const size_t cd_ = (size_t)((cid_ * 8 + h) * 2 + dir); const bf16_t* kn_ = KNT + (size_t)(cid_ * 8 + h) * 4096; const float* eg_ = EGD + cd_ * 128; \
    _Pragma("unroll") for (int mt = 0; mt < 4; ++mt) _Pragma("unroll") for (int s2 = 0; s2 < 2; ++s2) Kf[mt][s2] = *(const bf16x8*)(kn_ + foff + mt * 1024 + s2 * 32); \
    _Pragma("unroll") for (int mt = 0; mt < 4; ++mt) dc[mt] = *(const f32x4*)(eg_ + 64 + 16 * mt + 4 * q); \
    gl = eg_[dir ? 0 : 63]; } while (0)
#define SCAN_STEP(B, ST) do { const int cid_ = step_cid(ST); const size_t cd_ = (size_t)((cid_ * 8 + h) * 2 + dir); \
    const u32x4 sa_ = (u32x4){pk2(S[0].x, S[0].y), pk2(S[0].z, S[0].w), pk2(S[1].x, S[1].y), pk2(S[1].z, S[1].w)}, sb_ = (u32x4){pk2(S[2].x, S[2].y), pk2(S[2].z, S[2].w), pk2(S[3].x, S[3].y), pk2(S[3].z, S[3].w)}; \
    *(u32x4*)(SC + cd_ * 4096 + uoff) = sa_; *(u32x4*)(SC + cd_ * 4096 + uoff + 8) = sb_; \
    const bf16x8 bS0_ = __builtin_bit_cast(bf16x8, sa_), bS1_ = __builtin_bit_cast(bf16x8, sb_); \
    const unsigned uw_[8] = {Uf##B[0].x, Uf##B[0].y, Uf##B[0].z, Uf##B[0].w, Uf##B[1].x, Uf##B[1].y, Uf##B[1].z, Uf##B[1].w}; \
    f32x4 vn_[4]; \
    _Pragma("unroll") for (int mt = 0; mt < 4; ++mt) { f32x4 pacc_ = (f32x4){0.f, 0.f, 0.f, 0.f}; \
      pacc_ = __builtin_amdgcn_mfma_f32_16x16x32_bf16(Wf##B[mt][0], bS0_, pacc_, 0, 0, 0); pacc_ = __builtin_amdgcn_mfma_f32_16x16x32_bf16(Wf##B[mt][1], bS1_, pacc_, 0, 0, 0); \
      vn_[mt] = (f32x4){bflo(uw_[2 * mt]), bfhi(uw_[2 * mt]), bflo(uw_[2 * mt + 1]), bfhi(uw_[2 * mt + 1])} - pacc_; } \
    SCAN_LOAD(B, (ST) + 2); \
    const u32x4 va_ = (u32x4){pk2(vn_[0].x, vn_[0].y), pk2(vn_[0].z, vn_[0].w), pk2(vn_[1].x, vn_[1].y), pk2(vn_[1].z, vn_[1].w)}, vb_ = (u32x4){pk2(vn_[2].x, vn_[2].y), pk2(vn_[2].z, vn_[2].w), pk2(vn_[3].x, vn_[3].y), pk2(vn_[3].z, vn_[3].w)}; \
    bf16_t* ut_ = (bf16_t*)WUA + cd_ * 3 * 4096 + 8192 + uoff; *(u32x4*)ut_ = va_; *(u32x4*)(ut_ + 8) = vb_; \
    const bf16x8 bD0_ = pack_acc2(vn_[0] * dc[0], vn_[1] * dc[1]), bD1_ = pack_acc2(vn_[2] * dc[2], vn_[3] * dc[3]); \
    _Pragma("unroll") for (int t = 0; t < 4; ++t) { f32x4 sacc_ = S[t] * gl; \
      sacc_ = __builtin_amdgcn_mfma_f32_16x16x32_bf16(Kf[t][0], bD0_, sacc_, 0, 0, 0); sacc_ = __builtin_amdgcn_mfma_f32_16x16x32_bf16(Kf[t][1], bD1_, sacc_, 0, 0, 0); S[t] = sacc_; } \
    SCAN_LOADK((ST) + 1); } while (0)
__device__ __forceinline__ void scan_wave(const Params& p, int task) {
  const int lane = ltid() & 63, c = lane & 15, q = lane >> 4;
  const int w = task & 3, dir = (task >> 2) & 1, h = (task >> 3) & 7, b = task >> 6;
  const bf16_t* KNT = (const bf16_t*)(p.ws + WS_KNT);
  const bf16_t* WUA = (const bf16_t*)(p.ws + WS_WUA);
  const float* EGD = (const float*)(p.ws + WS_EGDEC);
  bf16_t* SC = (bf16_t*)(p.ws + WS_A);
  const int foff = c * 64 + 8 * q;
  const int uoff = (16 * w + c) * 64 + 16 * q;
  auto step_cid = [&](int st) -> int {
    if (st >= 132) st = 131;
    if (st < 4) return 256 + b * 4 + (dir ? 3 - st : st);
    const int cc = st - 4; return b * 128 + (dir ? 127 - cc : cc);
  };
  f32x4 S[4];
#pragma unroll
  for (int t = 0; t < 4; ++t) S[t] = (f32x4){0.f, 0.f, 0.f, 0.f};
  bf16x8 Wf0[4][2], Wf1[4][2], Kf[4][2]; u32x4 Uf0[2], Uf1[2]; f32x4 dc[4]; float gl;
  SCAN_LOAD(0, 0); SCAN_LOAD(1, 1); SCAN_LOADK(0);
  for (int st = 0; st < 132; st += 2) {
    SCAN_STEP(0, st);
    SCAN_STEP(1, st + 1);
  }
}

struct AttnState { f32x16 o0, o1; float m, l; };
__device__ __forceinline__ void attn_scores(const char* Kt, const bf16x8 (&qf)[4], int r32, int hh, f32x16& s0, f32x16& s1) {
  const int sw = (r32 >> 1) & 7;
#pragma unroll
  for (int s = 0; s < 4; ++s) {
    const int co = ((2 * s + hh) ^ sw) << 4;
    const bf16x8 k0 = *(const bf16x8*)(Kt + r32 * 128 + co);
    const bf16x8 k1 = *(const bf16x8*)(Kt + (32 + r32) * 128 + co);
    s0 = __builtin_amdgcn_mfma_f32_32x32x16_bf16(k0, qf[s], s0, 0, 0, 0);
    s1 = __builtin_amdgcn_mfma_f32_32x32x16_bf16(k1, qf[s], s1, 0, 0, 0);
  }
}
__device__ __forceinline__ void attn_update(AttnState& st, f32x16& s0, f32x16& s1, const char* Vt, int r32, int hh) {
  float mx = s0[0];
#pragma unroll
  for (int i = 1; i < 16; ++i) mx = fmaxf(mx, s0[i]);
#pragma unroll
  for (int i = 0; i < 16; ++i) mx = fmaxf(mx, s1[i]);
  mx = fmaxf(mx, __shfl_xor(mx, 32));
  const float mnew = fmaxf(st.m, mx);
  const float alpha = __builtin_amdgcn_exp2f(st.m - mnew);
  st.m = mnew;
  float ls = 0.f;
#pragma unroll
  for (int i = 0; i < 16; ++i) { s0[i] = __builtin_amdgcn_exp2f(s0[i] - mnew); ls += s0[i]; }
#pragma unroll
  for (int i = 0; i < 16; ++i) { s1[i] = __builtin_amdgcn_exp2f(s1[i] - mnew); ls += s1[i]; }
  st.l = st.l * alpha + ls;
  st.o0 *= alpha; st.o1 *= alpha;
  bf16x8 pf[2][2];
#pragma unroll
  for (int sp = 0; sp < 2; ++sp) {
    pf[0][sp] = __builtin_bit_cast(bf16x8, (u32x4){pk2(s0[8 * sp], s0[8 * sp + 1]), pk2(s0[8 * sp + 2], s0[8 * sp + 3]), pk2(s0[8 * sp + 4], s0[8 * sp + 5]), pk2(s0[8 * sp + 6], s0[8 * sp + 7])});
    pf[1][sp] = __builtin_bit_cast(bf16x8, (u32x4){pk2(s1[8 * sp], s1[8 * sp + 1]), pk2(s1[8 * sp + 2], s1[8 * sp + 3]), pk2(s1[8 * sp + 4], s1[8 * sp + 5]), pk2(s1[8 * sp + 6], s1[8 * sp + 7])});
  }
#pragma unroll
  for (int u = 0; u < 2; ++u)
#pragma unroll
    for (int sp = 0; sp < 2; ++sp) {
      const int ko = (32 * u + 16 * sp + 4 * hh) * 2;
      const char* a0 = Vt + r32 * 136 + ko; const char* a1 = Vt + (32 + r32) * 136 + ko;
      const u32x2 x0 = *(const u32x2*)a0, x1 = *(const u32x2*)(a0 + 16), y0 = *(const u32x2*)a1, y1 = *(const u32x2*)(a1 + 16);
      const bf16x8 v0 = __builtin_bit_cast(bf16x8, (u32x4){x0.x, x0.y, x1.x, x1.y}), v1 = __builtin_bit_cast(bf16x8, (u32x4){y0.x, y0.y, y1.x, y1.y});
      st.o0 = __builtin_amdgcn_mfma_f32_32x32x16_bf16(v0, pf[u][sp], st.o0, 0, 0, 0);
      st.o1 = __builtin_amdgcn_mfma_f32_32x32x16_bf16(v1, pf[u][sp], st.o1, 0, 0, 0);
    }
}
__device__ __forceinline__ void attn_update_bounded(AttnState& st, f32x16& s0, f32x16& s1, const char* Vt, int r32, int hh) {
  float ls = 0.f;
#pragma unroll
  for (int i = 0; i < 16; ++i) { s0[i] = __builtin_amdgcn_exp2f(s0[i]); ls += s0[i]; }
#pragma unroll
  for (int i = 0; i < 16; ++i) { s1[i] = __builtin_amdgcn_exp2f(s1[i]); ls += s1[i]; }
  st.l += ls;
  bf16x8 pf[2][2];
#pragma unroll
  for (int sp = 0; sp < 2; ++sp) {
    pf[0][sp] = __builtin_bit_cast(bf16x8, (u32x4){pk2(s0[8 * sp], s0[8 * sp + 1]), pk2(s0[8 * sp + 2], s0[8 * sp + 3]), pk2(s0[8 * sp + 4], s0[8 * sp + 5]), pk2(s0[8 * sp + 6], s0[8 * sp + 7])});
    pf[1][sp] = __builtin_bit_cast(bf16x8, (u32x4){pk2(s1[8 * sp], s1[8 * sp + 1]), pk2(s1[8 * sp + 2], s1[8 * sp + 3]), pk2(s1[8 * sp + 4], s1[8 * sp + 5]), pk2(s1[8 * sp + 6], s1[8 * sp + 7])});
  }
#pragma unroll
  for (int u = 0; u < 2; ++u)
#pragma unroll
    for (int sp = 0; sp < 2; ++sp) {
      const int ko = (32 * u + 16 * sp + 4 * hh) * 2;
      const char* a0 = Vt + r32 * 136 + ko; const char* a1 = Vt + (32 + r32) * 136 + ko;
      const u32x2 x0 = *(const u32x2*)a0, x1 = *(const u32x2*)(a0 + 16), y0 = *(const u32x2*)a1, y1 = *(const u32x2*)(a1 + 16);
      const bf16x8 v0 = __builtin_bit_cast(bf16x8, (u32x4){x0.x, x0.y, x1.x, x1.y}), v1 = __builtin_bit_cast(bf16x8, (u32x4){y0.x, y0.y, y1.x, y1.y});
      st.o0 = __builtin_amdgcn_mfma_f32_32x32x16_bf16(v0, pf[u][sp], st.o0, 0, 0, 0);
      st.o1 = __builtin_amdgcn_mfma_f32_32x32x16_bf16(v1, pf[u][sp], st.o1, 0, 0, 0);
    }
}
__device__ __forceinline__ void attn_tile_bounded(AttnState& st, const f32x16& negsh, const char* Kt, const char* Vt, const bf16x8 (&qf)[4], int r32, int hh) {
  const int sw = (r32 >> 1) & 7;
  bf16x8 kf[8];
#pragma unroll
  for (int s = 0; s < 4; ++s) { const int co = ((2 * s + hh) ^ sw) << 4; kf[2 * s] = *(const bf16x8*)(Kt + r32 * 128 + co); kf[2 * s + 1] = *(const bf16x8*)(Kt + (32 + r32) * 128 + co); }
  __builtin_amdgcn_sched_barrier(0);
  f32x16 s0 = negsh, s1 = negsh;
#pragma unroll
  for (int s = 0; s < 4; ++s) { s0 = __builtin_amdgcn_mfma_f32_32x32x16_bf16(kf[2 * s], qf[s], s0, 0, 0, 0); s1 = __builtin_amdgcn_mfma_f32_32x32x16_bf16(kf[2 * s + 1], qf[s], s1, 0, 0, 0); }
  bf16x8 vf[2][2][2];
#pragma unroll
  for (int u = 0; u < 2; ++u)
#pragma unroll
    for (int sp = 0; sp < 2; ++sp) {
      const int ko = (32 * u + 16 * sp + 4 * hh) * 2;
      const char* a0 = Vt + r32 * 136 + ko; const char* a1 = Vt + (32 + r32) * 136 + ko;
      const u32x2 x0 = *(const u32x2*)a0, x1 = *(const u32x2*)(a0 + 16), y0 = *(const u32x2*)a1, y1 = *(const u32x2*)(a1 + 16);
      vf[u][sp][0] = __builtin_bit_cast(bf16x8, (u32x4){x0.x, x0.y, x1.x, x1.y}); vf[u][sp][1] = __builtin_bit_cast(bf16x8, (u32x4){y0.x, y0.y, y1.x, y1.y});
    }
  __builtin_amdgcn_sched_barrier(0);
  float ls = 0.f;
#pragma unroll
  for (int i = 0; i < 16; ++i) { s0[i] = __builtin_amdgcn_exp2f(s0[i]); ls += s0[i]; }
#pragma unroll
  for (int i = 0; i < 16; ++i) { s1[i] = __builtin_amdgcn_exp2f(s1[i]); ls += s1[i]; }
  st.l += ls;
  bf16x8 pf[2][2];
#pragma unroll
  for (int sp = 0; sp < 2; ++sp) {
    pf[0][sp] = __builtin_bit_cast(bf16x8, (u32x4){pk2(s0[8 * sp], s0[8 * sp + 1]), pk2(s0[8 * sp + 2], s0[8 * sp + 3]), pk2(s0[8 * sp + 4], s0[8 * sp + 5]), pk2(s0[8 * sp + 6], s0[8 * sp + 7])});
    pf[1][sp] = __builtin_bit_cast(bf16x8, (u32x4){pk2(s1[8 * sp], s1[8 * sp + 1]), pk2(s1[8 * sp + 2], s1[8 * sp + 3]), pk2(s1[8 * sp + 4], s1[8 * sp + 5]), pk2(s1[8 * sp + 6], s1[8 * sp + 7])});
  }
#pragma unroll
  for (int u = 0; u < 2; ++u)
#pragma unroll
    for (int sp = 0; sp < 2; ++sp) {
      st.o0 = __builtin_amdgcn_mfma_f32_32x32x16_bf16(vf[u][sp][0], pf[u][sp], st.o0, 0, 0, 0);
      st.o1 = __builtin_amdgcn_mfma_f32_32x32x16_bf16(vf[u][sp][1], pf[u][sp], st.o1, 0, 0, 0);
    }
}
__device__ __forceinline__ void attn_tile_pipe(AttnState& st, f32x16& sc0, f32x16& sc1, float nsh, const char* Kn, const char* Vc, const bf16x8 (&qf)[4], int r32, int hh) {
  const int sw = (r32 >> 1) & 7;
  bf16x8 kf[8];
#pragma unroll
  for (int s = 0; s < 4; ++s) { const int co = ((2 * s + hh) ^ sw) << 4; kf[2 * s] = *(const bf16x8*)(Kn + r32 * 128 + co); kf[2 * s + 1] = *(const bf16x8*)(Kn + (32 + r32) * 128 + co); }
  f32x16 n0, n1;
#pragma unroll
  for (int i = 0; i < 16; ++i) { n0[i] = nsh; n1[i] = nsh; }
  __builtin_amdgcn_sched_barrier(0);
  float ls = 0.f;
#pragma unroll
  for (int s = 0; s < 4; ++s) {
    n0 = __builtin_amdgcn_mfma_f32_32x32x16_bf16(kf[2 * s], qf[s], n0, 0, 0, 0);
    __builtin_amdgcn_sched_barrier(0);
#pragma unroll
    for (int i = 4 * s; i < 4 * s + 4; ++i) { sc0[i] = __builtin_amdgcn_exp2f(sc0[i]); ls += sc0[i]; }
    __builtin_amdgcn_sched_barrier(0);
    n1 = __builtin_amdgcn_mfma_f32_32x32x16_bf16(kf[2 * s + 1], qf[s], n1, 0, 0, 0);
    __builtin_amdgcn_sched_barrier(0);
#pragma unroll
    for (int i = 4 * s; i < 4 * s + 4; ++i) { sc1[i] = __builtin_amdgcn_exp2f(sc1[i]); ls += sc1[i]; }
    __builtin_amdgcn_sched_barrier(0);
  }
  st.l += ls;
  bf16x8 vf[2][2][2];
#pragma unroll
  for (int u = 0; u < 2; ++u)
#pragma unroll
    for (int sp = 0; sp < 2; ++sp) {
      const int ko = (32 * u + 16 * sp + 4 * hh) * 2;
      const char* a0 = Vc + r32 * 136 + ko; const char* a1 = Vc + (32 + r32) * 136 + ko;
      const u32x2 x0 = *(const u32x2*)a0, x1 = *(const u32x2*)(a0 + 16), y0 = *(const u32x2*)a1, y1 = *(const u32x2*)(a1 + 16);
      vf[u][sp][0] = __builtin_bit_cast(bf16x8, (u32x4){x0.x, x0.y, x1.x, x1.y}); vf[u][sp][1] = __builtin_bit_cast(bf16x8, (u32x4){y0.x, y0.y, y1.x, y1.y});
    }
#pragma unroll
  for (int u = 0; u < 2; ++u)
#pragma unroll
    for (int sp = 0; sp < 2; ++sp) {
      const f32x16& sc = u ? sc1 : sc0;
      const bf16x8 pf = __builtin_bit_cast(bf16x8, (u32x4){pk2(sc[8 * sp], sc[8 * sp + 1]), pk2(sc[8 * sp + 2], sc[8 * sp + 3]), pk2(sc[8 * sp + 4], sc[8 * sp + 5]), pk2(sc[8 * sp + 6], sc[8 * sp + 7])});
      st.o0 = __builtin_amdgcn_mfma_f32_32x32x16_bf16(vf[u][sp][0], pf, st.o0, 0, 0, 0);
      st.o1 = __builtin_amdgcn_mfma_f32_32x32x16_bf16(vf[u][sp][1], pf, st.o1, 0, 0, 0);
    }
  sc0 = n0; sc1 = n1;
}
__device__ __forceinline__ void attn_store(const AttnState& st, bf16_t* orow, int hh) {
  const float l = st.l + __shfl_xor(st.l, 32);
  const float il = 1.f / l;
#pragma unroll
  for (int g = 0; g < 4; ++g) {
    u32x2 a; a.x = pk2(st.o0[4 * g] * il, st.o0[4 * g + 1] * il); a.y = pk2(st.o0[4 * g + 2] * il, st.o0[4 * g + 3] * il);
    *(u32x2*)(orow + 8 * g + 4 * hh) = a;
    u32x2 bq; bq.x = pk2(st.o1[4 * g] * il, st.o1[4 * g + 1] * il); bq.y = pk2(st.o1[4 * g + 2] * il, st.o1[4 * g + 3] * il);
    *(u32x2*)(orow + 32 + 8 * g + 4 * hh) = bq;
  }
}

__device__ __forceinline__ void gqa_item(const Params& p, int item, char* lds) {
  const int tid = ltid(), lane = tid & 63, w = tid >> 6, r32 = lane & 31, hh = lane >> 5;
  const bf16_t* QB = (const bf16_t*)(p.ws + WS_QB);
  const bf16_t* KB = (const bf16_t*)(p.ws + WS_KB);
  const bf16_t* VT = (const bf16_t*)(p.ws + WS_VT);
  bf16_t* MIX = (bf16_t*)(p.ws + WS_MIX);
  int b, hkv, row0, ntile, t0; const int khalf = item & 1;
  { const int it2 = item >> 1;
    if (it2 < 512) { b = it2 >> 8; hkv = (it2 >> 7) & 1; row0 = b * SEQ + (it2 & 127) * 64; ntile = NKEY / 128; t0 = khalf * ntile; }
    else { const int it = it2 - 512; b = it >> 3; hkv = (it >> 2) & 1; row0 = MLAT + b * NCTX + (it & 3) * 64; ntile = NCTX / 128; t0 = khalf * ntile; } }
  const int qh = hkv * 4 + (w & 3);
  const int qrow = row0 + 32 * (w >> 2) + r32;
  const bf16_t* kb = KB + (size_t)(b * 2 + hkv) * NKEY * 64;
  const bf16_t* vt = VT + (size_t)(b * 2 + hkv) * 64 * NKEY;
  bf16x8 qf[4];
#pragma unroll
  for (int s = 0; s < 4; ++s) qf[s] = *(const bf16x8*)(QB + (size_t)qrow * 512 + qh * 64 + 16 * s + 8 * hh);
  AttnState st; st.o0 = (f32x16){}; st.o1 = (f32x16){}; st.m = 0.f; st.l = 0.f;
  float gq = fabsf(p.even_q_norm_g[lane]), gk = fabsf(p.even_k_norm_g[lane]);
#pragma unroll
  for (int o = 1; o < 64; o <<= 1) { gq = fmaxf(gq, __shfl_xor(gq, o)); gk = fmaxf(gk, __shfl_xor(gk, o)); }
  const float nsh = __builtin_amdgcn_readfirstlane(-(8.f * gq * gk * LOG2E * 1.02f));
  char* Kt = lds; char* Vt = lds + 24576;
  const int lrow = tid >> 3, lch = tid & 7;
  const int tend = t0 + ntile - 1;
  u32x4 rk0, rk1, rv0, rv1;
#define GQA_GK(R, T) do { int t_ = (T); t_ = t_ < tend ? t_ : tend; rk##R = *(const u32x4*)(kb + (size_t)t_ * 4096 + tid * 8); } while (0)
#define GQA_GV(R, T) do { int t_ = (T); t_ = t_ < tend ? t_ : tend; rv##R = *(const u32x4*)(vt + (size_t)lrow * NKEY + t_ * 64 + lch * 8); } while (0)
#define GQA_SK(R, SLOT) do { *(u32x4*)(Kt + (SLOT) * 8192 + lrow * 128 + ((lch ^ ((lrow >> 1) & 7)) << 4)) = rk##R; } while (0)
#define GQA_SV(R, SLOT) do { char* d_ = Vt + (SLOT) * 8704 + lrow * 136 + lch * 16; *(u32x2*)d_ = (u32x2){rv##R.x, rv##R.y}; *(u32x2*)(d_ + 8) = (u32x2){rv##R.z, rv##R.w}; } while (0)
  __syncthreads();
  GQA_GK(0, t0); GQA_GK(1, t0 + 1); GQA_GV(0, t0);
  GQA_SK(0, 0); GQA_SK(1, 1); GQA_SV(0, 0);
  GQA_GK(0, t0 + 2); GQA_GV(1, t0 + 1);
  __syncthreads();
  f32x16 sc0, sc1;
#pragma unroll
  for (int i = 0; i < 16; ++i) { sc0[i] = nsh; sc1[i] = nsh; }
  {
    const int sw = (r32 >> 1) & 7;
#pragma unroll
    for (int s2 = 0; s2 < 4; ++s2) {
      const int co = ((2 * s2 + hh) ^ sw) << 4;
      sc0 = __builtin_amdgcn_mfma_f32_32x32x16_bf16(*(const bf16x8*)(Kt + r32 * 128 + co), qf[s2], sc0, 0, 0, 0);
      sc1 = __builtin_amdgcn_mfma_f32_32x32x16_bf16(*(const bf16x8*)(Kt + (32 + r32) * 128 + co), qf[s2], sc1, 0, 0, 0);
    }
  }
  int k1 = 1, k2 = 2, k0 = 0;
  for (int t = 0; t < ntile; t += 2) {
    GQA_GK(1, t0 + t + 3); GQA_GV(0, t0 + t + 2);
    attn_tile_pipe(st, sc0, sc1, nsh, Kt + k1 * 8192, Vt + k0 * 8704, qf, r32, hh);
    GQA_SK(0, k2); GQA_SV(1, k1);
    __syncthreads();
    GQA_GK(0, t0 + t + 4); GQA_GV(1, t0 + t + 3);
    attn_tile_pipe(st, sc0, sc1, nsh, Kt + k2 * 8192, Vt + k1 * 8704, qf, r32, hh);
    GQA_SK(1, k0); GQA_SV(0, k2);
    __syncthreads();
    const int tk = k0; k0 = k2; k2 = k1; k1 = tk;
  }
#undef GQA_GK
#undef GQA_GV
#undef GQA_SK
#undef GQA_SV
  {
    const float l = st.l + __shfl_xor(st.l, 32);
    if (hh == 0) ((float*)(p.ws + WS_AFF))[((size_t)khalf * NR + qrow) * 8 + qh] = l;
    st.l = 0.5f;
    attn_store(st, khalf ? MIX + (size_t)qrow * DM + 512 + qh * 64 : (bf16_t*)(p.ws + WS_O1) + (size_t)qrow * 512 + qh * 64, hh);
  }
}

__device__ __forceinline__ void mix_even(const Params& p, char* lds) {
  unsigned* ctr = (unsigned*)(p.ws + WS_CTL);
  int* sh_item = (int*)(lds + 100000);
  if (blockIdx.x < 64) {
    if ((ltid() >> 6) < 2) scan_wave(p, blockIdx.x * 2 + (ltid() >> 6));
    else convert_experts(p, 0, lds, (bf16_t*)(p.ws + WS_WEXP), 0, 16 * 3 * 128, (int)blockIdx.x * 6 + (ltid() >> 6) - 2, 64 * 6);
  }
  for (;;) {
    __syncthreads();
    if (ltid() == 0) *sh_item = (int)atomicAdd(ctr, 1u);
    __syncthreads();
    const int item = *sh_item;
    if (item >= 2 * (512 + 16)) break;
    gqa_item(p, item, lds);
  }
}

__device__ __forceinline__ void gate_phase(const Params& p) {
  const int lane = ltid() & 63, wave = ltid() >> 6, c = lane & 15, q = lane >> 4;
  const int gw = blockIdx.x * NWV + wave, ngw = gridDim.x * NWV;
  bf16_t* MIX = (bf16_t*)(p.ws + WS_MIX);
  const bf16_t* PROJ = (const bf16_t*)(p.ws + WS_PROJ);
  const bf16_t* QN = (const bf16_t*)(p.ws + WS_QN);
  const bf16_t* WUA = (const bf16_t*)(p.ws + WS_WUA);
  const bf16_t* SC = (const bf16_t*)(p.ws + WS_A);
  const float* EGD = (const float*)(p.ws + WS_EGDEC);
  {
    const bf16_t* O1 = (const bf16_t*)(p.ws + WS_O1); const float* LP = (const float*)(p.ws + WS_AFF);
    const int hd = lane >> 3;
    for (int r0 = gw; r0 < NR; r0 += 4 * ngw) {
      float l0[4], l1[4]; u32x4 a[4], b2[4];
#pragma unroll
      for (int u = 0; u < 4; ++u) {
        const int r = (r0 + u * ngw < NR) ? r0 + u * ngw : r0;
        l0[u] = LP[(size_t)r * 8 + hd]; l1[u] = LP[((size_t)NR + r) * 8 + hd];
        a[u] = *(const u32x4*)(O1 + (size_t)r * 512 + lane * 8); b2[u] = *(const u32x4*)(MIX + (size_t)r * DM + 512 + lane * 8);
      }
#pragma unroll
      for (int u = 0; u < 4; ++u) {
        const int r = r0 + u * ngw;
        if (r < NR) {
          const float il = 1.f / (l0[u] + l1[u]);
          u32x4 o; o.x = pk2((bflo(a[u].x) + bflo(b2[u].x)) * il, (bfhi(a[u].x) + bfhi(b2[u].x)) * il); o.y = pk2((bflo(a[u].y) + bflo(b2[u].y)) * il, (bfhi(a[u].y) + bfhi(b2[u].y)) * il);
          o.z = pk2((bflo(a[u].z) + bflo(b2[u].z)) * il, (bfhi(a[u].z) + bfhi(b2[u].z)) * il); o.w = pk2((bflo(a[u].w) + bflo(b2[u].w)) * il, (bfhi(a[u].w) + bfhi(b2[u].w)) * il);
          *(u32x4*)(MIX + (size_t)r * DM + 512 + lane * 8) = o;
        }
      }
    }
  }
  f32x4 ong[4];
#pragma unroll
  for (int d = 0; d < 4; ++d) ong[d] = *(const f32x4*)(p.even_out_norm_g + 16 * d + 4 * q);
  for (int tsk = gw; tsk < NCHUNK * 8 * 4; tsk += ngw) {
    const int mtw = tsk & 3, h = (tsk >> 2) & 7, cid = tsk >> 5;
    const int roff = (16 * mtw + c) * 64 + 8 * q;
    const bf16_t* qn = QN + (size_t)(cid * 8 + h) * 4096;
    const bf16x8 q0 = *(const bf16x8*)(qn + roff), q1 = *(const bf16x8*)(qn + roff + 32);
    f32x4 oacc[4];
#pragma unroll
    for (int d = 0; d < 4; ++d) oacc[d] = (f32x4){0.f, 0.f, 0.f, 0.f};
#pragma unroll
    for (int dir = 0; dir < 2; ++dir) {
      const size_t cd = (size_t)((cid * 8 + h) * 2 + dir);
      const bf16_t* wua = WUA + cd * 3 * 4096; const bf16_t* sc = SC + cd * 4096;
      const float eg = EGD[cd * 128 + 16 * mtw + c];
      const bf16x8 a0 = *(const bf16x8*)(wua + 4096 + roff), a1 = *(const bf16x8*)(wua + 4096 + roff + 32);
#pragma unroll
      for (int d = 0; d < 4; ++d) {
        const int so = (16 * d + c) * 64 + 16 * q;
        const bf16x8 s0 = *(const bf16x8*)(sc + so), s1 = *(const bf16x8*)(sc + so + 8), v0 = *(const bf16x8*)(wua + 8192 + so), v1 = *(const bf16x8*)(wua + 8192 + so + 8);
        f32x4 t = (f32x4){0.f, 0.f, 0.f, 0.f};
        t = __builtin_amdgcn_mfma_f32_16x16x32_bf16(s0, q0, t, 0, 0, 0);
        t = __builtin_amdgcn_mfma_f32_16x16x32_bf16(s1, q1, t, 0, 0, 0);
        f32x4 o = oacc[d] + t * eg;
        o = __builtin_amdgcn_mfma_f32_16x16x32_bf16(v0, a0, o, 0, 0, 0);
        o = __builtin_amdgcn_mfma_f32_16x16x32_bf16(v1, a1, o, 0, 0, 0);
        oacc[d] = o;
      }
    }
    float ss = 0.f;
#pragma unroll
    for (int d = 0; d < 4; ++d) ss += oacc[d].x * oacc[d].x + oacc[d].y * oacc[d].y + oacc[d].z * oacc[d].z + oacc[d].w * oacc[d].w;
    ss += __shfl_xor(ss, 16); ss += __shfl_xor(ss, 32);
    const float rs = rsqrtf(ss * (1.f / 64.f) + EPS);
    const int row = cid * 64 + 16 * mtw + c;
#pragma unroll
    for (int d = 0; d < 4; ++d) {
      const int dv = 16 * d + 4 * q;
      const u32x2 z = *(const u32x2*)(PROJ + (size_t)row * PROJ_LD + 1536 + h * 64 + dv);
      const f32x4 o = oacc[d] * rs * ong[d];
      u32x2 ow; ow.x = pk2(o.x * silu_f(bflo(z.x)), o.y * silu_f(bfhi(z.x))); ow.y = pk2(o.z * silu_f(bflo(z.y)), o.w * silu_f(bfhi(z.y)));
      *(u32x2*)(MIX + (size_t)row * DM + h * 64 + dv) = ow;
    }
  }
}

__device__ __forceinline__ void na_item(const Params& p, int item, char* lds_all) {
  const int tid = ltid(), half = tid >> 8, lt = tid & 255, lane = lt & 63, w = lt >> 6, r32 = lane & 31, hh = lane >> 5;
  char* lds = lds_all + half * 53248;
  const bf16_t* PROJ = (const bf16_t*)(p.ws + WS_PROJ);
  bf16_t* MIX = (bf16_t*)(p.ws + WS_MIX);
  const int head = 2 * (item & 7) + half, rp = (item >> 3) & 63, b = item >> 9;
  const int QR = 2 * rp + (w >> 1), colh = w & 1;
  const int qc = 32 * colh + r32;
  const int qrow = b * SEQ + QR * 64 + qc;
  int rs_w = QR - 4; rs_w = rs_w < 0 ? 0 : (rs_w > 120 ? 120 : rs_w);
  int rlo = 2 * rp - 4; rlo = rlo < 0 ? 0 : (rlo > 120 ? 120 : rlo);
  int rhi = 2 * rp + 1 - 4; rhi = rhi < 0 ? 0 : (rhi > 120 ? 120 : rhi); rhi += 7;
  const int ntile = 4 + (rhi - rlo + 1);
  char* Kt = lds; char* Vt = lds + 24576; float* bias = (float*)(lds + 24576 + 3 * 8704);
  __syncthreads();
  for (int i = lt; i < 15 * 32; i += 256) { const int br = i >> 5, bc = i & 31; bias[i] = (bc < 31) ? p.odd_rpb[(size_t)head * 465 + br * 31 + bc] * LOG2E : -1e30f; }
  bf16x8 qf[4];
#pragma unroll
  for (int s = 0; s < 4; ++s) qf[s] = *(const bf16x8*)(PROJ + (size_t)qrow * PROJ_LD + head * 64 + 16 * s + 8 * hh);
  AttnState st; st.o0 = (f32x16){}; st.o1 = (f32x16){}; st.m = -1e30f; st.l = 0.f;
  const int lrow0 = lt >> 3, lch = lt & 7;
  auto tile_row0 = [&](int t) -> int { t = t < ntile ? t : ntile - 1; return t < 4 ? MLAT + b * NCTX + t * 64 : b * SEQ + (rlo + t - 4) * 64; };
  u32x4 rk0[2], rv0[2], rk1[2], rv1[2];
  const int vkp = lt & 31, vch = lt >> 5;
#define NA_GLOAD(R, T) do { const int r0_ = tile_row0(T); _Pragma("unroll") for (int i = 0; i < 2; ++i) { \
      rk##R[i] = *(const u32x4*)(PROJ + (size_t)(r0_ + lrow0 + 32 * i) * PROJ_LD + 1024 + head * 64 + lch * 8); \
      rv##R[i] = *(const u32x4*)(PROJ + (size_t)(r0_ + 2 * vkp + i) * PROJ_LD + 2048 + head * 64 + vch * 8); } } while (0)
#define NA_LSTORE(R, BUF) do { _Pragma("unroll") for (int i = 0; i < 2; ++i) { const int row_ = lrow0 + 32 * i; \
      *(u32x4*)(Kt + (BUF) * 8192 + row_ * 128 + ((lch ^ ((row_ >> 1) & 7)) << 4)) = rk##R[i]; } \
    { unsigned* vb_ = (unsigned*)(Vt + (BUF) * 8704) + vkp; const unsigned va_[4] = {rv##R[0].x, rv##R[0].y, rv##R[0].z, rv##R[0].w}, vc_[4] = {rv##R[1].x, rv##R[1].y, rv##R[1].z, rv##R[1].w}; \
      _Pragma("unroll") for (int q2 = 0; q2 < 4; ++q2) { vb_[(vch * 8 + 2 * q2) * 34] = (va_[q2] & 0xffffu) | (vc_[q2] << 16); vb_[(vch * 8 + 2 * q2 + 1) * 34] = (va_[q2] >> 16) | (vc_[q2] & 0xffff0000u); } } } while (0)
  NA_GLOAD(0, 0); NA_GLOAD(1, 1);
  NA_LSTORE(0, 0);
  __syncthreads();
  const float sc = 0.125f * LOG2E;
  int cs = qc - 8; cs = cs < 0 ? 0 : (cs > 48 ? 48 : cs);
#define NA_STEP(T, CUR) do { const int t_ = (T); const int KR = rlo + t_ - 4; \
    const bool active = (t_ < 4) || (KR >= rs_w && KR < rs_w + 8); \
    if (active) { f32x16 s0 = (f32x16){}, s1 = (f32x16){}; \
      attn_scores(Kt + (CUR) * 8192, qf, r32, hh, s0, s1); \
      if (t_ < 4) { _Pragma("unroll") for (int i = 0; i < 16; ++i) { s0[i] *= sc; s1[i] *= sc; } } \
      else { const float* brow = bias + (KR - QR + 7) * 32; _Pragma("unroll") for (int i = 0; i < 16; ++i) { const int kc0 = (i & 3) + 8 * (i >> 2) + 4 * hh, kc1 = kc0 + 32; \
          s0[i] = s0[i] * sc + brow[(kc0 >= cs && kc0 < cs + 16) ? kc0 - qc + 15 : 31]; s1[i] = s1[i] * sc + brow[(kc1 >= cs && kc1 < cs + 16) ? kc1 - qc + 15 : 31]; } } \
      attn_update(st, s0, s1, Vt + (CUR) * 8704, r32, hh); } } while (0)
  int b0 = 0, b1 = 1, b2 = 2;
  for (int t = 0; t < ntile; t += 2) {
    NA_GLOAD(0, t + 2);
    NA_STEP(t, b0);
    NA_LSTORE(1, b1);
    __syncthreads();
    if (t + 1 >= ntile) break;
    NA_GLOAD(1, t + 3);
    NA_STEP(t + 1, b1);
    NA_LSTORE(0, b2);
    __syncthreads();
    const int tb = b0; b0 = b2; b2 = b1; b1 = tb;
  }
#undef NA_GLOAD
#undef NA_LSTORE
#undef NA_STEP
  attn_store(st, MIX + (size_t)qrow * DM + head * 64, hh);
}
__device__ __forceinline__ void mix_odd(const Params& p, char* lds) {
  for (int item = blockIdx.x; item < 1024; item += gridDim.x) na_item(p, item, lds);
}

#define XB_TMO      128
#define XB_XCNT(j)  (256  + 64 * (j))
#define XB_XSUB(j)  (1280 + 64 * (j))
#define XB_XGEN(j)  (2304 + 64 * (j))
#define XB_TOP      3328
#define XB_TOPGEN   3392
#define XCD_BAR_WORDS 3456
#define XB_SPIN_CAP (1u << 22)
#define LAS __attribute__((address_space(3)))
__device__ __forceinline__ unsigned xb_ld(unsigned* p)              { return __hip_atomic_load(p, __ATOMIC_RELAXED, __HIP_MEMORY_SCOPE_AGENT); }
__device__ __forceinline__ unsigned xb_add(unsigned* p, unsigned v) { return __hip_atomic_fetch_add(p, v, __ATOMIC_RELAXED, __HIP_MEMORY_SCOPE_AGENT); }
__device__ __forceinline__ unsigned xb_xcc_id() { return (unsigned)__builtin_amdgcn_s_getreg((3 << 11) | 20) & 0xFu; }
#define XB_SPIN(cond, bar) do { unsigned _sp = 0; while (cond) { __builtin_amdgcn_s_sleep(1); \
    if ((++_sp & 255u) == 0u) { if (xb_ld(&(bar)[XB_TMO])) break; if (_sp > XB_SPIN_CAP) { atomicAdd(&(bar)[XB_TMO], 1u); break; } } } } while (0)
struct XcdBarrier { unsigned* bar; unsigned x; volatile LAS unsigned* st; };
__device__ __forceinline__ XcdBarrier xcd_barrier_post(unsigned* bar, volatile LAS unsigned* st) {
    XcdBarrier b; b.bar = bar; b.x = xb_xcc_id(); b.st = st;
    if (threadIdx.x == 0) (void)xb_add(&bar[XB_XCNT(b.x)], 1u);
    return b;
}
__device__ __forceinline__ void xcd_barrier_complete(unsigned* bar, unsigned x, unsigned& nloc, unsigned& nx) {
    const unsigned G = gridDim.x * gridDim.y * gridDim.z;
    unsigned sum, cnt, mine, sp = 0u;
    for (;;) {
        sum = 0u; cnt = 0u; mine = 0u;
#pragma unroll
        for (unsigned j = 0; j < 16; ++j) { const unsigned c = xb_ld(&bar[XB_XCNT(j)]); sum += c; cnt += (c > 0u) ? 1u : 0u; mine = (j == x) ? c : mine; }
        if (sum == G) break;
        __builtin_amdgcn_s_sleep(1);
        if ((++sp & 255u) == 0u) { if (xb_ld(&bar[XB_TMO])) break; if (sp > XB_SPIN_CAP) { atomicAdd(&bar[XB_TMO], 1u); break; } }
    }
    nloc = mine > 0u ? mine : 1u; nx = cnt > 0u ? cnt : 1u;
}
__device__ __forceinline__ void xcd_barrier(const XcdBarrier& b) {
    asm volatile("s_waitcnt vmcnt(0)" ::: "memory");
    __syncthreads();
    if (threadIdx.x == 0) {
        unsigned* bar = b.bar;
        __builtin_amdgcn_s_waitcnt(0);
        unsigned nloc = b.st[0], nx = b.st[1];
        if (nloc == 0u) { xcd_barrier_complete(bar, b.x, nloc, nx); b.st[0] = nloc; b.st[1] = nx; }
        const unsigned old = xb_add(&bar[XB_XSUB(b.x)], 1u);
        const unsigned gen = old / nloc;
        if (old + 1u == (gen + 1u) * nloc) {
            __builtin_amdgcn_fence(__ATOMIC_RELEASE, "agent");
            asm volatile("s_waitcnt vmcnt(0)" ::: "memory");
            const unsigned og = xb_add(&bar[XB_TOP], 1u);
            const unsigned tg = og / nx;
            if (og + 1u == (tg + 1u) * nx) xb_add(&bar[XB_TOPGEN], 1u);
            else XB_SPIN(xb_ld(&bar[XB_TOPGEN]) == tg, bar);
            __builtin_amdgcn_fence(__ATOMIC_ACQUIRE, "agent");
            xb_add(&bar[XB_XGEN(b.x)], 1u);
            asm volatile("s_waitcnt vmcnt(0)" ::: "memory");
        } else {
            XB_SPIN(xb_ld(&bar[XB_XGEN(b.x)]) == gen, bar);
            __builtin_amdgcn_fence(__ATOMIC_ACQUIRE, "agent");
            asm volatile("s_waitcnt vmcnt(0)" ::: "memory");
        }
    }
    __syncthreads();
}
#define GSYNC() xcd_barrier(xbar)

constexpr int PT_OFF = LDS_BYTES - 16 - 256;
template <class T> __device__ __forceinline__ T* ldptr(const char* lds, int i) {
  const volatile unsigned* q = (const volatile unsigned*)(lds + PT_OFF + 8 * i);
  const unsigned lo = __builtin_amdgcn_readfirstlane(q[0]), hi = __builtin_amdgcn_readfirstlane(q[1]);
  typedef __attribute__((address_space(1))) T* gptr_t;
  return (T*)(gptr_t)(((unsigned long long)hi << 32) | (unsigned long long)lo);
}
__device__ __forceinline__ Params fresh(const char* lds) {
  Params p;
  p.x = ldptr<const float>(lds, 0); p.c = ldptr<const float>(lds, 1); p.ctx = ldptr<const float>(lds, 2); p.c_ctx = ldptr<const float>(lds, 3); p.ada_w = ldptr<const float>(lds, 4); p.ada_b = ldptr<const float>(lds, 5);
  p.ln1_g = ldptr<const float>(lds, 6); p.ln2_g = ldptr<const float>(lds, 7); p.even_w_in = ldptr<const float>(lds, 8); p.even_conv_w = ldptr<const float>(lds, 9); p.even_a_log = ldptr<const float>(lds, 10);
  p.even_dt_bias = ldptr<const float>(lds, 11); p.even_out_norm_g = ldptr<const float>(lds, 12); p.even_q_norm_g = ldptr<const float>(lds, 13); p.even_k_norm_g = ldptr<const float>(lds, 14);
  p.even_w_out = ldptr<const float>(lds, 15); p.odd_w_in = ldptr<const float>(lds, 16); p.odd_rpb = ldptr<const float>(lds, 17); p.odd_w_out = ldptr<const float>(lds, 18); p.router_w = ldptr<const float>(lds, 19);
  p.w_gate = ldptr<const float>(lds, 20); p.w_up = ldptr<const float>(lds, 21); p.w_down = ldptr<const float>(lds, 22); p.final_g = ldptr<const float>(lds, 23);
  p.out = ldptr<float>(lds, 24); p.ws = ldptr<unsigned char>(lds, 25);
  return p;
}
__global__ void __launch_bounds__(NT, 2) fwd_megakernel(Params p0) {
  cg::grid_group grid = cg::this_grid();
  extern __shared__ __attribute__((aligned(16))) char lds[];
  volatile LAS unsigned* xb_st = (volatile LAS unsigned*)(lds + LDS_BYTES - 16);
  if (threadIdx.x < 4) xb_st[threadIdx.x] = 0u;
  if (threadIdx.x == 0) {
    unsigned long long* tab = (unsigned long long*)(lds + PT_OFF);
    tab[0] = (unsigned long long)p0.x; tab[1] = (unsigned long long)p0.c; tab[2] = (unsigned long long)p0.ctx; tab[3] = (unsigned long long)p0.c_ctx; tab[4] = (unsigned long long)p0.ada_w; tab[5] = (unsigned long long)p0.ada_b;
    tab[6] = (unsigned long long)p0.ln1_g; tab[7] = (unsigned long long)p0.ln2_g; tab[8] = (unsigned long long)p0.even_w_in; tab[9] = (unsigned long long)p0.even_conv_w; tab[10] = (unsigned long long)p0.even_a_log;
    tab[11] = (unsigned long long)p0.even_dt_bias; tab[12] = (unsigned long long)p0.even_out_norm_g; tab[13] = (unsigned long long)p0.even_q_norm_g; tab[14] = (unsigned long long)p0.even_k_norm_g;
    tab[15] = (unsigned long long)p0.even_w_out; tab[16] = (unsigned long long)p0.odd_w_in; tab[17] = (unsigned long long)p0.odd_rpb; tab[18] = (unsigned long long)p0.odd_w_out; tab[19] = (unsigned long long)p0.router_w;
    tab[20] = (unsigned long long)p0.w_gate; tab[21] = (unsigned long long)p0.w_up; tab[22] = (unsigned long long)p0.w_down; tab[23] = (unsigned long long)p0.final_g;
    tab[24] = (unsigned long long)p0.out; tab[25] = (unsigned long long)p0.ws;
  }
  __syncthreads();
  XcdBarrier xbar = xcd_barrier_post((unsigned*)(ldptr<unsigned char>(lds, 25) + WS_CTL + 16384), xb_st);
  grid.sync();

  { const Params p = fresh(lds); const bf16_t* A = (const bf16_t*)(p.ws + WS_A); const float* MOD = (const float*)(p.ws + WS_MOD); const bf16_t* WEXP = (const bf16_t*)(p.ws + WS_WEXP); bf16_t* PROJ = (bf16_t*)(p.ws + WS_PROJ); const bf16_t* MIX = (const bf16_t*)(p.ws + WS_MIX); (void)A; (void)MOD; (void)WEXP; (void)PROJ; (void)MIX; phase0(p, lds); }
  GSYNC();
  { const Params p = fresh(lds); const bf16_t* A = (const bf16_t*)(p.ws + WS_A); const float* MOD = (const float*)(p.ws + WS_MOD); const bf16_t* WEXP = (const bf16_t*)(p.ws + WS_WEXP); bf16_t* PROJ = (bf16_t*)(p.ws + WS_PROJ); const bf16_t* MIX = (const bf16_t*)(p.ws + WS_MIX); (void)A; (void)MOD; (void)WEXP; (void)PROJ; (void)MIX; rowpass_a<0, false>(p, lds); }
  GSYNC();
  { const Params p = fresh(lds); const bf16_t* A = (const bf16_t*)(p.ws + WS_A); const float* MOD = (const float*)(p.ws + WS_MOD); const bf16_t* WEXP = (const bf16_t*)(p.ws + WS_WEXP); bf16_t* PROJ = (bf16_t*)(p.ws + WS_PROJ); const bf16_t* MIX = (const bf16_t*)(p.ws + WS_MIX); (void)A; (void)MOD; (void)WEXP; (void)PROJ; (void)MIX;  EpiStoreBf16 E{PROJ, PROJ_LD, nullptr}; big_gemm(lds, A, (const bf16_t*)(p.ws + WS_WEI), MLAT, 3072, 0, 0, E);  }
  { const Params p = fresh(lds); const bf16_t* A = (const bf16_t*)(p.ws + WS_A); const float* MOD = (const float*)(p.ws + WS_MOD); const bf16_t* WEXP = (const bf16_t*)(p.ws + WS_WEXP); bf16_t* PROJ = (bf16_t*)(p.ws + WS_PROJ); const bf16_t* MIX = (const bf16_t*)(p.ws + WS_MIX); (void)A; (void)MOD; (void)WEXP; (void)PROJ; (void)MIX;  OpInProjCtx<0> op{A, (const bf16_t*)(p.ws + WS_WEI), PROJ, 4 * 23}; gemm_small_phase(op, lds);  }
  GSYNC();
  { const Params p = fresh(lds); const bf16_t* A = (const bf16_t*)(p.ws + WS_A); const float* MOD = (const float*)(p.ws + WS_MOD); const bf16_t* WEXP = (const bf16_t*)(p.ws + WS_WEXP); bf16_t* PROJ = (bf16_t*)(p.ws + WS_PROJ); const bf16_t* MIX = (const bf16_t*)(p.ws + WS_MIX); (void)A; (void)MOD; (void)WEXP; (void)PROJ; (void)MIX; prep_even(p, lds); }
  GSYNC();
  { const Params p = fresh(lds); const bf16_t* A = (const bf16_t*)(p.ws + WS_A); const float* MOD = (const float*)(p.ws + WS_MOD); const bf16_t* WEXP = (const bf16_t*)(p.ws + WS_WEXP); bf16_t* PROJ = (bf16_t*)(p.ws + WS_PROJ); const bf16_t* MIX = (const bf16_t*)(p.ws + WS_MIX); (void)A; (void)MOD; (void)WEXP; (void)PROJ; (void)MIX; mix_even(p, lds); }
  GSYNC();
  { const Params p = fresh(lds); const bf16_t* A = (const bf16_t*)(p.ws + WS_A); const float* MOD = (const float*)(p.ws + WS_MOD); const bf16_t* WEXP = (const bf16_t*)(p.ws + WS_WEXP); bf16_t* PROJ = (bf16_t*)(p.ws + WS_PROJ); const bf16_t* MIX = (const bf16_t*)(p.ws + WS_MIX); (void)A; (void)MOD; (void)WEXP; (void)PROJ; (void)MIX; gate_phase(p); }
  GSYNC();
  { const Params p = fresh(lds); const bf16_t* A = (const bf16_t*)(p.ws + WS_A); const float* MOD = (const float*)(p.ws + WS_MOD); const bf16_t* WEXP = (const bf16_t*)(p.ws + WS_WEXP); bf16_t* PROJ = (bf16_t*)(p.ws + WS_PROJ); const bf16_t* MIX = (const bf16_t*)(p.ws + WS_MIX); (void)A; (void)MOD; (void)WEXP; (void)PROJ; (void)MIX;  EpiResid E{p.out, p.out, MOD + 2 * 1024}; big_gemm(lds, MIX, (const bf16_t*)(p.ws + WS_WEO), MLAT, 1024, 0, 0, E);  }
  { const Params p = fresh(lds); const bf16_t* A = (const bf16_t*)(p.ws + WS_A); const float* MOD = (const float*)(p.ws + WS_MOD); const bf16_t* WEXP = (const bf16_t*)(p.ws + WS_WEXP); bf16_t* PROJ = (bf16_t*)(p.ws + WS_PROJ); const bf16_t* MIX = (const bf16_t*)(p.ws + WS_MIX); (void)A; (void)MOD; (void)WEXP; (void)PROJ; (void)MIX;  OpOutProjCtx op{MIX, (const bf16_t*)(p.ws + WS_WEO), MOD + 2 * 6144 + 2 * 1024, (float*)(p.ws + WS_HC), 4 * 8}; gemm_small_phase(op, lds);  }
  GSYNC();
  { const Params p = fresh(lds); const bf16_t* A = (const bf16_t*)(p.ws + WS_A); const float* MOD = (const float*)(p.ws + WS_MOD); const bf16_t* WEXP = (const bf16_t*)(p.ws + WS_WEXP); bf16_t* PROJ = (bf16_t*)(p.ws + WS_PROJ); const bf16_t* MIX = (const bf16_t*)(p.ws + WS_MIX); (void)A; (void)MOD; (void)WEXP; (void)PROJ; (void)MIX; rowpass_b<0>(p, lds); }
  GSYNC();
  { const Params p = fresh(lds); const bf16_t* A = (const bf16_t*)(p.ws + WS_A); const float* MOD = (const float*)(p.ws + WS_MOD); const bf16_t* WEXP = (const bf16_t*)(p.ws + WS_WEXP); bf16_t* PROJ = (bf16_t*)(p.ws + WS_PROJ); const bf16_t* MIX = (const bf16_t*)(p.ws + WS_MIX); (void)A; (void)MOD; (void)WEXP; (void)PROJ; (void)MIX; topk_phase<0>(p, lds); if (blockIdx.x >= 64) convert_experts(p, 1, lds, (bf16_t*)(p.ws + WS_WEXP1), 0, 3072, ((int)blockIdx.x - 64) * NWV + (ltid() >> 6), ((int)gridDim.x - 64) * NWV); }
  GSYNC();
  { const Params p = fresh(lds); const bf16_t* A = (const bf16_t*)(p.ws + WS_A); const float* MOD = (const float*)(p.ws + WS_MOD); const bf16_t* WEXP = (const bf16_t*)(p.ws + WS_WEXP); bf16_t* PROJ = (bf16_t*)(p.ws + WS_PROJ); const bf16_t* MIX = (const bf16_t*)(p.ws + WS_MIX); (void)A; (void)MOD; (void)WEXP; (void)PROJ; (void)MIX;  EpiMoe1 E{(bf16_t*)(p.ws + WS_HIDL)}; big_gemm_gather(lds, A, (const int*)(p.ws + WS_IDX), WEXP, 16 * 2048, 2048, 8, EXPW * 2, E);  }
  { const Params p = fresh(lds); const bf16_t* A = (const bf16_t*)(p.ws + WS_A); const float* MOD = (const float*)(p.ws + WS_MOD); const bf16_t* WEXP = (const bf16_t*)(p.ws + WS_WEXP); bf16_t* PROJ = (bf16_t*)(p.ws + WS_PROJ); const bf16_t* MIX = (const bf16_t*)(p.ws + WS_MIX); (void)A; (void)MOD; (void)WEXP; (void)PROJ; (void)MIX;  OpMoe1Ctx op{A, WEXP, (const int*)(p.ws + WS_IDX), (bf16_t*)(p.ws + WS_HIDC), 16 * 16}; gemm_small_phase(op, lds);  }
  GSYNC();
  { const Params p = fresh(lds); const bf16_t* A = (const bf16_t*)(p.ws + WS_A); const float* MOD = (const float*)(p.ws + WS_MOD); const bf16_t* WEXP = (const bf16_t*)(p.ws + WS_WEXP); bf16_t* PROJ = (bf16_t*)(p.ws + WS_PROJ); const bf16_t* MIX = (const bf16_t*)(p.ws + WS_MIX); (void)A; (void)MOD; (void)WEXP; (void)PROJ; (void)MIX;  EpiStoreBf16 E{(bf16_t*)(p.ws + WS_YL), DM, (const float*)(p.ws + WS_GATEV)}; big_gemm(lds, (const bf16_t*)(p.ws + WS_HIDL), WEXP + (size_t)2048 * DM, 16 * 2048, 1024, 8, EXPW * 2, E);  }
  { const Params p = fresh(lds); const bf16_t* A = (const bf16_t*)(p.ws + WS_A); const float* MOD = (const float*)(p.ws + WS_MOD); const bf16_t* WEXP = (const bf16_t*)(p.ws + WS_WEXP); bf16_t* PROJ = (bf16_t*)(p.ws + WS_PROJ); const bf16_t* MIX = (const bf16_t*)(p.ws + WS_MIX); (void)A; (void)MOD; (void)WEXP; (void)PROJ; (void)MIX;  OpMoe2Ctx op{(const bf16_t*)(p.ws + WS_HIDC), WEXP, (const float*)(p.ws + WS_GATEV), (bf16_t*)(p.ws + WS_YC), 16 * 8}; gemm_small_phase(op, lds);  }
  GSYNC();
  { const Params p = fresh(lds); const bf16_t* A = (const bf16_t*)(p.ws + WS_A); const float* MOD = (const float*)(p.ws + WS_MOD); const bf16_t* WEXP = (const bf16_t*)(p.ws + WS_WEXP1); bf16_t* PROJ = (bf16_t*)(p.ws + WS_PROJ); const bf16_t* MIX = (const bf16_t*)(p.ws + WS_MIX); (void)A; (void)MOD; (void)WEXP; (void)PROJ; (void)MIX; rowpass_a<1, false>(p, lds); }
  GSYNC();
  { const Params p = fresh(lds); const bf16_t* A = (const bf16_t*)(p.ws + WS_A); const float* MOD = (const float*)(p.ws + WS_MOD); const bf16_t* WEXP = (const bf16_t*)(p.ws + WS_WEXP1); bf16_t* PROJ = (bf16_t*)(p.ws + WS_PROJ); const bf16_t* MIX = (const bf16_t*)(p.ws + WS_MIX); (void)A; (void)MOD; (void)WEXP; (void)PROJ; (void)MIX;  EpiStoreBf16 E{PROJ, PROJ_LD, nullptr}; big_gemm(lds, A, (const bf16_t*)(p.ws + WS_WOI), MLAT, 3072, 0, 0, E);  }
  { const Params p = fresh(lds); const bf16_t* A = (const bf16_t*)(p.ws + WS_A); const float* MOD = (const float*)(p.ws + WS_MOD); const bf16_t* WEXP = (const bf16_t*)(p.ws + WS_WEXP1); bf16_t* PROJ = (bf16_t*)(p.ws + WS_PROJ); const bf16_t* MIX = (const bf16_t*)(p.ws + WS_MIX); (void)A; (void)MOD; (void)WEXP; (void)PROJ; (void)MIX;  OpInProjCtx<1> op{A, (const bf16_t*)(p.ws + WS_WOI), PROJ, 4 * 16}; gemm_small_phase(op, lds);  }
  GSYNC();
  { const Params p = fresh(lds); const bf16_t* A = (const bf16_t*)(p.ws + WS_A); const float* MOD = (const float*)(p.ws + WS_MOD); const bf16_t* WEXP = (const bf16_t*)(p.ws + WS_WEXP1); bf16_t* PROJ = (bf16_t*)(p.ws + WS_PROJ); const bf16_t* MIX = (const bf16_t*)(p.ws + WS_MIX); (void)A; (void)MOD; (void)WEXP; (void)PROJ; (void)MIX; mix_odd(p, lds); }
  GSYNC();
  { const Params p = fresh(lds); const bf16_t* A = (const bf16_t*)(p.ws + WS_A); const float* MOD = (const float*)(p.ws + WS_MOD); const bf16_t* WEXP = (const bf16_t*)(p.ws + WS_WEXP1); bf16_t* PROJ = (bf16_t*)(p.ws + WS_PROJ); const bf16_t* MIX = (const bf16_t*)(p.ws + WS_MIX); (void)A; (void)MOD; (void)WEXP; (void)PROJ; (void)MIX;  EpiResid E{p.out, p.out, MOD + 3 * 6144 + 2 * 1024}; big_gemm(lds, MIX, (const bf16_t*)(p.ws + WS_WOO), MLAT, 1024, 0, 0, E);  }
  GSYNC();
  { const Params p = fresh(lds); const bf16_t* A = (const bf16_t*)(p.ws + WS_A); const float* MOD = (const float*)(p.ws + WS_MOD); const bf16_t* WEXP = (const bf16_t*)(p.ws + WS_WEXP1); bf16_t* PROJ = (bf16_t*)(p.ws + WS_PROJ); const bf16_t* MIX = (const bf16_t*)(p.ws + WS_MIX); (void)A; (void)MOD; (void)WEXP; (void)PROJ; (void)MIX; rowpass_b<1>(p, lds); }
  GSYNC();
  { const Params p = fresh(lds); const bf16_t* A = (const bf16_t*)(p.ws + WS_A); const float* MOD = (const float*)(p.ws + WS_MOD); const bf16_t* WEXP = (const bf16_t*)(p.ws + WS_WEXP1); bf16_t* PROJ = (bf16_t*)(p.ws + WS_PROJ); const bf16_t* MIX = (const bf16_t*)(p.ws + WS_MIX); (void)A; (void)MOD; (void)WEXP; (void)PROJ; (void)MIX; topk_phase<1>(p, lds); if (blockIdx.x >= 32) convert_experts(p, 1, lds, (bf16_t*)(p.ws + WS_WEXP1), 3072, 6144, ((int)blockIdx.x - 32) * NWV + (ltid() >> 6), ((int)gridDim.x - 32) * NWV); }
  GSYNC();
  { const Params p = fresh(lds); const bf16_t* A = (const bf16_t*)(p.ws + WS_A); const float* MOD = (const float*)(p.ws + WS_MOD); const bf16_t* WEXP = (const bf16_t*)(p.ws + WS_WEXP1); bf16_t* PROJ = (bf16_t*)(p.ws + WS_PROJ); const bf16_t* MIX = (const bf16_t*)(p.ws + WS_MIX); (void)A; (void)MOD; (void)WEXP; (void)PROJ; (void)MIX;  EpiMoe1 E{(bf16_t*)(p.ws + WS_HIDL)}; big_gemm_gather(lds, A, (const int*)(p.ws + WS_IDX), WEXP, 16 * 2048, 2048, 8, EXPW * 2, E);  }
  GSYNC();
  { const Params p = fresh(lds); const bf16_t* A = (const bf16_t*)(p.ws + WS_A); const float* MOD = (const float*)(p.ws + WS_MOD); const bf16_t* WEXP = (const bf16_t*)(p.ws + WS_WEXP1); bf16_t* PROJ = (bf16_t*)(p.ws + WS_PROJ); const bf16_t* MIX = (const bf16_t*)(p.ws + WS_MIX); (void)A; (void)MOD; (void)WEXP; (void)PROJ; (void)MIX;  EpiStoreBf16 E{(bf16_t*)(p.ws + WS_YL), DM, (const float*)(p.ws + WS_GATEV)}; big_gemm(lds, (const bf16_t*)(p.ws + WS_HIDL), WEXP + (size_t)2048 * DM, 16 * 2048, 1024, 8, EXPW * 2, E);  }
  GSYNC();
  { const Params p = fresh(lds); const bf16_t* A = (const bf16_t*)(p.ws + WS_A); const float* MOD = (const float*)(p.ws + WS_MOD); const bf16_t* WEXP = (const bf16_t*)(p.ws + WS_WEXP1); bf16_t* PROJ = (bf16_t*)(p.ws + WS_PROJ); const bf16_t* MIX = (const bf16_t*)(p.ws + WS_MIX); (void)A; (void)MOD; (void)WEXP; (void)PROJ; (void)MIX; rowpass_a<1, true>(p, lds); }
}

extern "C" void kernel_launch(void* const* d_in, const int* in_sizes, int n_in, void* d_out, int out_size,
                              void* d_ws, size_t ws_size, hipStream_t stream) {
  static int grid_blocks = 0;
  if (!grid_blocks) {
    int dev = 0, cus = 0, per_cu = 0;
    (void)hipGetDevice(&dev);
    (void)hipDeviceGetAttribute(&cus, hipDeviceAttributeMultiprocessorCount, dev);
    (void)hipFuncSetAttribute((const void*)fwd_megakernel, hipFuncAttributeMaxDynamicSharedMemorySize, LDS_BYTES);
    (void)hipOccupancyMaxActiveBlocksPerMultiprocessor(&per_cu, fwd_megakernel, NT, LDS_BYTES);
    if (per_cu > 1) per_cu = 1;
    grid_blocks = cus * per_cu;
    if (ws_size < WS_END || n_in != 24 || per_cu < 1 || (grid_blocks & 7)) { fprintf(stderr, "kernel_launch: unexpected setup (ws %zu need %zu, n_in %d, per_cu %d, grid %d)\n", ws_size, (size_t)WS_END, n_in, per_cu, grid_blocks); grid_blocks = -1; }
  }
  if (grid_blocks < 0) return;
  Params p{};
  const float** pp = (const float**)&p;
  for (int i = 0; i < 24; ++i) pp[i] = (const float*)d_in[i];
  p.out = (float*)d_out; p.ws = (unsigned char*)d_ws;
  void* args[] = {&p};
  (void)hipMemsetAsync((char*)d_ws + WS_CTL + 16384, 0, XCD_BAR_WORDS * 4, stream);
  hipError_t e = hipLaunchCooperativeKernel((void*)fwd_megakernel, dim3(grid_blocks), dim3(NT), args, LDS_BYTES, stream);
  if (e != hipSuccess) fprintf(stderr, "cooperative launch failed: %s (grid %d)\n", hipGetErrorString(e), grid_blocks);
}
```

```cpp
#include <hip/hip_runtime.h>
#include <hip/hip_cooperative_groups.h>
#include <cstdio>
#include <cstdint>
namespace cg = cooperative_groups;

typedef unsigned short bf16_t;
typedef short bf16x8 __attribute__((ext_vector_type(8)));
typedef float f32x2 __attribute__((ext_vector_type(2)));
typedef float f32x4 __attribute__((ext_vector_type(4)));
typedef float f32x16 __attribute__((ext_vector_type(16)));
typedef unsigned u32x2 __attribute__((ext_vector_type(2)));
typedef unsigned u32x4 __attribute__((ext_vector_type(4)));
typedef __bf16 bf16x2_t __attribute__((ext_vector_type(2)));

constexpr int NT = 512, NWV = 8;
constexpr int LDS_BYTES = 155648;
constexpr int DM = 1024, SEQ = 8192, NCTX = 256;
constexpr int MLAT = 2 * SEQ;
constexpr int NR = MLAT + 2 * NCTX;
constexpr int PROJ_LD = 3072;
constexpr int NKEY = NCTX + SEQ;
constexpr int SLOTS = 2112;
constexpr int NCHUNK = NR / 64;
constexpr float LOG2E = 1.4426950408889634f;
constexpr float EPS = 1e-6f;

constexpr size_t MB = 1u << 20;
constexpr size_t WS_CTL = 0;
constexpr size_t WS_MOD = 64 * 1024;
constexpr size_t WS_ROPE = 1 * MB;
constexpr size_t WS_AFF = 3 * MB;
constexpr size_t WS_INV = 5 * MB;
constexpr size_t WS_IDX = 7 * MB;
constexpr size_t WS_GATEV = 7 * MB + 512 * 1024;
constexpr size_t WS_GATES = 8 * MB;
constexpr size_t WS_EGDEC = 11 * MB;
constexpr size_t WS_HC = 14 * MB;
constexpr size_t WS_WEI = 16 * MB;
constexpr size_t WS_WEO = 23 * MB;
constexpr size_t WS_WOI = 25 * MB;
constexpr size_t WS_WOO = 32 * MB;
constexpr size_t WS_WEXP = 34 * MB;
constexpr size_t WS_A = 136 * MB;
constexpr size_t WS_R = 172 * MB;
constexpr size_t WS_PROJ = WS_R;
constexpr size_t WS_MIX = WS_R + 104 * MB;
constexpr size_t WS_O1 = WS_R + 139 * MB;
constexpr size_t WS_QB = WS_R + 157 * MB;
constexpr size_t WS_KB = WS_R + 175 * MB;
constexpr size_t WS_VT = WS_R + 180 * MB;
constexpr size_t WS_QN = WS_R + 185 * MB;
constexpr size_t WS_KNT = WS_R + 203 * MB;
constexpr size_t WS_WUA = WS_R + 221 * MB;
constexpr size_t WS_WEXP1 = WS_R + (221ull << 20);
constexpr size_t WS_XS = WS_R;
constexpr size_t WS_HIDL = WS_R + 64 * MB;
constexpr size_t WS_YL = WS_R + 128 * MB;
constexpr size_t WS_HIDC = WS_R + 192 * MB;
constexpr size_t WS_YC = WS_R + 194 * MB;
constexpr size_t WS_END = WS_R + 326 * MB;
constexpr size_t EXPW = (size_t)3072 * 1024;

struct Params {
  const float* x; const float* c; const float* ctx; const float* c_ctx; const float* ada_w; const float* ada_b;
  const float* ln1_g; const float* ln2_g; const float* even_w_in; const float* even_conv_w; const float* even_a_log;
  const float* even_dt_bias; const float* even_out_norm_g; const float* even_q_norm_g; const float* even_k_norm_g;
  const float* even_w_out; const float* odd_w_in; const float* odd_rpb; const float* odd_w_out; const float* router_w;
  const float* w_gate; const float* w_up; const float* w_down; const float* final_g;
  float* out; unsigned char* ws;
};

__device__ __forceinline__ unsigned pk2(float lo, float hi) { f32x2 v = {lo, hi}; bf16x2_t b = __builtin_convertvector(v, bf16x2_t); return __builtin_bit_cast(unsigned, b); }
__device__ __forceinline__ float bflo(unsigned u) { return __uint_as_float(u << 16); }
__device__ __forceinline__ float bfhi(unsigned u) { return __uint_as_float(u & 0xffff0000u); }
__device__ __forceinline__ float bf1(bf16_t b) { return __uint_as_float(((unsigned)b) << 16); }
__device__ __forceinline__ bf16_t f2bf(float f) { return (bf16_t)(pk2(f, 0.f) & 0xffffu); }
__device__ __forceinline__ float wave_sum(float v) {
  v += __int_as_float(__builtin_amdgcn_mov_dpp(__float_as_int(v), 0xB1, 0xF, 0xF, true));
  v += __int_as_float(__builtin_amdgcn_mov_dpp(__float_as_int(v), 0x4E, 0xF, 0xF, true));
  v += __int_as_float(__builtin_amdgcn_mov_dpp(__float_as_int(v), 0x141, 0xF, 0xF, true));
  v += __int_as_float(__builtin_amdgcn_mov_dpp(__float_as_int(v), 0x140, 0xF, 0xF, true));
  const float r0 = __int_as_float(__builtin_amdgcn_readlane(__float_as_int(v), 0)), r1 = __int_as_float(__builtin_amdgcn_readlane(__float_as_int(v), 16));
  const float r2 = __int_as_float(__builtin_amdgcn_readlane(__float_as_int(v), 32)), r3 = __int_as_float(__builtin_amdgcn_readlane(__float_as_int(v), 48));
  return (r0 + r1) + (r2 + r3);
}
__device__ __forceinline__ float silu_f(float v) { return v / (1.f + __expf(-v)); }
__device__ __forceinline__ float sigmoid_f(float v) { return 1.f / (1.f + __expf(-v)); }
__device__ __forceinline__ float softplus_f(float v) { return fmaxf(v, 0.f) + log1pf(__expf(-fabsf(v))); }
__device__ __forceinline__ int row_sel(int r) { return r >= MLAT ? 2 : (r >> 13); }
__device__ __forceinline__ float* hrow_ptr(const Params& p, int r) { return r < MLAT ? p.out + (size_t)r * DM : (float*)(p.ws + WS_HC) + (size_t)(r - MLAT) * DM; }

__device__ __forceinline__ void sincos_d(float af, float& sn, float& cs) {
  const double a = (double)af;
  const double k = rint(a * 0.63661977236758134308);
  const double r = (a - k * 1.57079632679489655800) - k * 6.12323399573676603587e-17;
  const double r2 = r * r;
  double s = r * (1.0 + r2 * (-1.0 / 6 + r2 * (1.0 / 120 + r2 * (-1.0 / 5040 + r2 * (1.0 / 362880 + r2 * (-1.0 / 39916800 + r2 * (1.0 / 6227020800.0)))))));
  double c = 1.0 + r2 * (-0.5 + r2 * (1.0 / 24 + r2 * (-1.0 / 720 + r2 * (1.0 / 40320 + r2 * (-1.0 / 3628800 + r2 * (1.0 / 479001600.0 + r2 * (-1.0 / 87178291200.0)))))));
  const int q = ((int)k) & 3;
  double ss = (q & 1) ? c : s, cc = (q & 1) ? s : c;
  if (q == 1) cc = -cc; else if (q == 2) { ss = -ss; cc = -cc; } else if (q == 3) ss = -ss;
  sn = (float)ss; cs = (float)cc;
}

__device__ __forceinline__ float dpp_xor1(float v) { return __int_as_float(__builtin_amdgcn_mov_dpp(__float_as_int(v), 0xB1, 0xF, 0xF, true)); }
__device__ __forceinline__ float dpp_xor2(float v) { return __int_as_float(__builtin_amdgcn_mov_dpp(__float_as_int(v), 0x4E, 0xF, 0xF, true)); }
__device__ __forceinline__ unsigned wave_incl_scan_u(unsigned v, int lane) {
#pragma unroll
  for (int o = 1; o < 64; o <<= 1) { const unsigned t = __shfl_up(v, o); if (lane >= o) v += t; }
  return v;
}
__device__ __forceinline__ float wave_incl_scan_f(float v, int lane) {
#pragma unroll
  for (int o = 1; o < 64; o <<= 1) { const float t = __shfl_up(v, o); if (lane >= o) v += t; }
  return v;
}

__device__ __forceinline__ int ltid() { int t = threadIdx.x; asm volatile("" : "+v"(t)); return t; }

__device__ __forceinline__ float tred32(float (&a)[32], int lane) {
  float b[16], c[8], d[4], e[2];
  const bool h5 = lane & 32, h4 = lane & 16, h3 = lane & 8, h2 = lane & 4, h1 = lane & 2;
#pragma unroll
  for (int j = 0; j < 16; ++j) { const float keep = h5 ? a[16 + j] : a[j], send = h5 ? a[j] : a[16 + j]; b[j] = keep + __shfl_xor(send, 32); }
#pragma unroll
  for (int j = 0; j < 8; ++j) { const float keep = h4 ? b[8 + j] : b[j], send = h4 ? b[j] : b[8 + j]; c[j] = keep + __shfl_xor(send, 16); }
#pragma unroll
  for (int j = 0; j < 4; ++j) { const float keep = h3 ? c[4 + j] : c[j], send = h3 ? c[j] : c[4 + j]; d[j] = keep + __shfl_xor(send, 8); }
#pragma unroll
  for (int j = 0; j < 2; ++j) { const float keep = h2 ? d[2 + j] : d[j], send = h2 ? d[j] : d[2 + j]; e[j] = keep + __shfl_xor(send, 4); }
  const float keep = h1 ? e[1] : e[0], send = h1 ? e[0] : e[1];
  float v = keep + __shfl_xor(send, 2);
  v += __shfl_xor(v, 1);
  return v;
}
__device__ __forceinline__ float tred16(float (&a)[16], int lane) {
  float c[8], d[4], e[2];
  const bool h5 = lane & 32, h4 = lane & 16, h3 = lane & 8, h2 = lane & 4;
#pragma unroll
  for (int j = 0; j < 8; ++j) { const float keep = h5 ? a[8 + j] : a[j], send = h5 ? a[j] : a[8 + j]; c[j] = keep + __shfl_xor(send, 32); }
#pragma unroll
  for (int j = 0; j < 4; ++j) { const float keep = h4 ? c[4 + j] : c[j], send = h4 ? c[j] : c[4 + j]; d[j] = keep + __shfl_xor(send, 16); }
#pragma unroll
  for (int j = 0; j < 2; ++j) { const float keep = h3 ? d[2 + j] : d[j], send = h3 ? d[j] : d[2 + j]; e[j] = keep + __shfl_xor(send, 8); }
  const float keep = h2 ? e[1] : e[0], send = h2 ? e[0] : e[1];
  float v = keep + __shfl_xor(send, 4);
  v += __shfl_xor(v, 2); v += __shfl_xor(v, 1);
  return v;
}
namespace pg8 {
#define PG8_LAS __attribute__((address_space(3)))
typedef unsigned short bf16_t;
typedef short bf16x8 __attribute__((ext_vector_type(8)));
typedef float f32x4 __attribute__((ext_vector_type(4)));
typedef unsigned u32x4 __attribute__((ext_vector_type(4)));
constexpr int BM = 256, BK = 64, HALF = 128, HTB = HALF * BK * 2  , STAGE_BYTES = 8 * HTB, NXCD = 8, WGM = 8;

__host__ __device__ __forceinline__ int lds_byte(int r, int c) { const int st = (r >> 4) * 2 + (c >> 5), rr = r & 15, cc = c & 31, ob = rr * 64 + cc * 2; return st * 1024 + (ob ^ (((ob >> 9) & 1) << 5)); }
__host__ __device__ __forceinline__ void stage_rc(int b, int& R, int& C) { const int st = b / 1024, sb = b % 1024, swz = sb ^ (((sb >> 9) & 1) << 5); R = (st >> 1) * 16 + swz / 64; C = (st & 1) * 32 + (swz % 64) / 2; }
__host__ __device__ __forceinline__ int perm32(int rho) { const int n = rho >> 4, i = rho & 15; return 8 * (i >> 2) + 4 * n + (i & 3); }

struct Unit { int pm, pn; };
struct Gemm { const bf16_t* A; const bf16_t* Bt; int M, N, K; int mpe; size_t bgroup; };

struct StaticOrder {
    int nM, nN, nwg, G, c;
    __host__ __device__ void init(int M, int N, int G_, int c_) { nM = M / BM; nN = N / BM; nwg = nM * nN; G = G_; c = c_; }
    __host__ __device__ bool next(int i, Unit& u) const {
        const long L = (long)i * G + c; if (L >= nwg) return false;
        int wgid = (int)L; { const int q = nwg / NXCD, r = nwg % NXCD, xcd = wgid % NXCD, off = wgid / NXCD; wgid = (xcd < r ? xcd * (q + 1) : r * (q + 1) + (xcd - r) * q) + off; }
        const int nig = WGM * nN, gid = wgid / nig, fm = gid * WGM, gsz = (nM - fm) < WGM ? (nM - fm) : WGM;
        u.pm = fm + ((wgid % nig) % gsz); u.pn = (wgid % nig) / gsz; return true;
    }
    __device__ __forceinline__ void a_ready(const Unit&) const {}
    __device__ __forceinline__ void done(const Unit&) const {}
};


template <class Epi, class Sched, bool ALIGN_EPI = false, bool SP2 = false, bool GATHER = false>
__device__ __forceinline__ void gemm_phase(PG8_LAS unsigned char* lds, const Gemm g, const Sched& S, const Epi& E, const PG8_LAS unsigned* gtab = nullptr) {
    const int tid = threadIdx.x, wid = __builtin_amdgcn_readfirstlane(tid >> 6), lane = tid & 63, wr = wid >> 2, wc = wid & 3, fr = lane & 15, fq = lane >> 4;
    const int K = g.K, nt = K / BK;
    unsigned voffA[2], voffB[2];
#pragma unroll
    for (int i = 0; i < 2; ++i) { int R, C; stage_rc(tid * 16 + i * 8192, R, C); const int Rb = Epi::PERM ? ((R & ~31) + perm32(R & 31)) : R;
        voffA[i] = (unsigned)(R * K + C) * 2u; voffB[i] = (unsigned)(Rb * K + C) * 2u; }
    int gR0; unsigned gC; { int R, C; stage_rc(tid * 16, R, C); gR0 = R; gC = (unsigned)C * 2u; }
    unsigned go[2][2], ngo[2][2];
    const size_t kstep = (size_t)(BK * 2);
    const size_t hstep = (size_t)HALF * K * 2;
    const size_t tstep = 2 * hstep;
    const unsigned ldsw = (unsigned)wid * 1024u;
    const int aoff = lds_byte(wr * 64 + fr, fq * 8), boff = lds_byte(wc * 32 + fr, fq * 8);
#define PG8_SA(b, h) (((b) * 2 + (h)) * HTB)
#define PG8_SB(b, h) ((4 + (b) * 2 + (h)) * HTB)
#define PG8_STAGE(bufoff, gbase, voff) do { _Pragma("unroll") for (int _i = 0; _i < 2; ++_i) \
        __builtin_amdgcn_global_load_lds((const unsigned*)((const char*)(gbase) + (voff)[_i]), (PG8_LAS unsigned*)(lds + (bufoff) + ldsw + _i * 8192), 16, 0, 0); } while (0)
#define PG8_STAGE_A(bufoff, ptr_ng, kb, h, OFFS) do { if constexpr (GATHER) { PG8_STAGE(bufoff, (const char*)g.A + (kb), OFFS[h]); } else { PG8_STAGE(bufoff, (ptr_ng) + (h) * hstep, voffA); } } while (0)
#define PG8_LDA(dst, b, h) do { _Pragma("unroll") for (int m = 0; m < 4; ++m) _Pragma("unroll") for (int k = 0; k < 2; ++k) dst[m][k] = *(const PG8_LAS bf16x8*)(lds + PG8_SA(b, h) + aoff + m * 2048 + k * 1024); } while (0)
#define PG8_LDB(dst, b, h) do { _Pragma("unroll") for (int n = 0; n < 2; ++n) _Pragma("unroll") for (int k = 0; k < 2; ++k) dst[n][k] = *(const PG8_LAS bf16x8*)(lds + PG8_SB(b, h) + boff + n * 2048 + k * 1024); } while (0)
#define PG8_MMA(ai, bj, At, Bt) do { __builtin_amdgcn_s_setprio(1); _Pragma("unroll") for (int m = 0; m < 4; ++m) _Pragma("unroll") for (int n = 0; n < 2; ++n) _Pragma("unroll") for (int k = 0; k < 2; ++k) \
        acc[ai][bj][m][n] = __builtin_amdgcn_mfma_f32_16x16x32_bf16(Bt[n][k], At[m][k], acc[ai][bj][m][n], 0, 0, 0); __builtin_amdgcn_s_setprio(0); } while (0)
#define PG8_WAIT_V(n) asm volatile("s_waitcnt vmcnt(" #n ")" ::: "memory")
#define PG8_WAIT_L(n) asm volatile("s_waitcnt lgkmcnt(" #n ")" ::: "memory")
#define PG8_BAR __builtin_amdgcn_s_barrier()
#define PG8_SCHED __builtin_amdgcn_sched_barrier(0)
    Unit cur, nxt; int ui = 0;
    if (!S.next(0, cur)) return;
    f32x4 acc[2][2][4][2];
#pragma unroll
    for (int a = 0; a < 2; ++a)
#pragma unroll
        for (int b = 0; b < 2; ++b)
#pragma unroll
            for (int m = 0; m < 4; ++m)
#pragma unroll
                for (int n = 0; n < 2; ++n) acc[a][b][m][n] = (f32x4){0.f, 0.f, 0.f, 0.f};
    bf16x8 At[4][2], B0[2][2], B1[2][2];
    const char* cA = (const char*)g.A + (size_t)cur.pm * tstep; const char* cB = (const char*)g.Bt + (g.mpe ? (size_t)(cur.pm / g.mpe) * g.bgroup : (size_t)0) + (size_t)cur.pn * tstep;
    S.a_ready(cur);
    if constexpr (GATHER) {
#pragma unroll
        for (int h = 0; h < 2; ++h)
#pragma unroll
            for (int i = 0; i < 2; ++i) go[h][i] = gtab[h * 128 + gR0 + 64 * i] + gC;
    }
    if constexpr (SP2) {
        PG8_STAGE(PG8_SB(0, 0), cB, voffB); PG8_STAGE(PG8_SB(0, 1), cB + hstep, voffB); PG8_STAGE_A(PG8_SA(0, 0), cA, 0, 0, go); PG8_STAGE_A(PG8_SA(0, 1), cA, 0, 1, go);
        if (wr == 1) PG8_BAR;
        PG8_WAIT_V(2); PG8_BAR;
        PG8_STAGE(PG8_SB(1, 0), cB + kstep, voffB); PG8_STAGE_A(PG8_SA(1, 0), cA + kstep, kstep, 0, go); PG8_STAGE(PG8_SB(1, 1), cB + hstep + kstep, voffB);
        PG8_WAIT_V(6); PG8_BAR;
    } else {
        PG8_STAGE(PG8_SB(0, 0), cB, voffB); PG8_STAGE(PG8_SA(0, 0), cA, voffA); PG8_STAGE(PG8_SB(0, 1), cB + hstep, voffB); PG8_STAGE(PG8_SA(0, 1), cA + hstep, voffA);
        if (wr == 1) PG8_BAR;
        PG8_WAIT_V(4); PG8_BAR;
        PG8_STAGE(PG8_SB(1, 0), cB + kstep, voffB); PG8_STAGE(PG8_SA(1, 0), cA + kstep, voffA); PG8_STAGE(PG8_SB(1, 1), cB + hstep + kstep, voffB);
        PG8_WAIT_V(6); PG8_BAR;
    }
    for (;;) {
        const bool has_next = S.next(ui + 1, nxt);
        if constexpr (GATHER) {
#pragma unroll
            for (int h = 0; h < 2; ++h)
#pragma unroll
                for (int i = 0; i < 2; ++i) ngo[h][i] = has_next ? gtab[(ui + 1) * 256 + h * 128 + gR0 + 64 * i] + gC : go[h][i];
        }
        const char* nA = has_next ? (const char*)g.A + (size_t)nxt.pm * tstep : cA; const char* nB = has_next ? (const char*)g.Bt + (g.mpe ? (size_t)(nxt.pm / g.mpe) * g.bgroup : (size_t)0) + (size_t)nxt.pn * tstep : cB;
        for (int t = 0; t < nt; t += 2) {
            const bool last = (t == nt - 2);
            const char* a1 = cA + (size_t)(t + 1) * kstep;
            const char* a2 = last ? nA : cA + (size_t)(t + 2) * kstep; const char* b2 = last ? nB : cB + (size_t)(t + 2) * kstep;
            const char* a3 = a2 + kstep; const char* b3 = b2 + kstep;
            if (last && has_next) S.a_ready(nxt);
            unsigned s2[2][2]; size_t kb1 = 0, kb2 = 0;
            if constexpr (GATHER) {
#pragma unroll
                for (int h = 0; h < 2; ++h)
#pragma unroll
                    for (int i = 0; i < 2; ++i) s2[h][i] = last ? ngo[h][i] : go[h][i];
                kb1 = (size_t)(t + 1) * kstep; kb2 = last ? (size_t)0 : (size_t)(t + 2) * kstep;
            }
            if constexpr (SP2) {
            PG8_LDB(B0, 0, 0); PG8_LDB(B1, 0, 1); PG8_SCHED; PG8_LDA(At, 0, 0); PG8_STAGE_A(PG8_SA(1, 1), a1, kb1, 1, go);
            PG8_WAIT_V(8); PG8_WAIT_L(0); PG8_BAR; PG8_MMA(0, 0, At, B0); PG8_MMA(0, 1, At, B1); PG8_BAR; PG8_SCHED;
            PG8_LDA(At, 0, 1); PG8_STAGE(PG8_SB(0, 0), b2, voffB); PG8_STAGE(PG8_SB(0, 1), b2 + hstep, voffB); PG8_STAGE_A(PG8_SA(0, 0), a2, kb2, 0, s2);
            PG8_WAIT_V(8); PG8_WAIT_L(0); PG8_BAR; PG8_MMA(1, 0, At, B0); PG8_MMA(1, 1, At, B1); PG8_BAR; PG8_SCHED;
            PG8_LDB(B0, 1, 0); PG8_LDB(B1, 1, 1); PG8_SCHED; PG8_LDA(At, 1, 0); PG8_STAGE_A(PG8_SA(0, 1), a2, kb2, 1, s2);
            PG8_WAIT_V(8); PG8_WAIT_L(0); PG8_BAR; PG8_MMA(0, 0, At, B0); PG8_MMA(0, 1, At, B1); PG8_BAR; PG8_SCHED;
            PG8_LDA(At, 1, 1); PG8_STAGE(PG8_SB(1, 0), b3, voffB); PG8_STAGE(PG8_SB(1, 1), b3 + hstep, voffB); PG8_STAGE_A(PG8_SA(1, 0), a3, kb2 + kstep, 0, s2);
            PG8_WAIT_V(8); PG8_WAIT_L(0); PG8_BAR; PG8_MMA(1, 0, At, B0); PG8_MMA(1, 1, At, B1); PG8_BAR; PG8_SCHED;
            } else {
            PG8_LDB(B0, 0, 0); PG8_SCHED; PG8_LDA(At, 0, 0); PG8_STAGE(PG8_SA(1, 1), a1 + hstep, voffA);
            PG8_WAIT_L(8); PG8_BAR; PG8_WAIT_L(0); PG8_MMA(0, 0, At, B0); PG8_BAR; PG8_SCHED;
            PG8_LDB(B1, 0, 1); PG8_STAGE(PG8_SB(0, 0), b2, voffB);
            PG8_BAR; PG8_WAIT_L(0); PG8_MMA(0, 1, At, B1); PG8_BAR;
            PG8_LDA(At, 0, 1); PG8_STAGE(PG8_SA(0, 0), a2, voffA);
            PG8_BAR; PG8_WAIT_L(0); PG8_MMA(1, 0, At, B0); PG8_BAR; PG8_SCHED;
            PG8_STAGE(PG8_SB(0, 1), b2 + hstep, voffB);
            PG8_WAIT_V(6); PG8_BAR; PG8_MMA(1, 1, At, B1); PG8_BAR;
            PG8_LDB(B0, 1, 0); PG8_SCHED; PG8_LDA(At, 1, 0); PG8_STAGE(PG8_SA(0, 1), a2 + hstep, voffA);
            PG8_WAIT_L(8); PG8_BAR; PG8_WAIT_L(0); PG8_MMA(0, 0, At, B0); PG8_BAR; PG8_SCHED;
            PG8_LDB(B1, 1, 1); PG8_STAGE(PG8_SB(1, 0), b3, voffB);
            PG8_BAR; PG8_WAIT_L(0); PG8_MMA(0, 1, At, B1); PG8_BAR;
            PG8_LDA(At, 1, 1); PG8_STAGE(PG8_SA(1, 0), a3, voffA);
            PG8_BAR; PG8_WAIT_L(0); PG8_MMA(1, 0, At, B0); PG8_BAR; PG8_SCHED;
            PG8_STAGE(PG8_SB(1, 1), b3 + hstep, voffB);
            PG8_WAIT_V(6); PG8_BAR; PG8_MMA(1, 1, At, B1); PG8_BAR;
            }
        }
        if constexpr (ALIGN_EPI) { if (wr == 0) PG8_BAR; }
        if constexpr (!Epi::AFTER_DRAIN) { E(acc, cur, wr, wc, fr, fq); S.done(cur); }
        if (!has_next) break;
#pragma unroll
        for (int a = 0; a < 2; ++a)
#pragma unroll
            for (int b = 0; b < 2; ++b)
#pragma unroll
                for (int m = 0; m < 4; ++m)
#pragma unroll
                    for (int n = 0; n < 2; ++n) acc[a][b][m][n] = (f32x4){0.f, 0.f, 0.f, 0.f};
        cur = nxt; cA = nA; cB = nB; ++ui;
        if constexpr (GATHER) {
#pragma unroll
            for (int h = 0; h < 2; ++h)
#pragma unroll
                for (int i = 0; i < 2; ++i) go[h][i] = ngo[h][i];
        }
        if constexpr (ALIGN_EPI) { if (wr == 1) PG8_BAR; }
    }
    PG8_WAIT_V(0);
    if constexpr (!ALIGN_EPI) { if (wr == 0) PG8_BAR; }
    PG8_BAR;
    if constexpr (Epi::AFTER_DRAIN) { E.fused(acc, cur, wr, wc, fr, fq, lds, wid, lane); S.done(cur); }
#undef PG8_SA
#undef PG8_SB
#undef PG8_STAGE
#undef PG8_STAGE_A
#undef PG8_LDA
#undef PG8_LDB
#undef PG8_MMA
#undef PG8_WAIT_V
#undef PG8_WAIT_L
#undef PG8_BAR
#undef PG8_SCHED
}
}

using pg8::Unit;
struct EpiStoreBf16 {
  static constexpr bool PERM = true, AFTER_DRAIN = false;
  bf16_t* O; int ldc; const float* rowscale;
  __device__ __forceinline__ void operator()(const f32x4 (&acc)[2][2][4][2], const Unit& u, int wr, int wc, int fr, int fq) const {
    const int row0 = u.pm * 256 + wr * 64 + fr, col0 = u.pn * 256 + wc * 32 + 8 * fq;
#pragma unroll
    for (int ai = 0; ai < 2; ++ai)
#pragma unroll
      for (int m = 0; m < 4; ++m) {
        const int row = row0 + ai * 128 + m * 16;
        const float sc = rowscale ? rowscale[(row >> 11) * SLOTS + (row & 2047)] : 1.f;
#pragma unroll
        for (int bj = 0; bj < 2; ++bj) {
          const f32x4 v0 = acc[ai][bj][m][0] * sc, v1 = acc[ai][bj][m][1] * sc;
          u32x4 w; w.x = pk2(v0.x, v0.y); w.y = pk2(v0.z, v0.w); w.z = pk2(v1.x, v1.y); w.w = pk2(v1.z, v1.w);
          *(u32x4*)(O + (size_t)row * ldc + col0 + bj * 128) = w;
        }
      }
  }
};
struct EpiResid {
  static constexpr bool PERM = true, AFTER_DRAIN = false;
  const float* Hin; float* H; const float* G1;
  __device__ __forceinline__ void operator()(const f32x4 (&acc)[2][2][4][2], const Unit& u, int wr, int wc, int fr, int fq) const {
    const int row0 = u.pm * 256 + wr * 64 + fr, col0 = u.pn * 256 + wc * 32 + 8 * fq;
    const float* g1 = G1 + ((u.pm * 256) >> 13) * 6144;
#pragma unroll
    for (int bj = 0; bj < 2; ++bj) {
      const int col = col0 + bj * 128;
      const f32x4 g0 = *(const f32x4*)(g1 + col), g4 = *(const f32x4*)(g1 + col + 4);
#pragma unroll
      for (int ai = 0; ai < 2; ++ai)
#pragma unroll
        for (int m = 0; m < 4; ++m) {
          const size_t ho = (size_t)(row0 + ai * 128 + m * 16) * DM + col;
          f32x4 h0 = *(const f32x4*)(Hin + ho), h1 = *(const f32x4*)(Hin + ho + 4);
          h0 += g0 * acc[ai][bj][m][0]; h1 += g4 * acc[ai][bj][m][1];
          *(f32x4*)(H + ho) = h0; *(f32x4*)(H + ho + 4) = h1;
        }
    }
  }
};
struct EpiMoe1 {
  static constexpr bool PERM = true, AFTER_DRAIN = false;
  bf16_t* HID;
  __device__ __forceinline__ void operator()(const f32x4 (&acc)[2][2][4][2], const Unit& u, int wr, int wc, int fr, int fq) const {
    const int row0 = u.pm * 256 + wr * 64 + fr, f0 = u.pn * 128 + wc * 32 + 8 * fq;
#pragma unroll
    for (int ai = 0; ai < 2; ++ai)
#pragma unroll
      for (int m = 0; m < 4; ++m) {
        const f32x4 g0 = acc[ai][0][m][0], g1 = acc[ai][0][m][1], u0 = acc[ai][1][m][0], u1 = acc[ai][1][m][1];
        u32x4 o; o.x = pk2(silu_f(g0.x) * u0.x, silu_f(g0.y) * u0.y); o.y = pk2(silu_f(g0.z) * u0.z, silu_f(g0.w) * u0.w);
        o.z = pk2(silu_f(g1.x) * u1.x, silu_f(g1.y) * u1.y); o.w = pk2(silu_f(g1.z) * u1.z, silu_f(g1.w) * u1.w);
        *(u32x4*)(HID + (size_t)(row0 + ai * 128 + m * 16) * DM + f0) = o;
      }
  }
};
template <class Epi>
__device__ __forceinline__ void big_gemm(char* lds, const bf16_t* A, const bf16_t* Bt, int M, int N, int mpe, size_t bgroup, const Epi& E) {
  pg8::Gemm g{A, Bt, M, N, DM, mpe, bgroup};
  pg8::StaticOrder S; S.init(M, N, (int)gridDim.x, (int)blockIdx.x);
  pg8::gemm_phase<Epi, pg8::StaticOrder, true, true>((PG8_LAS unsigned char*)lds, g, S, E);
}

template <class Epi>
__device__ __forceinline__ void big_gemm_gather(char* lds, const bf16_t* A, const int* IDX, const bf16_t* Bt, int M, int N, int mpe, size_t bgroup, const Epi& E) {
  pg8::Gemm g{A, Bt, M, N, DM, mpe, bgroup};
  pg8::StaticOrder S; S.init(M, N, (int)gridDim.x, (int)blockIdx.x);
  unsigned* gtab = (unsigned*)(lds + pg8::STAGE_BYTES);
  for (int i = ltid(); i < 1024; i += NT) {
    pg8::Unit u;
    if (S.next(i >> 8, u)) { const int r = u.pm * 256 + (i & 255); gtab[i] = (unsigned)IDX[(r >> 11) * SLOTS + (r & 2047)] * (unsigned)(DM * 2); }
  }
  __syncthreads();
  pg8::gemm_phase<Epi, pg8::StaticOrder, true, true, true>((PG8_LAS unsigned char*)lds, g, S, E, (const PG8_LAS unsigned*)(lds + pg8::STAGE_BYTES));
}

template <class Op>
__device__ __forceinline__ void gemm_tile_h(const Op& op, int tile, char* lds_all) {
  const int half = ltid() >> 8;
  char* lds = lds_all + half * 65536;
  const int tid = ltid() & 255, lane = tid & 63, wid = tid >> 6, wr = wid >> 1, wc = wid & 1, fr = lane & 15, fq = lane >> 4;
  const int lrow = tid >> 3, lc = tid & 7;
  const bf16_t* ap[4]; const bf16_t* bp[4];
#pragma unroll
  for (int i = 0; i < 4; ++i) { ap[i] = op.arow(tile, lrow + 32 * i) + lc * 8 + half * 512; bp[i] = op.brow(tile, lrow + 32 * i) + lc * 8 + half * 512; }
  const int woff = lrow * 128 + ((lc ^ ((lrow >> 1) & 7)) << 4);
  char* As = lds; char* Bs = lds + 32768;
  f32x4 acc[4][4];
#pragma unroll
  for (int m = 0; m < 4; ++m)
#pragma unroll
    for (int n = 0; n < 4; ++n) acc[m][n] = (f32x4){0.f, 0.f, 0.f, 0.f};
  u32x4 ra0[4], rb0[4], ra1[4], rb1[4], ra2[4], rb2[4];
#define GT_LOAD(R, KT) do { _Pragma("unroll") for (int i = 0; i < 4; ++i) { ra##R[i] = *(const u32x4*)(ap[i] + (KT) * 64); rb##R[i] = *(const u32x4*)(bp[i] + (KT) * 64); } } while (0)
#define GT_STORE(R, BUF) do { const int nb_ = (BUF) * 16384; _Pragma("unroll") for (int i = 0; i < 4; ++i) { *(u32x4*)(As + nb_ + woff + i * 4096) = ra##R[i]; *(u32x4*)(Bs + nb_ + woff + i * 4096) = rb##R[i]; } } while (0)
#define GT_COMPUTE(BUF) do { const char* A_ = As + (BUF) * 16384; const char* B_ = Bs + (BUF) * 16384; \
    _Pragma("unroll") for (int ks = 0; ks < 2; ++ks) { bf16x8 af[4], bfr[4]; const int co = ((ks * 4 + fq) ^ sw) << 4; \
      _Pragma("unroll") for (int m = 0; m < 4; ++m) af[m] = *(const bf16x8*)(A_ + arow0 + m * 2048 + co); \
      _Pragma("unroll") for (int n = 0; n < 4; ++n) bfr[n] = *(const bf16x8*)(B_ + brow0 + n * 2048 + co); \
      _Pragma("unroll") for (int m = 0; m < 4; ++m) _Pragma("unroll") for (int n = 0; n < 4; ++n) acc[m][n] = __builtin_amdgcn_mfma_f32_16x16x32_bf16(bfr[n], af[m], acc[m][n], 0, 0, 0); } } while (0)
  const int sw = (fr >> 1) & 7;
  const int arow0 = (wr * 64 + fr) * 128, brow0 = (wc * 64 + fr) * 128;
  GT_LOAD(0, 0); GT_LOAD(1, 1); GT_LOAD(2, 2);
  __syncthreads();
  GT_STORE(0, 0);
  GT_LOAD(0, 3);
  __syncthreads();
  GT_COMPUTE(0); GT_STORE(1, 1); GT_LOAD(1, 4); __syncthreads();
  GT_COMPUTE(1); GT_STORE(2, 0); GT_LOAD(2, 5); __syncthreads();
  GT_COMPUTE(0); GT_STORE(0, 1); GT_LOAD(0, 6); __syncthreads();
  GT_COMPUTE(1); GT_STORE(1, 0); GT_LOAD(1, 7); __syncthreads();
  GT_COMPUTE(0); GT_STORE(2, 1); __syncthreads();
  GT_COMPUTE(1); GT_STORE(0, 0); __syncthreads();
  GT_COMPUTE(0); GT_STORE(1, 1); __syncthreads();
  GT_COMPUTE(1); __syncthreads();
#undef GT_LOAD
#undef GT_STORE
#undef GT_COMPUTE
  f32x4* red = (f32x4*)(lds_all + 65536) + tid;
  if (half == 1) {
#pragma unroll
    for (int m = 0; m < 4; ++m)
#pragma unroll
      for (int n = 0; n < 4; ++n) red[(m * 4 + n) * 256] = acc[m][n];
  }
  __syncthreads();
  if (half == 0) {
#pragma unroll
    for (int m = 0; m < 4; ++m)
#pragma unroll
      for (int n = 0; n < 4; ++n) acc[m][n] += red[(m * 4 + n) * 256];
    op.epilogue(tile, acc, wr, wc, fr, fq);
  }
}
template <class Op>
__device__ __forceinline__ void gemm_small_phase(const Op& op, char* lds) {
  for (int t = (int)gridDim.x - 1 - (int)blockIdx.x; t < op.ntiles; t += gridDim.x) gemm_tile_h(op, t, lds);
}
template <int LAYER>
struct OpInProjCtx {
  const bf16_t* A; const bf16_t* W; bf16_t* PROJ; int ntiles;
  static constexpr int NTN = (LAYER == 0) ? 23 : 16, NOFF = (LAYER == 0) ? 0 : 8;
  __device__ __forceinline__ const bf16_t* arow(int t, int i) const { return A + (size_t)(MLAT + (t / NTN) * 128 + i) * DM; }
  __device__ __forceinline__ const bf16_t* brow(int t, int i) const { return W + (size_t)((t % NTN + NOFF) * 128 + i) * DM; }
  __device__ __forceinline__ void epilogue(int t, const f32x4 (&acc)[4][4], int wr, int wc, int fr, int fq) const {
    const int row0 = MLAT + (t / NTN) * 128 + wr * 64 + fr, col0 = (t % NTN + NOFF) * 128 + wc * 64 + fq * 4;
#pragma unroll
    for (int m = 0; m < 4; ++m)
#pragma unroll
      for (int n = 0; n < 4; ++n) { const f32x4 v = acc[m][n]; u32x2 o; o.x = pk2(v.x, v.y); o.y = pk2(v.z, v.w); *(u32x2*)(PROJ + (size_t)(row0 + m * 16) * PROJ_LD + col0 + n * 16) = o; }
  }
};
struct OpOutProjCtx {
  const bf16_t* MIX; const bf16_t* W; const float* G1; float* hc; int ntiles;
  __device__ __forceinline__ const bf16_t* arow(int t, int i) const { return MIX + (size_t)(MLAT + (t >> 3) * 128 + i) * DM; }
  __device__ __forceinline__ const bf16_t* brow(int t, int i) const { return W + (size_t)((t & 7) * 128 + i) * DM; }
  __device__ __forceinline__ void epilogue(int t, const f32x4 (&acc)[4][4], int wr, int wc, int fr, int fq) const {
    const int row0 = (t >> 3) * 128 + wr * 64 + fr, col0 = (t & 7) * 128 + wc * 64 + fq * 4;
#pragma unroll
    for (int m = 0; m < 4; ++m)
#pragma unroll
      for (int n = 0; n < 4; ++n) { const int col = col0 + n * 16; float* hp = hc + (size_t)(row0 + m * 16) * DM + col; const f32x4 g = *(const f32x4*)(G1 + col); f32x4 h = *(const f32x4*)hp; h += g * acc[m][n]; *(f32x4*)hp = h; }
  }
};
__device__ __forceinline__ int gu_row(int f, int which) { return 256 * (f >> 7) + 128 * which + (f & 127); }
struct OpMoe1Ctx {
  const bf16_t* A; const bf16_t* WEXP; const int* IDX; bf16_t* HIDC; int ntiles;
  __device__ __forceinline__ const bf16_t* arow(int t, int i) const { const int e = t >> 4; const int row = (i < 64) ? IDX[e * SLOTS + 2048 + i] : MLAT; return A + (size_t)row * DM; }
  __device__ __forceinline__ const bf16_t* brow(int t, int i) const {
    const int e = t >> 4, nt = t & 15, wc = i >> 6, n = (i >> 4) & 3, fr = i & 15;
    const int f = nt * 64 + wc * 32 + (n & 1) * 16 + fr;
    return WEXP + (size_t)e * EXPW + (size_t)gu_row(f, n >> 1) * DM;
  }
  __device__ __forceinline__ void epilogue(int t, const f32x4 (&acc)[4][4], int wr, int wc, int fr, int fq) const {
    const int e = t >> 4, nt = t & 15;
    if (wr == 0) {
#pragma unroll
      for (int m = 0; m < 4; ++m) {
        const int slot = m * 16 + fr;
#pragma unroll
        for (int nn = 0; nn < 2; ++nn) {
          const f32x4 g = acc[m][nn], u = acc[m][nn + 2]; const int f = nt * 64 + wc * 32 + nn * 16 + fq * 4;
          u32x2 o; o.x = pk2(silu_f(g.x) * u.x, silu_f(g.y) * u.y); o.y = pk2(silu_f(g.z) * u.z, silu_f(g.w) * u.w);
          *(u32x2*)(HIDC + (size_t)(e * 64 + slot) * DM + f) = o;
        }
      }
    }
  }
};
struct OpMoe2Ctx {
  const bf16_t* HIDC; const bf16_t* WEXP; const float* GATEV; bf16_t* YC; int ntiles;
  __device__ __forceinline__ const bf16_t* arow(int t, int i) const { const int e = t >> 3; return HIDC + (size_t)(e * 64 + (i & 63)) * DM; }
  __device__ __forceinline__ const bf16_t* brow(int t, int i) const { const int e = t >> 3, nt = t & 7; return WEXP + (size_t)e * EXPW + (size_t)(2048 + nt * 128 + i) * DM; }
  __device__ __forceinline__ void epilogue(int t, const f32x4 (&acc)[4][4], int wr, int wc, int fr, int fq) const {
    const int e = t >> 3, nt = t & 7;
    if (wr == 0) {
#pragma unroll
      for (int m = 0; m < 4; ++m) {
        const int slot = m * 16 + fr; const float gv = GATEV[e * SLOTS + 2048 + slot];
#pragma unroll
        for (int n = 0; n < 4; ++n) { const f32x4 v = acc[m][n] * gv; u32x2 o; o.x = pk2(v.x, v.y); o.y = pk2(v.z, v.w); *(u32x2*)(YC + (size_t)(e * 64 + slot) * DM + nt * 128 + wc * 64 + n * 16 + fq * 4) = o; }
      }
    }
  }
};

__device__ __forceinline__ void transpose_item(const float* W, int N, int k0, int n0, bf16_t* dst, int drow0, float* scr, int lane) {
  f32x4 tv[8];
#pragma unroll
  for (int i = 0; i < 8; ++i) { const int kk = 8 * i + (lane >> 3); tv[i] = *(const f32x4*)(W + (size_t)(k0 + kk) * N + n0 + 4 * (lane & 7)); }
#pragma unroll
  for (int i = 0; i < 8; ++i) { const int kk = 8 * i + (lane >> 3); float* d = scr + kk * 33 + 4 * (lane & 7); d[0] = tv[i].x; d[1] = tv[i].y; d[2] = tv[i].z; d[3] = tv[i].w; }
  __builtin_amdgcn_s_waitcnt(0); __builtin_amdgcn_wave_barrier();
  const int c = lane & 7;
#pragma unroll
  for (int j = 0; j < 4; ++j) {
    const int n = (lane >> 3) + 8 * j; const float* s = scr + (8 * c) * 33 + n;
    u32x4 o; o.x = pk2(s[0], s[33]); o.y = pk2(s[66], s[99]); o.z = pk2(s[132], s[165]); o.w = pk2(s[198], s[231]);
    *(u32x4*)(dst + (size_t)(drow0 + n) * 1024 + k0 + 8 * c) = o;
  }
  __builtin_amdgcn_s_waitcnt(0); __builtin_amdgcn_wave_barrier();
}
__device__ __forceinline__ int even_col_map(int c) {
  if (c < 2048) return c;
  if (c < 2080) return 2816 + (c - 2048);
  if (c < 2592) return 2048 + (c - 2080);
  if (c < 2720) return 2560 + (c - 2592);
  return 2688 + (c - 2720);
}
__device__ __forceinline__ void convert_experts(const Params& p, int layer, char* lds, bf16_t* dstb, int it0, int it1, int gw, int ngw) {
  const int lane = ltid() & 63, wave = ltid() >> 6;
  float* scr = (float*)lds + wave * (64 * 33);
  constexpr int SPM = 16 * 8;
  for (int it = it0 + gw; it < it1; it += ngw) {
    const int mat = it / SPM, r = it % SPM, e = mat / 3, which = mat % 3;
    const float* src = (which == 0 ? p.w_gate : which == 1 ? p.w_up : p.w_down) + ((size_t)layer * 16 + e) * 1024 * 1024;
    const int k0 = (r >> 3) * 64, ns = (r & 7) * 128;
    bf16_t* dst = dstb + (size_t)e * EXPW;
    f32x4 tv[4][8];
#pragma unroll
    for (int sb = 0; sb < 4; ++sb)
#pragma unroll
      for (int i = 0; i < 8; ++i) { const int kk = 8 * i + (lane >> 3); tv[sb][i] = *(const f32x4*)(src + (size_t)(k0 + kk) * 1024 + ns + sb * 32 + 4 * (lane & 7)); }
#pragma unroll
    for (int sb = 0; sb < 4; ++sb) {
      const int n0 = ns + sb * 32;
      const int drow = (which == 2) ? 2048 + n0 : gu_row(n0, which);
#pragma unroll
      for (int i = 0; i < 8; ++i) { const int kk = 8 * i + (lane >> 3); float* d = scr + kk * 33 + 4 * (lane & 7); d[0] = tv[sb][i].x; d[1] = tv[sb][i].y; d[2] = tv[sb][i].z; d[3] = tv[sb][i].w; }
      __builtin_amdgcn_s_waitcnt(0xc07f); __builtin_amdgcn_wave_barrier();
      const int c = lane & 7;
#pragma unroll
      for (int j = 0; j < 4; ++j) {
        const int n = (lane >> 3) + 8 * j; const float* sp = scr + (8 * c) * 33 + n;
        u32x4 o; o.x = pk2(sp[0], sp[33]); o.y = pk2(sp[66], sp[99]); o.z = pk2(sp[132], sp[165]); o.w = pk2(sp[198], sp[231]);
        *(u32x4*)(dst + (size_t)(drow + n) * 1024 + k0 + 8 * c) = o;
      }
      __builtin_amdgcn_s_waitcnt(0xc07f); __builtin_amdgcn_wave_barrier();
    }
  }
}
__device__ __forceinline__ void phase0(const Params& p, char* lds) {
  const int tid = ltid(), lane = tid & 63, wave = tid >> 6;
  const int gw = blockIdx.x * NWV + wave, ngw = gridDim.x * NWV;
  const int gt = blockIdx.x * NT + tid, ngt = gridDim.x * NT;
  if (blockIdx.x == 0 && tid < 64) ((unsigned*)(p.ws + WS_CTL))[tid] = 0u;
  {
    float* rc = (float*)(p.ws + WS_ROPE); float* rs = rc + 8192 * 32;
    for (int i = gt; i < 8192 * 32; i += ngt) {
      const int t = i >> 5, f = i & 31;
      const float pos = (f < 16) ? (float)(t >> 6) : (float)(t & 63);
      const float inv = powf(10000.f, -(float)(f & 15) * (1.f / 16.f));
      float sn, cs; sincos_d(pos * inv, sn, cs);
      rc[i] = cs; rs[i] = sn;
    }
  }
  if (blockIdx.x < 192) {
    float* sv = (float*)lds;
    float* red = sv + 3072;
    for (int i = tid; i < 3072; i += NT) { const int v = i >> 10, k = i & 1023; const float cv = (v < 2) ? p.c[v * 1024 + k] : p.c_ctx[k]; sv[i] = silu_f(cv); }
    __syncthreads();
    for (int task = blockIdx.x; task < 192; task += gridDim.x) {
      const int l = task / 96, col = (task % 96) * 64 + lane;
      const float* W = p.ada_w + (size_t)l * 1024 * 6144 + col;
      float a0 = 0.f, a1 = 0.f, a2 = 0.f;
      const int kb = wave * 128;
#pragma unroll 16
      for (int k = 0; k < 128; ++k) { const float w = W[(size_t)(kb + k) * 6144]; a0 += sv[kb + k] * w; a1 += sv[1024 + kb + k] * w; a2 += sv[2048 + kb + k] * w; }
      red[(wave * 3 + 0) * 64 + lane] = a0; red[(wave * 3 + 1) * 64 + lane] = a1; red[(wave * 3 + 2) * 64 + lane] = a2;
      __syncthreads();
      if (wave < 3) {
        float s = 0.f;
#pragma unroll
        for (int w8 = 0; w8 < 8; ++w8) s += red[(w8 * 3 + wave) * 64 + lane];
        ((float*)(p.ws + WS_MOD))[(l * 3 + wave) * 6144 + col] = s + p.ada_b[l * 6144 + col];
      }
      __syncthreads();
    }
  }
  __syncthreads();
  {
    float* scr = (float*)lds + wave * (64 * 33);
    for (int it = gw; it < 16 * 89; it += ngw) { const int kb = it / 89, nb = it % 89; transpose_item(p.even_w_in, 2848, kb * 64, nb * 32, (bf16_t*)(p.ws + WS_WEI), even_col_map(nb * 32), scr, lane); }
    for (int i = gt; i < 224 * 1024 / 8; i += ngt) ((u32x4*)((bf16_t*)(p.ws + WS_WEI) + (size_t)2848 * 1024))[i] = (u32x4){0u, 0u, 0u, 0u};
    for (int it = gw; it < 16 * 32; it += ngw) transpose_item(p.even_w_out, 1024, (it / 32) * 64, (it % 32) * 32, (bf16_t*)(p.ws + WS_WEO), (it % 32) * 32, scr, lane);
    for (int it = gw; it < 16 * 96; it += ngw) transpose_item(p.odd_w_in, 3072, (it / 96) * 64, (it % 96) * 32, (bf16_t*)(p.ws + WS_WOI), (it % 96) * 32, scr, lane);
    for (int it = gw; it < 16 * 32; it += ngw) transpose_item(p.odd_w_out, 1024, (it / 32) * 64, (it % 32) * 32, (bf16_t*)(p.ws + WS_WOO), (it % 32) * 32, scr, lane);
  }
}

template <int LAYER, bool FINAL>
__device__ __forceinline__ void rowpass_a(const Params& p, char* lds) {
  const int tid = ltid(), lane = tid & 63, wave = tid >> 6;
  const int gw = blockIdx.x * NWV + wave, ngw = gridDim.x * NWV;
  const float* MOD = (const float*)(p.ws + WS_MOD);
  const int* INV = (const int*)(p.ws + WS_INV);
  const bf16_t* YL = (const bf16_t*)(p.ws + WS_YL);
  const bf16_t* YC = (const bf16_t*)(p.ws + WS_YC);
  bf16_t* A = (bf16_t*)(p.ws + WS_A);
  float* GATES = (float*)(p.ws + WS_GATES);
  float* wg = (float*)lds;
  const int nrows = FINAL ? MLAT : NR;
  auto srcrow = [&](int r) -> const float* {
    if (LAYER == 0 && !FINAL) return (r < MLAT) ? p.x + (size_t)r * DM : p.ctx + (size_t)(r - MLAT) * DM;
    return hrow_ptr(p, r);
  };
  int vcur = -1, vcur2 = -1; f32x4 mg[4], ms[4], mg2[4], fg[4];
#pragma unroll
  for (int j = 0; j < 4; ++j) { mg[j] = (f32x4){0.f, 0.f, 0.f, 0.f}; ms[j] = mg[j]; mg2[j] = mg[j]; fg[j] = FINAL ? ((const f32x4*)p.final_g)[lane + 64 * j] : mg[j]; }
  constexpr bool COMB = !(LAYER == 0 && !FINAL);
  constexpr int PL = FINAL ? 1 : (LAYER > 0 ? LAYER - 1 : 0);
  f32x4 nx[4]; int cinv = -1, ainv = -1; u32x2 ny[4][4]; float nw[4] = {0.f, 0.f, 0.f, 0.f}; unsigned nrest = 0u;
#pragma unroll
  for (int k = 0; k < 4; ++k)
#pragma unroll
    for (int j = 0; j < 4; ++j) ny[k][j] = (u32x2){0u, 0u};
  auto yptr = [&](int e, int sl) -> const bf16_t* { return (sl < 2048) ? YL + ((size_t)e * 2048 + sl) * DM : YC + ((size_t)e * 64 + (sl - 2048)) * DM; };
#define RPA_ISSUE_Y(INVREG) do { unsigned m_ = (unsigned)__ballot((INVREG) >= 0) & 0xFFFFu; const bf16_t* yp_[4]; \
    _Pragma("unroll") for (int k = 0; k < 4; ++k) { \
      if (m_) { const int e_ = __ffs(m_) - 1; m_ &= m_ - 1u; yp_[k] = yptr(e_, __builtin_amdgcn_readlane((INVREG), e_)); nw[k] = 1.f; } \
      else { yp_[k] = k ? yp_[0] : YL; nw[k] = 0.f; } } \
    nrest = m_; \
    _Pragma("unroll") for (int k = 0; k < 4; ++k) _Pragma("unroll") for (int j = 0; j < 4; ++j) ny[k][j] = *(const u32x2*)(yp_[k] + 4 * (lane + 64 * j)); } while (0)
  if (gw < nrows) {
    const float* s0 = srcrow(gw);
#pragma unroll
    for (int j = 0; j < 4; ++j) nx[j] = ((const f32x4*)s0)[lane + 64 * j];
    if (COMB) {
      cinv = INV[gw * 16 + (lane & 15)];
      const int r1 = (gw + ngw < nrows) ? gw + ngw : gw;
      ainv = INV[r1 * 16 + (lane & 15)];
      RPA_ISSUE_Y(cinv);
    }
  }
  for (int r = gw; r < nrows; r += ngw) {
    const int v = row_sel(r);
    float* hp = hrow_ptr(p, r);
    f32x4 hv[4]; u32x2 cy[4][4]; float cw[4]; const unsigned crest = nrest; const int myinv = cinv;
#pragma unroll
    for (int j = 0; j < 4; ++j) hv[j] = nx[j];
    if (COMB) {
#pragma unroll
      for (int k = 0; k < 4; ++k) { cw[k] = nw[k];
#pragma unroll
        for (int j = 0; j < 4; ++j) cy[k][j] = ny[k][j]; }
    }
    {
      const int rn = (r + ngw < nrows) ? r + ngw : r;
      const float* s1 = srcrow(rn);
#pragma unroll
      for (int j = 0; j < 4; ++j) nx[j] = ((const f32x4*)s1)[lane + 64 * j];
      if (COMB) {
        const int rn2 = (rn + ngw < nrows) ? rn + ngw : rn;
        cinv = ainv;
        RPA_ISSUE_Y(cinv);
        ainv = INV[rn2 * 16 + (lane & 15)];
      }
    }
    if (!COMB) {
#pragma unroll
      for (int j = 0; j < 4; ++j) ((f32x4*)hp)[lane + 64 * j] = hv[j];
    } else {
      f32x4 acc[4];
#pragma unroll
      for (int j = 0; j < 4; ++j) acc[j] = (f32x4){0.f, 0.f, 0.f, 0.f};
#pragma unroll
      for (int k = 0; k < 4; ++k)
#pragma unroll
        for (int j = 0; j < 4; ++j) { const u32x2 w = cy[k][j]; acc[j].x += cw[k] * bflo(w.x); acc[j].y += cw[k] * bfhi(w.x); acc[j].z += cw[k] * bflo(w.y); acc[j].w += cw[k] * bfhi(w.y); }
      for (unsigned m = crest; m; m &= m - 1u) {
        const int e = __ffs(m) - 1;
        const bf16_t* yr = yptr(e, __builtin_amdgcn_readlane(myinv, e));
#pragma unroll
        for (int j = 0; j < 4; ++j) { const u32x2 w = *(const u32x2*)(yr + 4 * (lane + 64 * j)); acc[j].x += bflo(w.x); acc[j].y += bfhi(w.x); acc[j].z += bflo(w.y); acc[j].w += bfhi(w.y); }
      }
      if (v != vcur2) {
        vcur2 = v;
        const float* g2 = MOD + (PL * 3 + v) * 6144 + 5 * 1024;
#pragma unroll
        for (int j = 0; j < 4; ++j) mg2[j] = ((const f32x4*)g2)[lane + 64 * j];
      }
#pragma unroll
      for (int j = 0; j < 4; ++j) hv[j] += mg2[j] * acc[j];
      if (!FINAL) {
#pragma unroll
        for (int j = 0; j < 4; ++j) ((f32x4*)hp)[lane + 64 * j] = hv[j];
      }
    }
#undef RPA_ISSUE_Y
    float ss = 0.f;
#pragma unroll
    for (int j = 0; j < 4; ++j) ss += hv[j].x * hv[j].x + hv[j].y * hv[j].y + hv[j].z * hv[j].z + hv[j].w * hv[j].w;
    ss = wave_sum(ss);
    const float rs = rsqrtf(ss * (1.f / DM) + EPS);
    if (FINAL) {
#pragma unroll
      for (int j = 0; j < 4; ++j) ((f32x4*)hp)[lane + 64 * j] = hv[j] * rs * fg[j];
    } else {
      if (v != vcur) {
        vcur = v;
        const float* lg = p.ln1_g + LAYER * DM;
        const float* sh = MOD + (LAYER * 3 + v) * 6144;
        const float* sc = sh + 1024;
#pragma unroll
        for (int j = 0; j < 4; ++j) { mg[j] = ((const f32x4*)lg)[lane + 64 * j] * (1.f + ((const f32x4*)sc)[lane + 64 * j]); ms[j] = ((const f32x4*)sh)[lane + 64 * j]; }
      }
#pragma unroll
      for (int j = 0; j < 4; ++j) {
        hv[j] = (hv[j] * rs) * mg[j] + ms[j];
        u32x2 o; o.x = pk2(hv[j].x, hv[j].y); o.y = pk2(hv[j].z, hv[j].w);
        *(u32x2*)(A + (size_t)r * DM + 4 * (lane + 64 * j)) = o;
      }
    }
  }
}

template <int LAYER>
__device__ __forceinline__ void rowpass_b(const Params& p, char* lds) {
  const int tid = ltid(), lane = tid & 63, wave = tid >> 6;
  const int gw = blockIdx.x * NWV + wave, ngw = gridDim.x * NWV;
  float* wt = (float*)lds;
  const float* rw = p.router_w + (size_t)LAYER * 1024 * 16;
  for (int i = tid; i < 16384; i += NT) { const int k = i >> 4, e = i & 15; wt[e * 1024 + k] = rw[i]; }
  __syncthreads();
  const float* MOD = (const float*)(p.ws + WS_MOD);
  float* AFF = (float*)(p.ws + WS_AFF);
  int* INV = (int*)(p.ws + WS_INV);
  bf16_t* A = (bf16_t*)(p.ws + WS_A);
  const int nrows = (LAYER == 0) ? NR : MLAT;
  f32x4 nx[4];
  if (gw < nrows) {
    const float* s0 = hrow_ptr(p, gw);
#pragma unroll
    for (int j = 0; j < 4; ++j) nx[j] = ((const f32x4*)s0)[lane + 64 * j];
  }
  int vcur = -1; f32x4 mg[4], ms[4];
#pragma unroll
  for (int j = 0; j < 4; ++j) { mg[j] = (f32x4){0.f, 0.f, 0.f, 0.f}; ms[j] = mg[j]; }
  for (int r = gw; r < nrows; r += ngw) {
    const int v = row_sel(r);
    f32x4 hv[4];
#pragma unroll
    for (int j = 0; j < 4; ++j) hv[j] = nx[j];
    {
      const float* s1 = hrow_ptr(p, (r + ngw < nrows) ? r + ngw : r);
#pragma unroll
      for (int j = 0; j < 4; ++j) nx[j] = ((const f32x4*)s1)[lane + 64 * j];
    }
    float ss = 0.f;
#pragma unroll
    for (int j = 0; j < 4; ++j) ss += hv[j].x * hv[j].x + hv[j].y * hv[j].y + hv[j].z * hv[j].z + hv[j].w * hv[j].w;
    ss = wave_sum(ss);
    const float rs = rsqrtf(ss * (1.f / DM) + EPS);
    if (v != vcur) {
      vcur = v;
      const float* lg = p.ln2_g + LAYER * DM;
      const float* sh = MOD + (LAYER * 3 + v) * 6144 + 3 * 1024;
      const float* sc = sh + 1024;
#pragma unroll
      for (int j = 0; j < 4; ++j) { mg[j] = ((const f32x4*)lg)[lane + 64 * j] * (1.f + ((const f32x4*)sc)[lane + 64 * j]); ms[j] = ((const f32x4*)sh)[lane + 64 * j]; }
    }
#pragma unroll
    for (int j = 0; j < 4; ++j) {
      hv[j] = (hv[j] * rs) * mg[j] + ms[j];
      u32x2 o; o.x = pk2(hv[j].x, hv[j].y); o.y = pk2(hv[j].z, hv[j].w);
      *(u32x2*)(A + (size_t)r * DM + 4 * (lane + 64 * j)) = o;
    }
    float la[16];
#pragma unroll
    for (int e = 0; e < 16; ++e) {
      float a = 0.f;
#pragma unroll
      for (int j = 0; j < 4; ++j) { const f32x4 w = *(const f32x4*)(wt + e * 1024 + 4 * (lane + 64 * j)); a += hv[j].x * w.x + hv[j].y * w.y + hv[j].z * w.z + hv[j].w * w.w; }
      la[e] = a;
      if ((e & 3) == 3) asm volatile("" ::: "memory");
    }
    const float mylog = tred16(la, lane);
    float mx = mylog;
    mx = fmaxf(mx, __shfl_xor(mx, 4)); mx = fmaxf(mx, __shfl_xor(mx, 8)); mx = fmaxf(mx, __shfl_xor(mx, 16)); mx = fmaxf(mx, __shfl_xor(mx, 32));
    const float ex = expf(mylog - mx);
    float sum = ex;
    sum += __shfl_xor(sum, 4); sum += __shfl_xor(sum, 8); sum += __shfl_xor(sum, 16); sum += __shfl_xor(sum, 32);
    const float mine = ex / sum;
    if ((lane & 3) == 0) { AFF[(size_t)(lane >> 2) * NR + r] = mine; INV[r * 16 + (lane >> 2)] = -1; }
  }
}

__device__ __forceinline__ unsigned block_incl_scan(unsigned v, unsigned* tmp, unsigned& total) {
  const int lane = ltid() & 63, wave = ltid() >> 6;
  const unsigned inc = wave_incl_scan_u(v, lane);
  __syncthreads();
  if (lane == 63) tmp[wave] = inc;
  __syncthreads();
  unsigned off = 0u, tot = 0u;
#pragma unroll
  for (int w = 0; w < 8; ++w) { const unsigned t = tmp[w]; off += (w < wave) ? t : 0u; tot += t; }
  total = tot;
  return inc + off;
}
template <int LAYER>
__device__ __forceinline__ void topk_phase(const Params& p, char* lds) {
  const int tid = ltid(), lane = tid & 63, wave = tid >> 6;
  unsigned* keys = (unsigned*)lds;
  unsigned* hist = keys + 8192;
  unsigned* misc = hist + 256;
  unsigned* tmp = misc + 8;
  int* srow = (int*)(tmp + 8);
  const float* AFF = (const float*)(p.ws + WS_AFF);
  int* INV = (int*)(p.ws + WS_INV);
  int* IDX = (int*)(p.ws + WS_IDX);
  float* GATEV = (float*)(p.ws + WS_GATEV);
  const bf16_t* A = (const bf16_t*)(p.ws + WS_A);
  bf16_t* XS = (bf16_t*)(p.ws + WS_XS);
  const int ntask = (LAYER == 0) ? 64 : 32;
  for (int task = blockIdx.x; task < ntask; task += gridDim.x) {
    const bool isctx = task >= 32;
    const int be = task & 31, b = be >> 4, e = be & 15;
    const int n = isctx ? NCTX : SEQ, cap = isctx ? 32 : 1024;
    const int base = isctx ? MLAT + b * NCTX : b * SEQ;
    const int slotbase = isctx ? 2048 + b * 32 : b * 1024;
    __syncthreads();
    for (int i = tid; i < n; i += NT) keys[i] = __float_as_uint(AFF[(size_t)e * NR + base + i]);
    if (tid == 0) { misc[0] = 0u; misc[1] = 0u; misc[2] = (unsigned)cap; }
    __syncthreads();
    for (int pass = 3; pass >= 0; --pass) {
      if (tid < 256) hist[tid] = 0u;
      __syncthreads();
      const unsigned prefix = misc[0], mask = misc[1], kk = misc[2];
      for (int i = tid; i < n; i += NT) { const unsigned k = keys[i]; if ((k & mask) == prefix) atomicAdd(&hist[(k >> (8 * pass)) & 255u], 1u); }
      __syncthreads();
      const unsigned hc = (tid < 256) ? hist[tid] : 0u;
      unsigned total; const unsigned inc = block_incl_scan(hc, tmp, total);
      const unsigned above = total - inc;
      if (tid < 256 && hc > 0u && above < kk && kk <= above + hc) { misc[0] = prefix | ((unsigned)tid << (8 * pass)); misc[1] = mask | (255u << (8 * pass)); misc[2] = kk - above; }
      __syncthreads();
    }
    const unsigned T = misc[0]; const unsigned need = misc[2];
    const unsigned ngt_total = (unsigned)cap - need;
    const int per = (n + NT - 1) / NT, i0 = tid * per;
    unsigned cg_ = 0u, ce_ = 0u;
    for (int i = 0; i < per; ++i) { if (i0 + i < n) { const unsigned k = keys[i0 + i]; cg_ += (k > T) ? 1u : 0u; ce_ += (k == T) ? 1u : 0u; } }
    unsigned tg, te;
    const unsigned ig = block_incl_scan(cg_, tmp, tg);
    const unsigned ie = block_incl_scan(ce_, tmp, te);
    unsigned og = ig - cg_, oe = ie - ce_;
    for (int i = 0; i < per; ++i) {
      if (i0 + i < n) {
        const unsigned k = keys[i0 + i]; int slot = -1;
        if (k > T) slot = (int)(og++);
        else if (k == T) { if (oe < need) slot = (int)(ngt_total + oe); ++oe; }
        if (slot >= 0) {
          const int row = base + i0 + i;
          IDX[e * SLOTS + slotbase + slot] = row; GATEV[e * SLOTS + slotbase + slot] = __uint_as_float(k); INV[(size_t)row * 16 + e] = slotbase + slot;
        }
      }
    }
  }
}
__device__ __forceinline__ void gather_phase(const Params& p) {
  const int lane = ltid() & 63, wave = ltid() >> 6;
  const int gw = blockIdx.x * NWV + wave, ngw = gridDim.x * NWV;
  const int* IDX = (const int*)(p.ws + WS_IDX);
  const bf16_t* A = (const bf16_t*)(p.ws + WS_A);
  bf16_t* XS = (bf16_t*)(p.ws + WS_XS);
  for (int s = gw * 4; s < 16 * 2048; s += ngw * 4) {
    const int e = s >> 11, sl = s & 2047;
    u32x4 v0[4], v1[4];
#pragma unroll
    for (int j = 0; j < 4; ++j) { const u32x4* src = (const u32x4*)(A + (size_t)IDX[e * SLOTS + sl + j] * DM); v0[j] = src[lane]; v1[j] = src[lane + 64]; }
#pragma unroll
    for (int j = 0; j < 4; ++j) { u32x4* dst = (u32x4*)(XS + (size_t)(s + j) * DM); dst[lane] = v0[j]; dst[lane + 64] = v1[j]; }
  }
}

__device__ __forceinline__ int cperm(int c) { return (c & 32) + 8 * ((c & 15) >> 2) + 4 * ((c >> 4) & 1) + (c & 3); }
__device__ __forceinline__ bool seq_start(int r) { return r < MLAT ? ((r & (SEQ - 1)) == 0) : (((r - MLAT) & (NCTX - 1)) == 0); }

constexpr int CONVW_OFF = 147456;
struct ConvIn { u32x4 xm[4], xl[4], xr[4]; float a_in, b_in; };
__device__ __forceinline__ void dn_conv_w(const Params& p, int h, char* lds_all) {
  const int tid = ltid();
  if (tid < 24 * 6) {
    const int sc24 = tid / 6, part = tid % 6, seg = sc24 >> 3, ch = sc24 & 7;
    *(f32x4*)(lds_all + CONVW_OFF + (sc24 * 24 + part * 4) * 4) = *(const f32x4*)(p.even_conv_w + (part >> 1) * 1536 + seg * 512 + h * 64 + ch * 8 + (part & 1) * 4);
  }
}
__device__ __forceinline__ void dn_conv_load(const Params& p, int cid, int h, ConvIn& R) {
  const int tid = ltid(), dir = tid >> 8, lt = tid & 255, lane = lt & 63;
  const bf16_t* PROJ = (const bf16_t*)(p.ws + WS_PROJ);
  const int r0 = cid * 64;
  if (lt < 192) {
    const int sc24 = lt % 24, tg = lt / 24, seg = sc24 >> 3, ch = sc24 & 7;
    const int col = seg * 512 + h * 64 + ch * 8;
#pragma unroll
    for (int k4 = 0; k4 < 4; ++k4) {
      const int i = tg + 8 * (4 * dir + k4), r = r0 + i;
      const bool hasl = !seq_start(r), hasr = (r + 1 < NR) && !seq_start(r + 1);
      const u32x4 z4 = (u32x4){0u, 0u, 0u, 0u};
      R.xm[k4] = *(const u32x4*)(PROJ + (size_t)r * PROJ_LD + col);
      R.xl[k4] = hasl ? *(const u32x4*)(PROJ + (size_t)(r - 1) * PROJ_LD + col) : z4;
      R.xr[k4] = hasr ? *(const u32x4*)(PROJ + (size_t)(r + 1) * PROJ_LD + col) : z4;
    }
  } else {
    const int i = dir ? 63 - lane : lane;
    R.a_in = bf1(PROJ[(size_t)(r0 + i) * PROJ_LD + 2816 + dir * 16 + h]); R.b_in = bf1(PROJ[(size_t)(r0 + i) * PROJ_LD + 2816 + dir * 16 + 8 + h]);
  }
}
__device__ __forceinline__ void dn_prep_task(const Params& p, int cid, int h, char* lds_all, ConvIn& R, int ncid, int nh) {
  const int tid = ltid(), dir = tid >> 8, lt = tid & 255, lane = lt & 63, wv = lt >> 6;
  char* lds = lds_all + dir * 73728;
  float* Qf = (float*)lds;
  float* Kf = Qf + 64 * 72;
  float* Vf = Kf + 64 * 72;
  char* Qb = lds + 55296;
  char* Kb = Qb + 8192;
  float* G = (float*)(lds + 71680);
  float* BE = G + 64;
  float* SC = BE + 64;
  float* MP = Qf;
  const bf16_t* PROJ = (const bf16_t*)(p.ws + WS_PROJ);
  const float* GATES = (const float*)(p.ws + WS_GATES);
  const int r0 = cid * 64;
  __syncthreads();
  if (lt < 192) {
    const int sc24 = lt % 24, tg = lt / 24, seg = sc24 >> 3, ch = sc24 & 7;
    const f32x4* cwt = (const f32x4*)(lds_all + CONVW_OFF + sc24 * 96);
    const f32x4 w0a = cwt[0], w0b = cwt[1], w1a = cwt[2], w1b = cwt[3], w2a = cwt[4], w2b = cwt[5];
    const float wl[8] = {w0a.x, w0a.y, w0a.z, w0a.w, w0b.x, w0b.y, w0b.z, w0b.w}, wm[8] = {w1a.x, w1a.y, w1a.z, w1a.w, w1b.x, w1b.y, w1b.z, w1b.w}, wr_[8] = {w2a.x, w2a.y, w2a.z, w2a.w, w2b.x, w2b.y, w2b.z, w2b.w};
    float* dbase = (float*)lds_all + seg * (64 * 72) + ch * 8;
#pragma unroll
    for (int k4 = 0; k4 < 4; ++k4) {
      const int i = tg + 8 * (4 * dir + k4);
      const u32x4 xm = R.xm[k4], xl = R.xl[k4], xr = R.xr[k4];
      const unsigned xmv[4] = {xm.x, xm.y, xm.z, xm.w}, xlv[4] = {xl.x, xl.y, xl.z, xl.w}, xrv[4] = {xr.x, xr.y, xr.z, xr.w};
      float y[8];
#pragma unroll
      for (int q = 0; q < 4; ++q) {
        y[2 * q] = silu_f(wl[2 * q] * bflo(xlv[q]) + wm[2 * q] * bflo(xmv[q]) + wr_[2 * q] * bflo(xrv[q]));
        y[2 * q + 1] = silu_f(wl[2 * q + 1] * bfhi(xlv[q]) + wm[2 * q + 1] * bfhi(xmv[q]) + wr_[2 * q + 1] * bfhi(xrv[q]));
      }
      float ssq = 0.f;
#pragma unroll
      for (int q = 0; q < 8; ++q) ssq += y[q] * y[q];
      ssq += __shfl_xor(ssq, 1); ssq += __shfl_xor(ssq, 2); ssq += __shfl_xor(ssq, 4);
      const float scl = seg == 2 ? 1.f : rsqrtf(ssq + EPS) * (seg == 0 ? 0.125f : 1.f);
#pragma unroll
      for (int q = 0; q < 8; ++q) y[q] *= scl;
      if (seg != 0) {
        float* dst = dbase + i * 72;
        *(f32x4*)dst = (f32x4){y[0], y[1], y[2], y[3]}; *(f32x4*)(dst + 4) = (f32x4){y[4], y[5], y[6], y[7]};
        *(f32x4*)(dst + 73728 / 4) = (f32x4){y[0], y[1], y[2], y[3]}; *(f32x4*)(dst + 73728 / 4 + 4) = (f32x4){y[4], y[5], y[6], y[7]};
      }
      if (seg != 2) {
        u32x4 w; w.x = pk2(y[0], y[1]); w.y = pk2(y[2], y[3]); w.z = pk2(y[4], y[5]); w.w = pk2(y[6], y[7]);
        char* tb = lds_all + 55296 + seg * 8192 + i * 128 + ((ch ^ ((i >> 1) & 7)) << 4);
        *(u32x4*)tb = w; *(u32x4*)(tb + 73728) = w;
        if (seg == 0) { bf16_t* QN = (bf16_t*)(p.ws + WS_QN) + (size_t)(cid * 8 + h) * 4096; *(u32x2*)(QN + i * 64 + cperm(ch * 8)) = (u32x2){w.x, w.y}; *(u32x2*)(QN + i * 64 + cperm(ch * 8 + 4)) = (u32x2){w.z, w.w}; }
      }
    }
  } else {
    const int i = dir ? 63 - lane : lane;
    const float a_in = R.a_in, b_in = R.b_in;
    float v = -__expf(p.even_a_log[dir * 8 + h]) * softplus_f(a_in + p.even_dt_bias[dir * 8 + h]);
    v = wave_incl_scan_f(v, lane);
    G[i] = v;
    BE[i] = sigmoid_f(b_in);
  }
  __syncthreads();
  if (nh != h) dn_conv_w(p, nh, lds_all);
  dn_conv_load(p, ncid, nh, R);
  {
    float* EGD = (float*)(p.ws + WS_EGDEC);
    if (lt < 64) {
      const float gl = dir ? G[0] : G[63];
      float* o = EGD + ((size_t)((cid * 8 + h) * 2 + dir)) * 128;
      o[lt] = __expf(G[lt]); o[64 + lt] = __expf(gl - G[lt]);
    }
    if (dir == 0) {
      bf16_t* KNT = (bf16_t*)(p.ws + WS_KNT) + (size_t)(cid * 8 + h) * 4096;
      for (int u = lt; u < 64 * 16; u += 256) {
        const int i = u >> 4, c4 = (u & 15) * 4;
        u32x2 o2; o2.x = pk2(Kf[c4 * 72 + i], Kf[(c4 + 1) * 72 + i]); o2.y = pk2(Kf[(c4 + 2) * 72 + i], Kf[(c4 + 3) * 72 + i]);
        *(u32x2*)(KNT + i * 64 + cperm(c4)) = o2;
      }
    }
    const int fr = lane & 15, fq = lane >> 4, sw = (fr >> 1) & 7;
    f32x4 kk[4], qk[4];
#pragma unroll
    for (int n = 0; n < 4; ++n) { kk[n] = (f32x4){0.f, 0.f, 0.f, 0.f}; qk[n] = kk[n]; }
#pragma unroll
    for (int ks = 0; ks < 2; ++ks) {
      const int co = ((ks * 4 + fq) ^ sw) << 4;
      const bf16x8 ak = *(const bf16x8*)(Kb + (16 * wv + fr) * 128 + co), aq = *(const bf16x8*)(Qb + (16 * wv + fr) * 128 + co);
#pragma unroll
      for (int n = 0; n < 4; ++n) {
        const bf16x8 bk = *(const bf16x8*)(Kb + (16 * n + fr) * 128 + co);
        kk[n] = __builtin_amdgcn_mfma_f32_16x16x32_bf16(bk, ak, kk[n], 0, 0, 0);
        qk[n] = __builtin_amdgcn_mfma_f32_16x16x32_bf16(bk, aq, qk[n], 0, 0, 0);
      }
    }
    __syncthreads();
    char* Mb = Qb;
    bf16_t* AQ = (bf16_t*)(p.ws + WS_WUA) + ((size_t)((cid * 8 + h) * 2 + dir) * 3 + 1) * 4096;
    const int i = 16 * wv + fr; const float gi = G[i], bei = BE[i];
    const int ppi = dir ? 63 - i : i;
#pragma unroll
    for (int n = 0; n < 4; ++n) {
      float v0[4], mv[4];
#pragma unroll
      for (int q = 0; q < 4; ++q) {
        const int j = 16 * n + 4 * fq + q;
        const float e0 = __expf(fminf(gi - G[j], 0.f));
        const bool inc = dir ? (j >= i) : (j <= i);
        v0[q] = inc ? qk[n][q] * e0 : 0.f;
        const bool strict = dir ? (j > i) : (j < i);
        mv[q] = strict ? bei * kk[n][q] * e0 : 0.f;
        if (strict && n == wv) { const int pq = dir ? 63 - j : j; MP[((ppi >> 2) * 64 + pq) * 4 + (ppi & 3)] = mv[q]; }
      }
      u32x2 o; o.x = pk2(v0[0], v0[1]); o.y = pk2(v0[2], v0[3]); *(u32x2*)(AQ + i * 64 + cperm(16 * n + 4 * fq)) = o;
      {
        const int pq0 = dir ? 60 - 16 * n - 4 * fq : 16 * n + 4 * fq;
        u32x2 mo; mo.x = dir ? pk2(mv[3], mv[2]) : pk2(mv[0], mv[1]); mo.y = dir ? pk2(mv[1], mv[0]) : pk2(mv[2], mv[3]);
        *(u32x2*)(Mb + ppi * 128 + (((pq0 >> 3) ^ ((ppi >> 1) & 7)) << 4) + (pq0 & 7) * 2) = mo;
      }
    }
  }
  __syncthreads();
  for (int u = lt; u < 64 * 16; u += 256) {
    const int a = u >> 4, c4 = (u & 15) * 4; const float be = BE[a], bk = be * __expf(G[a]);
    *(f32x4*)(Vf + a * 72 + c4) = *(const f32x4*)(Vf + a * 72 + c4) * be; *(f32x4*)(Kf + a * 72 + c4) = *(const f32x4*)(Kf + a * 72 + c4) * bk;
  }
  float* TL = (float*)Kb;
  {
    const int j = lane & 15, g = lane >> 4;
    const f32x4* mblk = (const f32x4*)MP + (4 * wv) * 64 + 16 * wv;
    float t[16];
#pragma unroll
    for (int i = 0; i < 16; ++i) {
      float sacc = (i == j) ? 1.f : 0.f;
#pragma unroll
      for (int k = 0; k < i; ++k) { const f32x4 m4 = mblk[(i >> 2) * 64 + k]; const float mik = (i & 3) == 0 ? m4.x : (i & 3) == 1 ? m4.y : (i & 3) == 2 ? m4.z : m4.w; sacc -= mik * t[k]; }
      t[i] = sacc;
    }
#pragma unroll
    for (int i = 0; i < 16; ++i) if ((i & 3) == g) TL[wv * 256 + i * 16 + j] = t[i];
  }
  __syncthreads();
  {
    const char* Mb = Qb;
    const int fr = lane & 15, fq = lane >> 4;
    unsigned xb[2][4][2];
#pragma unroll
    for (int I = 0; I < 4; ++I) {
      const int mrow = 16 * I + fr, msw = (mrow >> 1) & 7;
      u32x2 m0lo = (u32x2){0u, 0u}, m0hi = m0lo, m1lo = m0lo;
      if (I >= 1) m0lo = *(const u32x2*)(Mb + mrow * 128 + (((0 + (fq >> 1)) ^ msw) << 4) + (fq & 1) * 8);
      if (I >= 2) m0hi = *(const u32x2*)(Mb + mrow * 128 + (((2 + (fq >> 1)) ^ msw) << 4) + (fq & 1) * 8);
      if (I >= 3) m1lo = *(const u32x2*)(Mb + mrow * 128 + (((4 + (fq >> 1)) ^ msw) << 4) + (fq & 1) * 8);
      const f32x4 tq = *(const f32x4*)(TL + I * 256 + fr * 16 + 4 * fq);
#pragma unroll
      for (int tsel = 0; tsel < 2; ++tsel) {
        float* Xa = (tsel ? Kf : Vf) + 16 * wv + fr;
        f32x4 acc = (f32x4){0.f, 0.f, 0.f, 0.f};
        if (I >= 1) {
          const bf16x8 af = __builtin_bit_cast(bf16x8, (u32x4){m0lo.x, m0lo.y, m0hi.x, m0hi.y});
          const bf16x8 bfv = __builtin_bit_cast(bf16x8, (u32x4){xb[tsel][0][0], xb[tsel][0][1], I >= 2 ? xb[tsel][1][0] : 0u, I >= 2 ? xb[tsel][1][1] : 0u});
          acc = __builtin_amdgcn_mfma_f32_16x16x32_bf16(af, bfv, acc, 0, 0, 0);
        }
        if (I >= 3) {
          const bf16x8 af = __builtin_bit_cast(bf16x8, (u32x4){m1lo.x, m1lo.y, 0u, 0u});
          const bf16x8 bfv = __builtin_bit_cast(bf16x8, (u32x4){xb[tsel][2][0], xb[tsel][2][1], 0u, 0u});
          acc = __builtin_amdgcn_mfma_f32_16x16x32_bf16(af, bfv, acc, 0, 0, 0);
        }
        float z[4];
#pragma unroll
        for (int r4 = 0; r4 < 4; ++r4) { const int pp = 16 * I + 4 * fq + r4; z[r4] = Xa[(dir ? 63 - pp : pp) * 72]; }
        z[0] -= acc.x; z[1] -= acc.y; z[2] -= acc.z; z[3] -= acc.w;
        f32x4 x = (f32x4){0.f, 0.f, 0.f, 0.f};
        x = __builtin_amdgcn_mfma_f32_16x16x4f32(tq.x, z[0], x, 0, 0, 0);
        x = __builtin_amdgcn_mfma_f32_16x16x4f32(tq.y, z[1], x, 0, 0, 0);
        x = __builtin_amdgcn_mfma_f32_16x16x4f32(tq.z, z[2], x, 0, 0, 0);
        x = __builtin_amdgcn_mfma_f32_16x16x4f32(tq.w, z[3], x, 0, 0, 0);
        const float xv[4] = {x.x, x.y, x.z, x.w};
#pragma unroll
        for (int r4 = 0; r4 < 4; ++r4) { const int pp = 16 * I + 4 * fq + r4; Xa[(dir ? 63 - pp : pp) * 72] = xv[r4]; }
        xb[tsel][I][0] = pk2(xv[0], xv[1]); xb[tsel][I][1] = pk2(xv[2], xv[3]);
      }
    }
  }
  __syncthreads();
  {
    bf16_t* WUA = (bf16_t*)(p.ws + WS_WUA) + (size_t)((cid * 8 + h) * 2 + dir) * 3 * 4096;
    for (int u = lt; u < 64 * 16; u += 256) {
      const int i = u >> 4, c4 = (u & 15) * 4;
      const f32x4 kv = *(const f32x4*)(Kf + i * 72 + c4);
      u32x2 o; o.x = pk2(kv.x, kv.y); o.y = pk2(kv.z, kv.w);
      *(u32x2*)(WUA + i * 64 + cperm(c4)) = o;
      u32x2 o2; o2.x = pk2(Vf[c4 * 72 + i], Vf[(c4 + 1) * 72 + i]); o2.y = pk2(Vf[(c4 + 2) * 72 + i], Vf[(c4 + 3) * 72 + i]);
      *(u32x2*)(WUA + 2 * 4096 + i * 64 + 16 * ((c4 & 15) >> 2) + 4 * (c4 >> 4)) = o2;
    }
  }
}

__device__ __forceinline__ void gqa_prep_task(const Params& p, int cid, char* lds) {
  const int tid = ltid(), lane = tid & 63, wave = tid >> 6;
  const bf16_t* PROJ = (const bf16_t*)(p.ws + WS_PROJ);
  bf16_t* QB = (bf16_t*)(p.ws + WS_QB);
  bf16_t* KB = (bf16_t*)(p.ws + WS_KB);
  bf16_t* VT = (bf16_t*)(p.ws + WS_VT);
  const float* rc = (const float*)(p.ws + WS_ROPE); const float* rsn = rc + 8192 * 32;
  const int r0 = cid * 64;
  const bool isctx = r0 >= MLAT;
  const int b = isctx ? (r0 - MLAT) / NCTX : r0 / SEQ;
  const int key0 = isctx ? (r0 - MLAT) % NCTX : NCTX + (r0 % SEQ);
  bf16_t* vt_lds = (bf16_t*)lds;
  __syncthreads();
  for (int u = tid; u < 64 * 16; u += NT) {
    const int i = u >> 4, ch = u & 15;
    const u32x4 v = *(const u32x4*)(PROJ + (size_t)(r0 + i) * PROJ_LD + 2688 + ch * 8);
    unsigned* d = (unsigned*)(vt_lds + i * 130 + ch * 8);
    d[0] = v.x; d[1] = v.y; d[2] = v.z; d[3] = v.w;
  }
  for (int i = wave * 8; i < wave * 8 + 8; ++i) {
    const int r = r0 + i; const int t = r & (SEQ - 1);
    const int d0 = 8 * (lane & 7), f0 = 8 * (lane & 3);
    f32x4 c0 = (f32x4){1.f, 1.f, 1.f, 1.f}, c1 = c0, s0 = (f32x4){0.f, 0.f, 0.f, 0.f}, s1 = s0;
    if (!isctx) { c0 = *(const f32x4*)(rc + t * 32 + f0); c1 = *(const f32x4*)(rc + t * 32 + f0 + 4); s0 = *(const f32x4*)(rsn + t * 32 + f0); s1 = *(const f32x4*)(rsn + t * 32 + f0 + 4); }
    const float cs[8] = {c0.x, c0.y, c0.z, c0.w, c1.x, c1.y, c1.z, c1.w}, sn[8] = {s0.x, s0.y, s0.z, s0.w, s1.x, s1.y, s1.z, s1.w};
    const bool lowhalf = (lane & 7) < 4;
#pragma unroll
    for (int pass = 0; pass < 2; ++pass) {
      const int lsrc = pass == 0 ? lane : (lane & 15);
      const u32x4 raw = *(const u32x4*)(PROJ + (size_t)r * PROJ_LD + (pass == 0 ? 2048 : 2560) + lsrc * 8);
      float xv[8] = {bflo(raw.x), bfhi(raw.x), bflo(raw.y), bfhi(raw.y), bflo(raw.z), bfhi(raw.z), bflo(raw.w), bfhi(raw.w)};
      float ss = 0.f;
#pragma unroll
      for (int q = 0; q < 8; ++q) ss += xv[q] * xv[q];
      ss += __shfl_xor(ss, 1); ss += __shfl_xor(ss, 2); ss += __shfl_xor(ss, 4);
      const float rs = rsqrtf(ss * (1.f / 64.f) + EPS) * (pass == 0 ? 0.125f * LOG2E : 1.f);
      const float* g = (pass == 0 ? p.even_q_norm_g : p.even_k_norm_g) + d0;
      float o[8];
#pragma unroll
      for (int q = 0; q < 8; ++q) {
        const float mine = xv[q] * rs * g[q];
        const float other = __shfl_xor(mine, 4);
        o[q] = lowhalf ? (mine * cs[q] - other * sn[q]) : (other * sn[q] + mine * cs[q]);
      }
      u32x4 w; w.x = pk2(o[0], o[1]); w.y = pk2(o[2], o[3]); w.z = pk2(o[4], o[5]); w.w = pk2(o[6], o[7]);
      if (pass == 0) *(u32x4*)(QB + (size_t)r * 512 + lane * 8) = w;
      else if (lane < 16) *(u32x4*)(KB + ((size_t)(b * 2 + (lane >> 3)) * NKEY + key0 + i) * 64 + d0) = w;
    }
  }
  __syncthreads();
  {
    const int d = tid >> 2, kh = (tid & 3) * 16;
    bf16_t* dst = VT + ((size_t)(b * 2 + (d >> 6)) * 64 + (d & 63)) * NKEY + key0 + kh;
#pragma unroll
    for (int c8 = 0; c8 < 2; ++c8) {
      unsigned w[4];
#pragma unroll
      for (int q = 0; q < 4; ++q) { const unsigned lo = vt_lds[(kh + c8 * 8 + 2 * q) * 130 + d], hi = vt_lds[(kh + c8 * 8 + 2 * q + 1) * 130 + d]; w[q] = lo | (hi << 16); }
      *(u32x4*)(dst + c8 * 8) = (u32x4){w[0], w[1], w[2], w[3]};
    }
  }
}
__device__ __forceinline__ void prep_even(const Params& p, char* lds) {
  {
    ConvIn R;
    int t = blockIdx.x;
    __syncthreads();
    dn_conv_w(p, t & 7, lds);
    dn_conv_load(p, (t < NCHUNK * 8) ? t >> 3 : 0, t & 7, R);
    for (; t < NCHUNK * 8; t += gridDim.x) {
      const int tn = (t + (int)gridDim.x < NCHUNK * 8) ? t + (int)gridDim.x : t;
      dn_prep_task(p, t >> 3, t & 7, lds, R, tn >> 3, tn & 7);
    }
  }
  const int nb = (NCHUNK * 8) % (int)gridDim.x;
  if ((int)blockIdx.x >= nb) for (int g = (int)blockIdx.x - nb; g < NCHUNK; g += (int)gridDim.x - nb) gqa_prep_task(p, g, lds);
}

__device__ __forceinline__ bf16x8 ldfrag136(const char* tile, int row, int s, int q) {
  const char* a = tile + row * 136 + (32 * s + 4 * q) * 2;
  const u32x2 lo = *(const u32x2*)a, hi = *(const u32x2*)(a + 32);
  return __builtin_bit_cast(bf16x8, (u32x4){lo.x, lo.y, hi.x, hi.y});
}
__device__ __forceinline__ bf16x8 pack_acc2(const f32x4& a, const f32x4& b) {
  return __builtin_bit_cast(bf16x8, (u32x4){pk2(a.x, a.y), pk2(a.z, a.w), pk2(b.x, b.y), pk2(b.z, b.w)});
}
#define SCAN_LOAD(B, ST) do { const int cid_ = step_cid(ST); const size_t cd_ = (size_t)((cid_ * 8 + h) * 2 + dir); const bf16_t* wua_ = WUA + cd_ * 3 * 4096; \
    _Pragma("unroll") for (int mt = 0; mt < 4; ++mt) _Pragma("unroll") for (int s2 = 0; s2 < 2; ++s2) Wf##B[mt][s2] = *(const bf16x8*)(wua_ + foff + mt * 1024 + s2 * 32); \
    Uf##B[0] = *(const u32x4*)(wua_ + 8192 + uoff); Uf##B[1] = *(const u32x4*)(wua_ + 8192 + uoff + 8); } while (0)
#define SCAN_LOADK(ST) do { const int cid_ = step_cid(ST); const size_t cd_ = (size_t)((cid_ * 8 + h) * 2 + dir); const bf16_t* kn_ = KNT + (size_t)(cid_ * 8 + h) * 4096; const float* eg_ = EGD + cd_ * 128; \
    _Pragma("unroll") for (int mt = 0; mt < 4; ++mt) _Pragma("unroll") for (int s2 = 0; s2 < 2; ++s2) Kf[mt][s2] = *(const bf16x8*)(kn_ + foff + mt * 1024 + s2 * 32); \
    _Pragma("unroll") for (int mt = 0; mt < 4; ++mt) dc[mt] = *(const f32x4*)(eg_ + 64 + 16 * mt + 4 * q); \
    gl = eg_[dir ? 0 : 63]; } while (0)
#define SCAN_STEP(B, ST) do { const int cid_ = step_cid(ST); const size_t cd_ = (size_t)((cid_ * 8 + h) * 2 + dir); \
    const u32x4 sa_ = (u32x4){pk2(S[0].x, S[0].y), pk2(S[0].z, S[0].w), pk2(S[1].x, S[1].y), pk2(S[1].z, S[1].w)}, sb_ = (u32x4){pk2(S[2].x, S[2].y), pk2(S[2].z, S[2].w), pk2(S[3].x, S[3].y), pk2(S[3].z, S[3].w)}; \
    *(u32x4*)(SC + cd_ * 4096 + uoff) = sa_; *(u32x4*)(SC + cd_ * 4096 + uoff + 8) = sb_; \
    const bf16x8 bS0_ = __builtin_bit_cast(bf16x8, sa_), bS1_ = __builtin_bit_cast(bf16x8, sb_); \
    const unsigned uw_[8] = {Uf##B[0].x, Uf##B[0].y, Uf##B[0].z, Uf##B[0].w, Uf##B[1].x, Uf##B[1].y, Uf##B[1].z, Uf##B[1].w}; \
    f32x4 vn_[4]; \
    _Pragma("unroll") for (int mt = 0; mt < 4; ++mt) { f32x4 pacc_ = (f32x4){0.f, 0.f, 0.f, 0.f}; \
      pacc_ = __builtin_amdgcn_mfma_f32_16x16x32_bf16(Wf##B[mt][0], bS0_, pacc_, 0, 0, 0); pacc_ = __builtin_amdgcn_mfma_f32_16x16x32_bf16(Wf##B[mt][1], bS1_, pacc_, 0, 0, 0); \
      vn_[mt] = (f32x4){bflo(uw_[2 * mt]), bfhi(uw_[2 * mt]), bflo(uw_[2 * mt + 1]), bfhi(uw_[2 * mt + 1])} - pacc_; } \
    SCAN_LOAD(B, (ST) + 2); \
    const u32x4 va_ = (u32x4){pk2(vn_[0].x, vn_[0].y), pk2(vn_[0].z, vn_[0].w), pk2(vn_[1].x, vn_[1].y), pk2(vn_[1].z, vn_[1].w)}, vb_ = (u32x4){pk2(vn_[2].x, vn_[2].y), pk2(vn_[2].z, vn_[2].w), pk2(vn_[3].x, vn_[3].y), pk2(vn_[3].z, vn_[3].w)}; \
    bf16_t* ut_ = (bf16_t*)WUA + cd_ * 3 * 4096 + 8192 + uoff; *(u32x4*)ut_ = va_; *(u32x4*)(ut_ + 8) = vb_; \
    const bf16x8 bD0_ = pack_acc2(vn_[0] * dc[0], vn_[1] * dc[1]), bD1_ = pack_acc2(vn_[2] * dc[2], vn_[3] * dc[3]); \
    _Pragma("unroll") for (int t = 0; t < 4; ++t) { f32x4 sacc_ = S[t] * gl; \
      sacc_ = __builtin_amdgcn_mfma_f32_16x16x32_bf16(Kf[t][0], bD0_, sacc_, 0, 0, 0); sacc_ = __builtin_amdgcn_mfma_f32_16x16x32_bf16(Kf[t][1], bD1_, sacc_, 0, 0, 0); S[t] = sacc_; } \
    SCAN_LOADK((ST) + 1); } while (0)
__device__ __forceinline__ void scan_wave(const Params& p, int task) {
  const int lane = ltid() & 63, c = lane & 15, q = lane >> 4;
  const int w = task & 3, dir = (task >> 2) & 1, h = (task >> 3) & 7, b = task >> 6;
  const bf16_t* KNT = (const bf16_t*)(p.ws + WS_KNT);
  const bf16_t* WUA = (const bf16_t*)(p.ws + WS_WUA);
  const float* EGD = (const float*)(p.ws + WS_EGDEC);
  bf16_t* SC = (bf16_t*)(p.ws + WS_A);
  const int foff = c * 64 + 8 * q;
  const int uoff = (16 * w + c) * 64 + 16 * q;
  auto step_cid = [&](int st) -> int {
    if (st >= 132) st = 131;
    if (st < 4) return 256 + b * 4 + (dir ? 3 - st : st);
    const int cc = st - 4; return b * 128 + (dir ? 127 - cc : cc);
  };
  f32x4 S[4];
#pragma unroll
  for (int t = 0; t < 4; ++t) S[t] = (f32x4){0.f, 0.f, 0.f, 0.f};
  bf16x8 Wf0[4][2], Wf1[4][2], Kf[4][2]; u32x4 Uf0[2], Uf1[2]; f32x4 dc[4]; float gl;
  SCAN_LOAD(0, 0); SCAN_LOAD(1, 1); SCAN_LOADK(0);
  for (int st = 0; st < 132; st += 2) {
    SCAN_STEP(0, st);
    SCAN_STEP(1, st + 1);
  }
}

struct AttnState { f32x16 o0, o1; float m, l; };
__device__ __forceinline__ void attn_scores(const char* Kt, const bf16x8 (&qf)[4], int r32, int hh, f32x16& s0, f32x16& s1) {
  const int sw = (r32 >> 1) & 7;
#pragma unroll
  for (int s = 0; s < 4; ++s) {
    const int co = ((2 * s + hh) ^ sw) << 4;
    const bf16x8 k0 = *(const bf16x8*)(Kt + r32 * 128 + co);
    const bf16x8 k1 = *(const bf16x8*)(Kt + (32 + r32) * 128 + co);
    s0 = __builtin_amdgcn_mfma_f32_32x32x16_bf16(k0, qf[s], s0, 0, 0, 0);
    s1 = __builtin_amdgcn_mfma_f32_32x32x16_bf16(k1, qf[s], s1, 0, 0, 0);
  }
}
__device__ __forceinline__ void attn_update(AttnState& st, f32x16& s0, f32x16& s1, const char* Vt, int r32, int hh) {
  float mx = s0[0];
#pragma unroll
  for (int i = 1; i < 16; ++i) mx = fmaxf(mx, s0[i]);
#pragma unroll
  for (int i = 0; i < 16; ++i) mx = fmaxf(mx, s1[i]);
  mx = fmaxf(mx, __shfl_xor(mx, 32));
  const float mnew = fmaxf(st.m, mx);
  const float alpha = __builtin_amdgcn_exp2f(st.m - mnew);
  st.m = mnew;
  float ls = 0.f;
#pragma unroll
  for (int i = 0; i < 16; ++i) { s0[i] = __builtin_amdgcn_exp2f(s0[i] - mnew); ls += s0[i]; }
#pragma unroll
  for (int i = 0; i < 16; ++i) { s1[i] = __builtin_amdgcn_exp2f(s1[i] - mnew); ls += s1[i]; }
  st.l = st.l * alpha + ls;
  st.o0 *= alpha; st.o1 *= alpha;
  bf16x8 pf[2][2];
#pragma unroll
  for (int sp = 0; sp < 2; ++sp) {
    pf[0][sp] = __builtin_bit_cast(bf16x8, (u32x4){pk2(s0[8 * sp], s0[8 * sp + 1]), pk2(s0[8 * sp + 2], s0[8 * sp + 3]), pk2(s0[8 * sp + 4], s0[8 * sp + 5]), pk2(s0[8 * sp + 6], s0[8 * sp + 7])});
    pf[1][sp] = __builtin_bit_cast(bf16x8, (u32x4){pk2(s1[8 * sp], s1[8 * sp + 1]), pk2(s1[8 * sp + 2], s1[8 * sp + 3]), pk2(s1[8 * sp + 4], s1[8 * sp + 5]), pk2(s1[8 * sp + 6], s1[8 * sp + 7])});
  }
#pragma unroll
  for (int u = 0; u < 2; ++u)
#pragma unroll
    for (int sp = 0; sp < 2; ++sp) {
      const int ko = (32 * u + 16 * sp + 4 * hh) * 2;
      const char* a0 = Vt + r32 * 136 + ko; const char* a1 = Vt + (32 + r32) * 136 + ko;
      const u32x2 x0 = *(const u32x2*)a0, x1 = *(const u32x2*)(a0 + 16), y0 = *(const u32x2*)a1, y1 = *(const u32x2*)(a1 + 16);
      const bf16x8 v0 = __builtin_bit_cast(bf16x8, (u32x4){x0.x, x0.y, x1.x, x1.y}), v1 = __builtin_bit_cast(bf16x8, (u32x4){y0.x, y0.y, y1.x, y1.y});
      st.o0 = __builtin_amdgcn_mfma_f32_32x32x16_bf16(v0, pf[u][sp], st.o0, 0, 0, 0);
      st.o1 = __builtin_amdgcn_mfma_f32_32x32x16_bf16(v1, pf[u][sp], st.o1, 0, 0, 0);
    }
}
__device__ __forceinline__ void attn_update_bounded(AttnState& st, f32x16& s0, f32x16& s1, const char* Vt, int r32, int hh) {
  float ls = 0.f;
#pragma unroll
  for (int i = 0; i < 16; ++i) { s0[i] = __builtin_amdgcn_exp2f(s0[i]); ls += s0[i]; }
#pragma unroll
  for (int i = 0; i < 16; ++i) { s1[i] = __builtin_amdgcn_exp2f(s1[i]); ls += s1[i]; }
  st.l += ls;
  bf16x8 pf[2][2];
#pragma unroll
  for (int sp = 0; sp < 2; ++sp) {
    pf[0][sp] = __builtin_bit_cast(bf16x8, (u32x4){pk2(s0[8 * sp], s0[8 * sp + 1]), pk2(s0[8 * sp + 2], s0[8 * sp + 3]), pk2(s0[8 * sp + 4], s0[8 * sp + 5]), pk2(s0[8 * sp + 6], s0[8 * sp + 7])});
    pf[1][sp] = __builtin_bit_cast(bf16x8, (u32x4){pk2(s1[8 * sp], s1[8 * sp + 1]), pk2(s1[8 * sp + 2], s1[8 * sp + 3]), pk2(s1[8 * sp + 4], s1[8 * sp + 5]), pk2(s1[8 * sp + 6], s1[8 * sp + 7])});
  }
#pragma unroll
  for (int u = 0; u < 2; ++u)
#pragma unroll
    for (int sp = 0; sp < 2; ++sp) {
      const int ko = (32 * u + 16 * sp + 4 * hh) * 2;
      const char* a0 = Vt + r32 * 136 + ko; const char* a1 = Vt + (32 + r32) * 136 + ko;
      const u32x2 x0 = *(const u32x2*)a0, x1 = *(const u32x2*)(a0 + 16), y0 = *(const u32x2*)a1, y1 = *(const u32x2*)(a1 + 16);
      const bf16x8 v0 = __builtin_bit_cast(bf16x8, (u32x4){x0.x, x0.y, x1.x, x1.y}), v1 = __builtin_bit_cast(bf16x8, (u32x4){y0.x, y0.y, y1.x, y1.y});
      st.o0 = __builtin_amdgcn_mfma_f32_32x32x16_bf16(v0, pf[u][sp], st.o0, 0, 0, 0);
      st.o1 = __builtin_amdgcn_mfma_f32_32x32x16_bf16(v1, pf[u][sp], st.o1, 0, 0, 0);
    }
}
__device__ __forceinline__ void attn_tile_bounded(AttnState& st, const f32x16& negsh, const char* Kt, const char* Vt, const bf16x8 (&qf)[4], int r32, int hh) {
  const int sw = (r32 >> 1) & 7;
  bf16x8 kf[8];
#pragma unroll
  for (int s = 0; s < 4; ++s) { const int co = ((2 * s + hh) ^ sw) << 4; kf[2 * s] = *(const bf16x8*)(Kt + r32 * 128 + co); kf[2 * s + 1] = *(const bf16x8*)(Kt + (32 + r32) * 128 + co); }
  __builtin_amdgcn_sched_barrier(0);
  f32x16 s0 = negsh, s1 = negsh;
#pragma unroll
  for (int s = 0; s < 4; ++s) { s0 = __builtin_amdgcn_mfma_f32_32x32x16_bf16(kf[2 * s], qf[s], s0, 0, 0, 0); s1 = __builtin_amdgcn_mfma_f32_32x32x16_bf16(kf[2 * s + 1], qf[s], s1, 0, 0, 0); }
  bf16x8 vf[2][2][2];
#pragma unroll
  for (int u = 0; u < 2; ++u)
#pragma unroll
    for (int sp = 0; sp < 2; ++sp) {
      const int ko = (32 * u + 16 * sp + 4 * hh) * 2;
      const char* a0 = Vt + r32 * 136 + ko; const char* a1 = Vt + (32 + r32) * 136 + ko;
      const u32x2 x0 = *(const u32x2*)a0, x1 = *(const u32x2*)(a0 + 16), y0 = *(const u32x2*)a1, y1 = *(const u32x2*)(a1 + 16);
      vf[u][sp][0] = __builtin_bit_cast(bf16x8, (u32x4){x0.x, x0.y, x1.x, x1.y}); vf[u][sp][1] = __builtin_bit_cast(bf16x8, (u32x4){y0.x, y0.y, y1.x, y1.y});
    }
  __builtin_amdgcn_sched_barrier(0);
  float ls = 0.f;
#pragma unroll
  for (int i = 0; i < 16; ++i) { s0[i] = __builtin_amdgcn_exp2f(s0[i]); ls += s0[i]; }
#pragma unroll
  for (int i = 0; i < 16; ++i) { s1[i] = __builtin_amdgcn_exp2f(s1[i]); ls += s1[i]; }
  st.l += ls;
  bf16x8 pf[2][2];
#pragma unroll
  for (int sp = 0; sp < 2; ++sp) {
    pf[0][sp] = __builtin_bit_cast(bf16x8, (u32x4){pk2(s0[8 * sp], s0[8 * sp + 1]), pk2(s0[8 * sp + 2], s0[8 * sp + 3]), pk2(s0[8 * sp + 4], s0[8 * sp + 5]), pk2(s0[8 * sp + 6], s0[8 * sp + 7])});
    pf[1][sp] = __builtin_bit_cast(bf16x8, (u32x4){pk2(s1[8 * sp], s1[8 * sp + 1]), pk2(s1[8 * sp + 2], s1[8 * sp + 3]), pk2(s1[8 * sp + 4], s1[8 * sp + 5]), pk2(s1[8 * sp + 6], s1[8 * sp + 7])});
  }
#pragma unroll
  for (int u = 0; u < 2; ++u)
#pragma unroll
    for (int sp = 0; sp < 2; ++sp) {
      st.o0 = __builtin_amdgcn_mfma_f32_32x32x16_bf16(vf[u][sp][0], pf[u][sp], st.o0, 0, 0, 0);
      st.o1 = __builtin_amdgcn_mfma_f32_32x32x16_bf16(vf[u][sp][1], pf[u][sp], st.o1, 0, 0, 0);
    }
}
__device__ __forceinline__ void attn_tile_pipe(AttnState& st, f32x16& sc0, f32x16& sc1, float nsh, const char* Kn, const char* Vc, const bf16x8 (&qf)[4], int r32, int hh) {
  const int sw = (r32 >> 1) & 7;
  bf16x8 kf[8];
#pragma unroll
  for (int s = 0; s < 4; ++s) { const int co = ((2 * s + hh) ^ sw) << 4; kf[2 * s] = *(const bf16x8*)(Kn + r32 * 128 + co); kf[2 * s + 1] = *(const bf16x8*)(Kn + (32 + r32) * 128 + co); }
  f32x16 n0, n1;
#pragma unroll
  for (int i = 0; i < 16; ++i) { n0[i] = nsh; n1[i] = nsh; }
  __builtin_amdgcn_sched_barrier(0);
  float ls = 0.f;
#pragma unroll
  for (int s = 0; s < 4; ++s) {
    n0 = __builtin_amdgcn_mfma_f32_32x32x16_bf16(kf[2 * s], qf[s], n0, 0, 0, 0);
    __builtin_amdgcn_sched_barrier(0);
#pragma unroll
    for (int i = 4 * s; i < 4 * s + 4; ++i) { sc0[i] = __builtin_amdgcn_exp2f(sc0[i]); ls += sc0[i]; }
    __builtin_amdgcn_sched_barrier(0);
    n1 = __builtin_amdgcn_mfma_f32_32x32x16_bf16(kf[2 * s + 1], qf[s], n1, 0, 0, 0);
    __builtin_amdgcn_sched_barrier(0);
#pragma unroll
    for (int i = 4 * s; i < 4 * s + 4; ++i) { sc1[i] = __builtin_amdgcn_exp2f(sc1[i]); ls += sc1[i]; }
    __builtin_amdgcn_sched_barrier(0);
  }
  st.l += ls;
  bf16x8 vf[2][2][2];
#pragma unroll
  for (int u = 0; u < 2; ++u)
#pragma unroll
    for (int sp = 0; sp < 2; ++sp) {
      const int ko = (32 * u + 16 * sp + 4 * hh) * 2;
      const char* a0 = Vc + r32 * 136 + ko; const char* a1 = Vc + (32 + r32) * 136 + ko;
      const u32x2 x0 = *(const u32x2*)a0, x1 = *(const u32x2*)(a0 + 16), y0 = *(const u32x2*)a1, y1 = *(const u32x2*)(a1 + 16);
      vf[u][sp][0] = __builtin_bit_cast(bf16x8, (u32x4){x0.x, x0.y, x1.x, x1.y}); vf[u][sp][1] = __builtin_bit_cast(bf16x8, (u32x4){y0.x, y0.y, y1.x, y1.y});
    }
#pragma unroll
  for (int u = 0; u < 2; ++u)
#pragma unroll
    for (int sp = 0; sp < 2; ++sp) {
      const f32x16& sc = u ? sc1 : sc0;
      const bf16x8 pf = __builtin_bit_cast(bf16x8, (u32x4){pk2(sc[8 * sp], sc[8 * sp + 1]), pk2(sc[8 * sp + 2], sc[8 * sp + 3]), pk2(sc[8 * sp + 4], sc[8 * sp + 5]), pk2(sc[8 * sp + 6], sc[8 * sp + 7])});
      st.o0 = __builtin_amdgcn_mfma_f32_32x32x16_bf16(vf[u][sp][0], pf, st.o0, 0, 0, 0);
      st.o1 = __builtin_amdgcn_mfma_f32_32x32x16_bf16(vf[u][sp][1], pf, st.o1, 0, 0, 0);
    }
  sc0 = n0; sc1 = n1;
}
__device__ __forceinline__ void attn_store(const AttnState& st, bf16_t* orow, int hh) {
  const float l = st.l + __shfl_xor(st.l, 32);
  const float il = 1.f / l;
#pragma unroll
  for (int g = 0; g < 4; ++g) {
    u32x2 a; a.x = pk2(st.o0[4 * g] * il, st.o0[4 * g + 1] * il); a.y = pk2(st.o0[4 * g + 2] * il, st.o0[4 * g + 3] * il);
    *(u32x2*)(orow + 8 * g + 4 * hh) = a;
    u32x2 bq; bq.x = pk2(st.o1[4 * g] * il, st.o1[4 * g + 1] * il); bq.y = pk2(st.o1[4 * g + 2] * il, st.o1[4 * g + 3] * il);
    *(u32x2*)(orow + 32 + 8 * g + 4 * hh) = bq;
  }
}

__device__ __forceinline__ void gqa_item(const Params& p, int item, char* lds) {
  const int tid = ltid(), lane = tid & 63, w = tid >> 6, r32 = lane & 31, hh = lane >> 5;
  const bf16_t* QB = (const bf16_t*)(p.ws + WS_QB);
  const bf16_t* KB = (const bf16_t*)(p.ws + WS_KB);
  const bf16_t* VT = (const bf16_t*)(p.ws + WS_VT);
  bf16_t* MIX = (bf16_t*)(p.ws + WS_MIX);
  int b, hkv, row0, ntile, t0; const int khalf = item & 1;
  { const int it2 = item >> 1;
    if (it2 < 512) { b = it2 >> 8; hkv = (it2 >> 7) & 1; row0 = b * SEQ + (it2 & 127) * 64; ntile = NKEY / 128; t0 = khalf * ntile; }
    else { const int it = it2 - 512; b = it >> 3; hkv = (it >> 2) & 1; row0 = MLAT + b * NCTX + (it & 3) * 64; ntile = NCTX / 128; t0 = khalf * ntile; } }
  const int qh = hkv * 4 + (w & 3);
  const int qrow = row0 + 32 * (w >> 2) + r32;
  const bf16_t* kb = KB + (size_t)(b * 2 + hkv) * NKEY * 64;
  const bf16_t* vt = VT + (size_t)(b * 2 + hkv) * 64 * NKEY;
  bf16x8 qf[4];
#pragma unroll
  for (int s = 0; s < 4; ++s) qf[s] = *(const bf16x8*)(QB + (size_t)qrow * 512 + qh * 64 + 16 * s + 8 * hh);
  AttnState st; st.o0 = (f32x16){}; st.o1 = (f32x16){}; st.m = 0.f; st.l = 0.f;
  float gq = fabsf(p.even_q_norm_g[lane]), gk = fabsf(p.even_k_norm_g[lane]);
#pragma unroll
  for (int o = 1; o < 64; o <<= 1) { gq = fmaxf(gq, __shfl_xor(gq, o)); gk = fmaxf(gk, __shfl_xor(gk, o)); }
  const float nsh = __builtin_amdgcn_readfirstlane(-(8.f * gq * gk * LOG2E * 1.02f));
  char* Kt = lds; char* Vt = lds + 24576;
  const int lrow = tid >> 3, lch = tid & 7;
  const int tend = t0 + ntile - 1;
  u32x4 rk0, rk1, rv0, rv1;
#define GQA_GK(R, T) do { int t_ = (T); t_ = t_ < tend ? t_ : tend; rk##R = *(const u32x4*)(kb + (size_t)t_ * 4096 + tid * 8); } while (0)
#define GQA_GV(R, T) do { int t_ = (T); t_ = t_ < tend ? t_ : tend; rv##R = *(const u32x4*)(vt + (size_t)lrow * NKEY + t_ * 64 + lch * 8); } while (0)
#define GQA_SK(R, SLOT) do { *(u32x4*)(Kt + (SLOT) * 8192 + lrow * 128 + ((lch ^ ((lrow >> 1) & 7)) << 4)) = rk##R; } while (0)
#define GQA_SV(R, SLOT) do { char* d_ = Vt + (SLOT) * 8704 + lrow * 136 + lch * 16; *(u32x2*)d_ = (u32x2){rv##R.x, rv##R.y}; *(u32x2*)(d_ + 8) = (u32x2){rv##R.z, rv##R.w}; } while (0)
  __syncthreads();
  GQA_GK(0, t0); GQA_GK(1, t0 + 1); GQA_GV(0, t0);
  GQA_SK(0, 0); GQA_SK(1, 1); GQA_SV(0, 0);
  GQA_GK(0, t0 + 2); GQA_GV(1, t0 + 1);
  __syncthreads();
  f32x16 sc0, sc1;
#pragma unroll
  for (int i = 0; i < 16; ++i) { sc0[i] = nsh; sc1[i] = nsh; }
  {
    const int sw = (r32 >> 1) & 7;
#pragma unroll
    for (int s2 = 0; s2 < 4; ++s2) {
      const int co = ((2 * s2 + hh) ^ sw) << 4;
      sc0 = __builtin_amdgcn_mfma_f32_32x32x16_bf16(*(const bf16x8*)(Kt + r32 * 128 + co), qf[s2], sc0, 0, 0, 0);
      sc1 = __builtin_amdgcn_mfma_f32_32x32x16_bf16(*(const bf16x8*)(Kt + (32 + r32) * 128 + co), qf[s2], sc1, 0, 0, 0);
    }
  }
  int k1 = 1, k2 = 2, k0 = 0;
  for (int t = 0; t < ntile; t += 2) {
    GQA_GK(1, t0 + t + 3); GQA_GV(0, t0 + t + 2);
    attn_tile_pipe(st, sc0, sc1, nsh, Kt + k1 * 8192, Vt + k0 * 8704, qf, r32, hh);
    GQA_SK(0, k2); GQA_SV(1, k1);
    __syncthreads();
    GQA_GK(0, t0 + t + 4); GQA_GV(1, t0 + t + 3);
    attn_tile_pipe(st, sc0, sc1, nsh, Kt + k2 * 8192, Vt + k1 * 8704, qf, r32, hh);
    GQA_SK(1, k0); GQA_SV(0, k2);
    __syncthreads();
    const int tk = k0; k0 = k2; k2 = k1; k1 = tk;
  }
#undef GQA_GK
#undef GQA_GV
#undef GQA_SK
#undef GQA_SV
  {
    const float l = st.l + __shfl_xor(st.l, 32);
    if (hh == 0) ((float*)(p.ws + WS_AFF))[((size_t)khalf * NR + qrow) * 8 + qh] = l;
    st.l = 0.5f;
    attn_store(st, khalf ? MIX + (size_t)qrow * DM + 512 + qh * 64 : (bf16_t*)(p.ws + WS_O1) + (size_t)qrow * 512 + qh * 64, hh);
  }
}

__device__ __forceinline__ void mix_even(const Params& p, char* lds) {
  unsigned* ctr = (unsigned*)(p.ws + WS_CTL);
  int* sh_item = (int*)(lds + 100000);
  if (blockIdx.x < 64) {
    if ((ltid() >> 6) < 2) scan_wave(p, blockIdx.x * 2 + (ltid() >> 6));
    else convert_experts(p, 0, lds, (bf16_t*)(p.ws + WS_WEXP), 0, 16 * 3 * 128, (int)blockIdx.x * 6 + (ltid() >> 6) - 2, 64 * 6);
  }
  for (;;) {
    __syncthreads();
    if (ltid() == 0) *sh_item = (int)atomicAdd(ctr, 1u);
    __syncthreads();
    const int item = *sh_item;
    if (item >= 2 * (512 + 16)) break;
    gqa_item(p, item, lds);
  }
}

__device__ __forceinline__ void gate_phase(const Params& p) {
  const int lane = ltid() & 63, wave = ltid() >> 6, c = lane & 15, q = lane >> 4;
  const int gw = blockIdx.x * NWV + wave, ngw = gridDim.x * NWV;
  bf16_t* MIX = (bf16_t*)(p.ws + WS_MIX);
  const bf16_t* PROJ = (const bf16_t*)(p.ws + WS_PROJ);
  const bf16_t* QN = (const bf16_t*)(p.ws + WS_QN);
  const bf16_t* WUA = (const bf16_t*)(p.ws + WS_WUA);
  const bf16_t* SC = (const bf16_t*)(p.ws + WS_A);
  const float* EGD = (const float*)(p.ws + WS_EGDEC);
  {
    const bf16_t* O1 = (const bf16_t*)(p.ws + WS_O1); const float* LP = (const float*)(p.ws + WS_AFF);
    const int hd = lane >> 3;
    for (int r0 = gw; r0 < NR; r0 += 4 * ngw) {
      float l0[4], l1[4]; u32x4 a[4], b2[4];
#pragma unroll
      for (int u = 0; u < 4; ++u) {
        const int r = (r0 + u * ngw < NR) ? r0 + u * ngw : r0;
        l0[u] = LP[(size_t)r * 8 + hd]; l1[u] = LP[((size_t)NR + r) * 8 + hd];
        a[u] = *(const u32x4*)(O1 + (size_t)r * 512 + lane * 8); b2[u] = *(const u32x4*)(MIX + (size_t)r * DM + 512 + lane * 8);
      }
#pragma unroll
      for (int u = 0; u < 4; ++u) {
        const int r = r0 + u * ngw;
        if (r < NR) {
          const float il = 1.f / (l0[u] + l1[u]);
          u32x4 o; o.x = pk2((bflo(a[u].x) + bflo(b2[u].x)) * il, (bfhi(a[u].x) + bfhi(b2[u].x)) * il); o.y = pk2((bflo(a[u].y) + bflo(b2[u].y)) * il, (bfhi(a[u].y) + bfhi(b2[u].y)) * il);
          o.z = pk2((bflo(a[u].z) + bflo(b2[u].z)) * il, (bfhi(a[u].z) + bfhi(b2[u].z)) * il); o.w = pk2((bflo(a[u].w) + bflo(b2[u].w)) * il, (bfhi(a[u].w) + bfhi(b2[u].w)) * il);
          *(u32x4*)(MIX + (size_t)r * DM + 512 + lane * 8) = o;
        }
      }
    }
  }
  f32x4 ong[4];
#pragma unroll
  for (int d = 0; d < 4; ++d) ong[d] = *(const f32x4*)(p.even_out_norm_g + 16 * d + 4 * q);
  for (int tsk = gw; tsk < NCHUNK * 8 * 4; tsk += ngw) {
    const int mtw = tsk & 3, h = (tsk >> 2) & 7, cid = tsk >> 5;
    const int roff = (16 * mtw + c) * 64 + 8 * q;
    const bf16_t* qn = QN + (size_t)(cid * 8 + h) * 4096;
    const bf16x8 q0 = *(const bf16x8*)(qn + roff), q1 = *(const bf16x8*)(qn + roff + 32);
    f32x4 oacc[4];
#pragma unroll
    for (int d = 0; d < 4; ++d) oacc[d] = (f32x4){0.f, 0.f, 0.f, 0.f};
#pragma unroll
    for (int dir = 0; dir < 2; ++dir) {
      const size_t cd = (size_t)((cid * 8 + h) * 2 + dir);
      const bf16_t* wua = WUA + cd * 3 * 4096; const bf16_t* sc = SC + cd * 4096;
      const float eg = EGD[cd * 128 + 16 * mtw + c];
      const bf16x8 a0 = *(const bf16x8*)(wua + 4096 + roff), a1 = *(const bf16x8*)(wua + 4096 + roff + 32);
#pragma unroll
      for (int d = 0; d < 4; ++d) {
        const int so = (16 * d + c) * 64 + 16 * q;
        const bf16x8 s0 = *(const bf16x8*)(sc + so), s1 = *(const bf16x8*)(sc + so + 8), v0 = *(const bf16x8*)(wua + 8192 + so), v1 = *(const bf16x8*)(wua + 8192 + so + 8);
        f32x4 t = (f32x4){0.f, 0.f, 0.f, 0.f};
        t = __builtin_amdgcn_mfma_f32_16x16x32_bf16(s0, q0, t, 0, 0, 0);
        t = __builtin_amdgcn_mfma_f32_16x16x32_bf16(s1, q1, t, 0, 0, 0);
        f32x4 o = oacc[d] + t * eg;
        o = __builtin_amdgcn_mfma_f32_16x16x32_bf16(v0, a0, o, 0, 0, 0);
        o = __builtin_amdgcn_mfma_f32_16x16x32_bf16(v1, a1, o, 0, 0, 0);
        oacc[d] = o;
      }
    }
    float ss = 0.f;
#pragma unroll
    for (int d = 0; d < 4; ++d) ss += oacc[d].x * oacc[d].x + oacc[d].y * oacc[d].y + oacc[d].z * oacc[d].z + oacc[d].w * oacc[d].w;
    ss += __shfl_xor(ss, 16); ss += __shfl_xor(ss, 32);
    const float rs = rsqrtf(ss * (1.f / 64.f) + EPS);
    const int row = cid * 64 + 16 * mtw + c;
#pragma unroll
    for (int d = 0; d < 4; ++d) {
      const int dv = 16 * d + 4 * q;
      const u32x2 z = *(const u32x2*)(PROJ + (size_t)row * PROJ_LD + 1536 + h * 64 + dv);
      const f32x4 o = oacc[d] * rs * ong[d];
      u32x2 ow; ow.x = pk2(o.x * silu_f(bflo(z.x)), o.y * silu_f(bfhi(z.x))); ow.y = pk2(o.z * silu_f(bflo(z.y)), o.w * silu_f(bfhi(z.y)));
      *(u32x2*)(MIX + (size_t)row * DM + h * 64 + dv) = ow;
    }
  }
}

__device__ __forceinline__ void na_item(const Params& p, int item, char* lds_all) {
  const int tid = ltid(), half = tid >> 8, lt = tid & 255, lane = lt & 63, w = lt >> 6, r32 = lane & 31, hh = lane >> 5;
  char* lds = lds_all + half * 53248;
  const bf16_t* PROJ = (const bf16_t*)(p.ws + WS_PROJ);
  bf16_t* MIX = (bf16_t*)(p.ws + WS_MIX);
  const int head = 2 * (item & 7) + half, rp = (item >> 3) & 63, b = item >> 9;
  const int QR = 2 * rp + (w >> 1), colh = w & 1;
  const int qc = 32 * colh + r32;
  const int qrow = b * SEQ + QR * 64 + qc;
  int rs_w = QR - 4; rs_w = rs_w < 0 ? 0 : (rs_w > 120 ? 120 : rs_w);
  int rlo = 2 * rp - 4; rlo = rlo < 0 ? 0 : (rlo > 120 ? 120 : rlo);
  int rhi = 2 * rp + 1 - 4; rhi = rhi < 0 ? 0 : (rhi > 120 ? 120 : rhi); rhi += 7;
  const int ntile = 4 + (rhi - rlo + 1);
  char* Kt = lds; char* Vt = lds + 24576; float* bias = (float*)(lds + 24576 + 3 * 8704);
  __syncthreads();
  for (int i = lt; i < 15 * 32; i += 256) { const int br = i >> 5, bc = i & 31; bias[i] = (bc < 31) ? p.odd_rpb[(size_t)head * 465 + br * 31 + bc] * LOG2E : -1e30f; }
  bf16x8 qf[4];
#pragma unroll
  for (int s = 0; s < 4; ++s) qf[s] = *(const bf16x8*)(PROJ + (size_t)qrow * PROJ_LD + head * 64 + 16 * s + 8 * hh);
  AttnState st; st.o0 = (f32x16){}; st.o1 = (f32x16){}; st.m = -1e30f; st.l = 0.f;
  const int lrow0 = lt >> 3, lch = lt & 7;
  auto tile_row0 = [&](int t) -> int { t = t < ntile ? t : ntile - 1; return t < 4 ? MLAT + b * NCTX + t * 64 : b * SEQ + (rlo + t - 4) * 64; };
  u32x4 rk0[2], rv0[2], rk1[2], rv1[2];
  const int vkp = lt & 31, vch = lt >> 5;
#define NA_GLOAD(R, T) do { const int r0_ = tile_row0(T); _Pragma("unroll") for (int i = 0; i < 2; ++i) { \
      rk##R[i] = *(const u32x4*)(PROJ + (size_t)(r0_ + lrow0 + 32 * i) * PROJ_LD + 1024 + head * 64 + lch * 8); \
      rv##R[i] = *(const u32x4*)(PROJ + (size_t)(r0_ + 2 * vkp + i) * PROJ_LD + 2048 + head * 64 + vch * 8); } } while (0)
#define NA_LSTORE(R, BUF) do { _Pragma("unroll") for (int i = 0; i < 2; ++i) { const int row_ = lrow0 + 32 * i; \
      *(u32x4*)(Kt + (BUF) * 8192 + row_ * 128 + ((lch ^ ((row_ >> 1) & 7)) << 4)) = rk##R[i]; } \
    { unsigned* vb_ = (unsigned*)(Vt + (BUF) * 8704) + vkp; const unsigned va_[4] = {rv##R[0].x, rv##R[0].y, rv##R[0].z, rv##R[0].w}, vc_[4] = {rv##R[1].x, rv##R[1].y, rv##R[1].z, rv##R[1].w}; \
      _Pragma("unroll") for (int q2 = 0; q2 < 4; ++q2) { vb_[(vch * 8 + 2 * q2) * 34] = (va_[q2] & 0xffffu) | (vc_[q2] << 16); vb_[(vch * 8 + 2 * q2 + 1) * 34] = (va_[q2] >> 16) | (vc_[q2] & 0xffff0000u); } } } while (0)
  NA_GLOAD(0, 0); NA_GLOAD(1, 1);
  NA_LSTORE(0, 0);
  __syncthreads();
  const float sc = 0.125f * LOG2E;
  int cs = qc - 8; cs = cs < 0 ? 0 : (cs > 48 ? 48 : cs);
#define NA_STEP(T, CUR) do { const int t_ = (T); const int KR = rlo + t_ - 4; \
    const bool active = (t_ < 4) || (KR >= rs_w && KR < rs_w + 8); \
    if (active) { f32x16 s0 = (f32x16){}, s1 = (f32x16){}; \
      attn_scores(Kt + (CUR) * 8192, qf, r32, hh, s0, s1); \
      if (t_ < 4) { _Pragma("unroll") for (int i = 0; i < 16; ++i) { s0[i] *= sc; s1[i] *= sc; } } \
      else { const float* brow = bias + (KR - QR + 7) * 32; _Pragma("unroll") for (int i = 0; i < 16; ++i) { const int kc0 = (i & 3) + 8 * (i >> 2) + 4 * hh, kc1 = kc0 + 32; \
          s0[i] = s0[i] * sc + brow[(kc0 >= cs && kc0 < cs + 16) ? kc0 - qc + 15 : 31]; s1[i] = s1[i] * sc + brow[(kc1 >= cs && kc1 < cs + 16) ? kc1 - qc + 15 : 31]; } } \
      attn_update(st, s0, s1, Vt + (CUR) * 8704, r32, hh); } } while (0)
  int b0 = 0, b1 = 1, b2 = 2;
  for (int t = 0; t < ntile; t += 2) {
    NA_GLOAD(0, t + 2);
    NA_STEP(t, b0);
    NA_LSTORE(1, b1);
    __syncthreads();
    if (t + 1 >= ntile) break;
    NA_GLOAD(1, t + 3);
    NA_STEP(t + 1, b1);
    NA_LSTORE(0, b2);
    __syncthreads();
    const int tb = b0; b0 = b2; b2 = b1; b1 = tb;
  }
#undef NA_GLOAD
#undef NA_LSTORE
#undef NA_STEP
  attn_store(st, MIX + (size_t)qrow * DM + head * 64, hh);
}
__device__ __forceinline__ void mix_odd(const Params& p, char* lds) {
  for (int item = blockIdx.x; item < 1024; item += gridDim.x) na_item(p, item, lds);
}

#define XB_TMO      128
#define XB_XCNT(j)  (256  + 64 * (j))
#define XB_XSUB(j)  (1280 + 64 * (j))
#define XB_XGEN(j)  (2304 + 64 * (j))
#define XB_TOP      3328
#define XB_TOPGEN   3392
#define XCD_BAR_WORDS 3456
#define XB_SPIN_CAP (1u << 22)
#define LAS __attribute__((address_space(3)))
__device__ __forceinline__ unsigned xb_ld(unsigned* p)              { return __hip_atomic_load(p, __ATOMIC_RELAXED, __HIP_MEMORY_SCOPE_AGENT); }
__device__ __forceinline__ unsigned xb_add(unsigned* p, unsigned v) { return __hip_atomic_fetch_add(p, v, __ATOMIC_RELAXED, __HIP_MEMORY_SCOPE_AGENT); }
__device__ __forceinline__ unsigned xb_xcc_id() { return (unsigned)__builtin_amdgcn_s_getreg((3 << 11) | 20) & 0xFu; }
#define XB_SPIN(cond, bar) do { unsigned _sp = 0; while (cond) { __builtin_amdgcn_s_sleep(1); \
    if ((++_sp & 255u) == 0u) { if (xb_ld(&(bar)[XB_TMO])) break; if (_sp > XB_SPIN_CAP) { atomicAdd(&(bar)[XB_TMO], 1u); break; } } } } while (0)
struct XcdBarrier { unsigned* bar; unsigned x; volatile LAS unsigned* st; };
__device__ __forceinline__ XcdBarrier xcd_barrier_post(unsigned* bar, volatile LAS unsigned* st) {
    XcdBarrier b; b.bar = bar; b.x = xb_xcc_id(); b.st = st;
    if (threadIdx.x == 0) (void)xb_add(&bar[XB_XCNT(b.x)], 1u);
    return b;
}
__device__ __forceinline__ void xcd_barrier_complete(unsigned* bar, unsigned x, unsigned& nloc, unsigned& nx) {
    const unsigned G = gridDim.x * gridDim.y * gridDim.z;
    unsigned sum, cnt, mine, sp = 0u;
    for (;;) {
        sum = 0u; cnt = 0u; mine = 0u;
#pragma unroll
        for (unsigned j = 0; j < 16; ++j) { const unsigned c = xb_ld(&bar[XB_XCNT(j)]); sum += c; cnt += (c > 0u) ? 1u : 0u; mine = (j == x) ? c : mine; }
        if (sum == G) break;
        __builtin_amdgcn_s_sleep(1);
        if ((++sp & 255u) == 0u) { if (xb_ld(&bar[XB_TMO])) break; if (sp > XB_SPIN_CAP) { atomicAdd(&bar[XB_TMO], 1u); break; } }
    }
    nloc = mine > 0u ? mine : 1u; nx = cnt > 0u ? cnt : 1u;
}
__device__ __forceinline__ void xcd_barrier(const XcdBarrier& b) {
    asm volatile("s_waitcnt vmcnt(0)" ::: "memory");
    __syncthreads();
    if (threadIdx.x == 0) {
        unsigned* bar = b.bar;
        __builtin_amdgcn_s_waitcnt(0);
        unsigned nloc = b.st[0], nx = b.st[1];
        if (nloc == 0u) { xcd_barrier_complete(bar, b.x, nloc, nx); b.st[0] = nloc; b.st[1] = nx; }
        const unsigned old = xb_add(&bar[XB_XSUB(b.x)], 1u);
        const unsigned gen = old / nloc;
        if (old + 1u == (gen + 1u) * nloc) {
            __builtin_amdgcn_fence(__ATOMIC_RELEASE, "agent");
            asm volatile("s_waitcnt vmcnt(0)" ::: "memory");
            const unsigned og = xb_add(&bar[XB_TOP], 1u);
            const unsigned tg = og / nx;
            if (og + 1u == (tg + 1u) * nx) xb_add(&bar[XB_TOPGEN], 1u);
            else XB_SPIN(xb_ld(&bar[XB_TOPGEN]) == tg, bar);
            __builtin_amdgcn_fence(__ATOMIC_ACQUIRE, "agent");
            xb_add(&bar[XB_XGEN(b.x)], 1u);
            asm volatile("s_waitcnt vmcnt(0)" ::: "memory");
        } else {
            XB_SPIN(xb_ld(&bar[XB_XGEN(b.x)]) == gen, bar);
            __builtin_amdgcn_fence(__ATOMIC_ACQUIRE, "agent");
            asm volatile("s_waitcnt vmcnt(0)" ::: "memory");
        }
    }
    __syncthreads();
}
#define GSYNC() xcd_barrier(xbar)

constexpr int PT_OFF = LDS_BYTES - 16 - 256;
template <class T> __device__ __forceinline__ T* ldptr(const char* lds, int i) {
  const volatile unsigned* q = (const volatile unsigned*)(lds + PT_OFF + 8 * i);
  const unsigned lo = __builtin_amdgcn_readfirstlane(q[0]), hi = __builtin_amdgcn_readfirstlane(q[1]);
  typedef __attribute__((address_space(1))) T* gptr_t;
  return (T*)(gptr_t)(((unsigned long long)hi << 32) | (unsigned long long)lo);
}
__device__ __forceinline__ Params fresh(const char* lds) {
  Params p;
  p.x = ldptr<const float>(lds, 0); p.c = ldptr<const float>(lds, 1); p.ctx = ldptr<const float>(lds, 2); p.c_ctx = ldptr<const float>(lds, 3); p.ada_w = ldptr<const float>(lds, 4); p.ada_b = ldptr<const float>(lds, 5);
  p.ln1_g = ldptr<const float>(lds, 6); p.ln2_g = ldptr<const float>(lds, 7); p.even_w_in = ldptr<const float>(lds, 8); p.even_conv_w = ldptr<const float>(lds, 9); p.even_a_log = ldptr<const float>(lds, 10);
  p.even_dt_bias = ldptr<const float>(lds, 11); p.even_out_norm_g = ldptr<const float>(lds, 12); p.even_q_norm_g = ldptr<const float>(lds, 13); p.even_k_norm_g = ldptr<const float>(lds, 14);
  p.even_w_out = ldptr<const float>(lds, 15); p.odd_w_in = ldptr<const float>(lds, 16); p.odd_rpb = ldptr<const float>(lds, 17); p.odd_w_out = ldptr<const float>(lds, 18); p.router_w = ldptr<const float>(lds, 19);
  p.w_gate = ldptr<const float>(lds, 20); p.w_up = ldptr<const float>(lds, 21); p.w_down = ldptr<const float>(lds, 22); p.final_g = ldptr<const float>(lds, 23);
  p.out = ldptr<float>(lds, 24); p.ws = ldptr<unsigned char>(lds, 25);
  return p;
}
__global__ void __launch_bounds__(NT, 2) fwd_megakernel(Params p0) {
  cg::grid_group grid = cg::this_grid();
  extern __shared__ __attribute__((aligned(16))) char lds[];
  volatile LAS unsigned* xb_st = (volatile LAS unsigned*)(lds + LDS_BYTES - 16);
  if (threadIdx.x < 4) xb_st[threadIdx.x] = 0u;
  if (threadIdx.x == 0) {
    unsigned long long* tab = (unsigned long long*)(lds + PT_OFF);
    tab[0] = (unsigned long long)p0.x; tab[1] = (unsigned long long)p0.c; tab[2] = (unsigned long long)p0.ctx; tab[3] = (unsigned long long)p0.c_ctx; tab[4] = (unsigned long long)p0.ada_w; tab[5] = (unsigned long long)p0.ada_b;
    tab[6] = (unsigned long long)p0.ln1_g; tab[7] = (unsigned long long)p0.ln2_g; tab[8] = (unsigned long long)p0.even_w_in; tab[9] = (unsigned long long)p0.even_conv_w; tab[10] = (unsigned long long)p0.even_a_log;
    tab[11] = (unsigned long long)p0.even_dt_bias; tab[12] = (unsigned long long)p0.even_out_norm_g; tab[13] = (unsigned long long)p0.even_q_norm_g; tab[14] = (unsigned long long)p0.even_k_norm_g;
    tab[15] = (unsigned long long)p0.even_w_out; tab[16] = (unsigned long long)p0.odd_w_in; tab[17] = (unsigned long long)p0.odd_rpb; tab[18] = (unsigned long long)p0.odd_w_out; tab[19] = (unsigned long long)p0.router_w;
    tab[20] = (unsigned long long)p0.w_gate; tab[21] = (unsigned long long)p0.w_up; tab[22] = (unsigned long long)p0.w_down; tab[23] = (unsigned long long)p0.final_g;
    tab[24] = (unsigned long long)p0.out; tab[25] = (unsigned long long)p0.ws;
  }
  __syncthreads();
  XcdBarrier xbar = xcd_barrier_post((unsigned*)(ldptr<unsigned char>(lds, 25) + WS_CTL + 16384), xb_st);
  grid.sync();

  { const Params p = fresh(lds); const bf16_t* A = (const bf16_t*)(p.ws + WS_A); const float* MOD = (const float*)(p.ws + WS_MOD); const bf16_t* WEXP = (const bf16_t*)(p.ws + WS_WEXP); bf16_t* PROJ = (bf16_t*)(p.ws + WS_PROJ); const bf16_t* MIX = (const bf16_t*)(p.ws + WS_MIX); (void)A; (void)MOD; (void)WEXP; (void)PROJ; (void)MIX; phase0(p, lds); }
  GSYNC();
  { const Params p = fresh(lds); const bf16_t* A = (const bf16_t*)(p.ws + WS_A); const float* MOD = (const float*)(p.ws + WS_MOD); const bf16_t* WEXP = (const bf16_t*)(p.ws + WS_WEXP); bf16_t* PROJ = (bf16_t*)(p.ws + WS_PROJ); const bf16_t* MIX = (const bf16_t*)(p.ws + WS_MIX); (void)A; (void)MOD; (void)WEXP; (void)PROJ; (void)MIX; rowpass_a<0, false>(p, lds); }
  GSYNC();
  { const Params p = fresh(lds); const bf16_t* A = (const bf16_t*)(p.ws + WS_A); const float* MOD = (const float*)(p.ws + WS_MOD); const bf16_t* WEXP = (const bf16_t*)(p.ws + WS_WEXP); bf16_t* PROJ = (bf16_t*)(p.ws + WS_PROJ); const bf16_t* MIX = (const bf16_t*)(p.ws + WS_MIX); (void)A; (void)MOD; (void)WEXP; (void)PROJ; (void)MIX;  EpiStoreBf16 E{PROJ, PROJ_LD, nullptr}; big_gemm(lds, A, (const bf16_t*)(p.ws + WS_WEI), MLAT, 3072, 0, 0, E);  }
  { const Params p = fresh(lds); const bf16_t* A = (const bf16_t*)(p.ws + WS_A); const float* MOD = (const float*)(p.ws + WS_MOD); const bf16_t* WEXP = (const bf16_t*)(p.ws + WS_WEXP); bf16_t* PROJ = (bf16_t*)(p.ws + WS_PROJ); const bf16_t* MIX = (const bf16_t*)(p.ws + WS_MIX); (void)A; (void)MOD; (void)WEXP; (void)PROJ; (void)MIX;  OpInProjCtx<0> op{A, (const bf16_t*)(p.ws + WS_WEI), PROJ, 4 * 23}; gemm_small_phase(op, lds);  }
  GSYNC();
  { const Params p = fresh(lds); const bf16_t* A = (const bf16_t*)(p.ws + WS_A); const float* MOD = (const float*)(p.ws + WS_MOD); const bf16_t* WEXP = (const bf16_t*)(p.ws + WS_WEXP); bf16_t* PROJ = (bf16_t*)(p.ws + WS_PROJ); const bf16_t* MIX = (const bf16_t*)(p.ws + WS_MIX); (void)A; (void)MOD; (void)WEXP; (void)PROJ; (void)MIX; prep_even(p, lds); }
  GSYNC();
  { const Params p = fresh(lds); const bf16_t* A = (const bf16_t*)(p.ws + WS_A); const float* MOD = (const float*)(p.ws + WS_MOD); const bf16_t* WEXP = (const bf16_t*)(p.ws + WS_WEXP); bf16_t* PROJ = (bf16_t*)(p.ws + WS_PROJ); const bf16_t* MIX = (const bf16_t*)(p.ws + WS_MIX); (void)A; (void)MOD; (void)WEXP; (void)PROJ; (void)MIX; mix_even(p, lds); }
  GSYNC();
  { const Params p = fresh(lds); const bf16_t* A = (const bf16_t*)(p.ws + WS_A); const float* MOD = (const float*)(p.ws + WS_MOD); const bf16_t* WEXP = (const bf16_t*)(p.ws + WS_WEXP); bf16_t* PROJ = (bf16_t*)(p.ws + WS_PROJ); const bf16_t* MIX = (const bf16_t*)(p.ws + WS_MIX); (void)A; (void)MOD; (void)WEXP; (void)PROJ; (void)MIX; gate_phase(p); }
  GSYNC();
  { const Params p = fresh(lds); const bf16_t* A = (const bf16_t*)(p.ws + WS_A); const float* MOD = (const float*)(p.ws + WS_MOD); const bf16_t* WEXP = (const bf16_t*)(p.ws + WS_WEXP); bf16_t* PROJ = (bf16_t*)(p.ws + WS_PROJ); const bf16_t* MIX = (const bf16_t*)(p.ws + WS_MIX); (void)A; (void)MOD; (void)WEXP; (void)PROJ; (void)MIX;  EpiResid E{p.out, p.out, MOD + 2 * 1024}; big_gemm(lds, MIX, (const bf16_t*)(p.ws + WS_WEO), MLAT, 1024, 0, 0, E);  }
  { const Params p = fresh(lds); const bf16_t* A = (const bf16_t*)(p.ws + WS_A); const float* MOD = (const float*)(p.ws + WS_MOD); const bf16_t* WEXP = (const bf16_t*)(p.ws + WS_WEXP); bf16_t* PROJ = (bf16_t*)(p.ws + WS_PROJ); const bf16_t* MIX = (const bf16_t*)(p.ws + WS_MIX); (void)A; (void)MOD; (void)WEXP; (void)PROJ; (void)MIX;  OpOutProjCtx op{MIX, (const bf16_t*)(p.ws + WS_WEO), MOD + 2 * 6144 + 2 * 1024, (float*)(p.ws + WS_HC), 4 * 8}; gemm_small_phase(op, lds);  }
  GSYNC();
  { const Params p = fresh(lds); const bf16_t* A = (const bf16_t*)(p.ws + WS_A); const float* MOD = (const float*)(p.ws + WS_MOD); const bf16_t* WEXP = (const bf16_t*)(p.ws + WS_WEXP); bf16_t* PROJ = (bf16_t*)(p.ws + WS_PROJ); const bf16_t* MIX = (const bf16_t*)(p.ws + WS_MIX); (void)A; (void)MOD; (void)WEXP; (void)PROJ; (void)MIX; rowpass_b<0>(p, lds); }
  GSYNC();
  { const Params p = fresh(lds); const bf16_t* A = (const bf16_t*)(p.ws + WS_A); const float* MOD = (const float*)(p.ws + WS_MOD); const bf16_t* WEXP = (const bf16_t*)(p.ws + WS_WEXP); bf16_t* PROJ = (bf16_t*)(p.ws + WS_PROJ); const bf16_t* MIX = (const bf16_t*)(p.ws + WS_MIX); (void)A; (void)MOD; (void)WEXP; (void)PROJ; (void)MIX; topk_phase<0>(p, lds); if (blockIdx.x >= 64) convert_experts(p, 1, lds, (bf16_t*)(p.ws + WS_WEXP1), 0, 3072, ((int)blockIdx.x - 64) * NWV + (ltid() >> 6), ((int)gridDim.x - 64) * NWV); }
  GSYNC();
  { const Params p = fresh(lds); const bf16_t* A = (const bf16_t*)(p.ws + WS_A); const float* MOD = (const float*)(p.ws + WS_MOD); const bf16_t* WEXP = (const bf16_t*)(p.ws + WS_WEXP); bf16_t* PROJ = (bf16_t*)(p.ws + WS_PROJ); const bf16_t* MIX = (const bf16_t*)(p.ws + WS_MIX); (void)A; (void)MOD; (void)WEXP; (void)PROJ; (void)MIX;  EpiMoe1 E{(bf16_t*)(p.ws + WS_HIDL)}; big_gemm_gather(lds, A, (const int*)(p.ws + WS_IDX), WEXP, 16 * 2048, 2048, 8, EXPW * 2, E);  }
  { const Params p = fresh(lds); const bf16_t* A = (const bf16_t*)(p.ws + WS_A); const float* MOD = (const float*)(p.ws + WS_MOD); const bf16_t* WEXP = (const bf16_t*)(p.ws + WS_WEXP); bf16_t* PROJ = (bf16_t*)(p.ws + WS_PROJ); const bf16_t* MIX = (const bf16_t*)(p.ws + WS_MIX); (void)A; (void)MOD; (void)WEXP; (void)PROJ; (void)MIX;  OpMoe1Ctx op{A, WEXP, (const int*)(p.ws + WS_IDX), (bf16_t*)(p.ws + WS_HIDC), 16 * 16}; gemm_small_phase(op, lds);  }
  GSYNC();
  { const Params p = fresh(lds); const bf16_t* A = (const bf16_t*)(p.ws + WS_A); const float* MOD = (const float*)(p.ws + WS_MOD); const bf16_t* WEXP = (const bf16_t*)(p.ws + WS_WEXP); bf16_t* PROJ = (bf16_t*)(p.ws + WS_PROJ); const bf16_t* MIX = (const bf16_t*)(p.ws + WS_MIX); (void)A; (void)MOD; (void)WEXP; (void)PROJ; (void)MIX;  EpiStoreBf16 E{(bf16_t*)(p.ws + WS_YL), DM, (const float*)(p.ws + WS_GATEV)}; big_gemm(lds, (const bf16_t*)(p.ws + WS_HIDL), WEXP + (size_t)2048 * DM, 16 * 2048, 1024, 8, EXPW * 2, E);  }
  { const Params p = fresh(lds); const bf16_t* A = (const bf16_t*)(p.ws + WS_A); const float* MOD = (const float*)(p.ws + WS_MOD); const bf16_t* WEXP = (const bf16_t*)(p.ws + WS_WEXP); bf16_t* PROJ = (bf16_t*)(p.ws + WS_PROJ); const bf16_t* MIX = (const bf16_t*)(p.ws + WS_MIX); (void)A; (void)MOD; (void)WEXP; (void)PROJ; (void)MIX;  OpMoe2Ctx op{(const bf16_t*)(p.ws + WS_HIDC), WEXP, (const float*)(p.ws + WS_GATEV), (bf16_t*)(p.ws + WS_YC), 16 * 8}; gemm_small_phase(op, lds);  }
  GSYNC();
  { const Params p = fresh(lds); const bf16_t* A = (const bf16_t*)(p.ws + WS_A); const float* MOD = (const float*)(p.ws + WS_MOD); const bf16_t* WEXP = (const bf16_t*)(p.ws + WS_WEXP1); bf16_t* PROJ = (bf16_t*)(p.ws + WS_PROJ); const bf16_t* MIX = (const bf16_t*)(p.ws + WS_MIX); (void)A; (void)MOD; (void)WEXP; (void)PROJ; (void)MIX; rowpass_a<1, false>(p, lds); }
  GSYNC();
  { const Params p = fresh(lds); const bf16_t* A = (const bf16_t*)(p.ws + WS_A); const float* MOD = (const float*)(p.ws + WS_MOD); const bf16_t* WEXP = (const bf16_t*)(p.ws + WS_WEXP1); bf16_t* PROJ = (bf16_t*)(p.ws + WS_PROJ); const bf16_t* MIX = (const bf16_t*)(p.ws + WS_MIX); (void)A; (void)MOD; (void)WEXP; (void)PROJ; (void)MIX;  EpiStoreBf16 E{PROJ, PROJ_LD, nullptr}; big_gemm(lds, A, (const bf16_t*)(p.ws + WS_WOI), MLAT, 3072, 0, 0, E);  }
  { const Params p = fresh(lds); const bf16_t* A = (const bf16_t*)(p.ws + WS_A); const float* MOD = (const float*)(p.ws + WS_MOD); const bf16_t* WEXP = (const bf16_t*)(p.ws + WS_WEXP1); bf16_t* PROJ = (bf16_t*)(p.ws + WS_PROJ); const bf16_t* MIX = (const bf16_t*)(p.ws + WS_MIX); (void)A; (void)MOD; (void)WEXP; (void)PROJ; (void)MIX;  OpInProjCtx<1> op{A, (const bf16_t*)(p.ws + WS_WOI), PROJ, 4 * 16}; gemm_small_phase(op, lds);  }
  GSYNC();
  { const Params p = fresh(lds); const bf16_t* A = (const bf16_t*)(p.ws + WS_A); const float* MOD = (const float*)(p.ws + WS_MOD); const bf16_t* WEXP = (const bf16_t*)(p.ws + WS_WEXP1); bf16_t* PROJ = (bf16_t*)(p.ws + WS_PROJ); const bf16_t* MIX = (const bf16_t*)(p.ws + WS_MIX); (void)A; (void)MOD; (void)WEXP; (void)PROJ; (void)MIX; mix_odd(p, lds); }
  GSYNC();
  { const Params p = fresh(lds); const bf16_t* A = (const bf16_t*)(p.ws + WS_A); const float* MOD = (const float*)(p.ws + WS_MOD); const bf16_t* WEXP = (const bf16_t*)(p.ws + WS_WEXP1); bf16_t* PROJ = (bf16_t*)(p.ws + WS_PROJ); const bf16_t* MIX = (const bf16_t*)(p.ws + WS_MIX); (void)A; (void)MOD; (void)WEXP; (void)PROJ; (void)MIX;  EpiResid E{p.out, p.out, MOD + 3 * 6144 + 2 * 1024}; big_gemm(lds, MIX, (const bf16_t*)(p.ws + WS_WOO), MLAT, 1024, 0, 0, E);  }
  GSYNC();
  { const Params p = fresh(lds); const bf16_t* A = (const bf16_t*)(p.ws + WS_A); const float* MOD = (const float*)(p.ws + WS_MOD); const bf16_t* WEXP = (const bf16_t*)(p.ws + WS_WEXP1); bf16_t* PROJ = (bf16_t*)(p.ws + WS_PROJ); const bf16_t* MIX = (const bf16_t*)(p.ws + WS_MIX); (void)A; (void)MOD; (void)WEXP; (void)PROJ; (void)MIX; rowpass_b<1>(p, lds); }
  GSYNC();
  { const Params p = fresh(lds); const bf16_t* A = (const bf16_t*)(p.ws + WS_A); const float* MOD = (const float*)(p.ws + WS_MOD); const bf16_t* WEXP = (const bf16_t*)(p.ws + WS_WEXP1); bf16_t* PROJ = (bf16_t*)(p.ws + WS_PROJ); const bf16_t* MIX = (const bf16_t*)(p.ws + WS_MIX); (void)A; (void)MOD; (void)WEXP; (void)PROJ; (void)MIX; topk_phase<1>(p, lds); if (blockIdx.x >= 32) convert_experts(p, 1, lds, (bf16_t*)(p.ws + WS_WEXP1), 3072, 6144, ((int)blockIdx.x - 32) * NWV + (ltid() >> 6), ((int)gridDim.x - 32) * NWV); }
  GSYNC();
  { const Params p = fresh(lds); const bf16_t* A = (const bf16_t*)(p.ws + WS_A); const float* MOD = (const float*)(p.ws + WS_MOD); const bf16_t* WEXP = (const bf16_t*)(p.ws + WS_WEXP1); bf16_t* PROJ = (bf16_t*)(p.ws + WS_PROJ); const bf16_t* MIX = (const bf16_t*)(p.ws + WS_MIX); (void)A; (void)MOD; (void)WEXP; (void)PROJ; (void)MIX;  EpiMoe1 E{(bf16_t*)(p.ws + WS_HIDL)}; big_gemm_gather(lds, A, (const int*)(p.ws + WS_IDX), WEXP, 16 * 2048, 2048, 8, EXPW * 2, E);  }
  GSYNC();
  { const Params p = fresh(lds); const bf16_t* A = (const bf16_t*)(p.ws + WS_A); const float* MOD = (const float*)(p.ws + WS_MOD); const bf16_t* WEXP = (const bf16_t*)(p.ws + WS_WEXP1); bf16_t* PROJ = (bf16_t*)(p.ws + WS_PROJ); const bf16_t* MIX = (const bf16_t*)(p.ws + WS_MIX); (void)A; (void)MOD; (void)WEXP; (void)PROJ; (void)MIX;  EpiStoreBf16 E{(bf16_t*)(p.ws + WS_YL), DM, (const float*)(p.ws + WS_GATEV)}; big_gemm(lds, (const bf16_t*)(p.ws + WS_HIDL), WEXP + (size_t)2048 * DM, 16 * 2048, 1024, 8, EXPW * 2, E);  }
  GSYNC();
  { const Params p = fresh(lds); const bf16_t* A = (const bf16_t*)(p.ws + WS_A); const float* MOD = (const float*)(p.ws + WS_MOD); const bf16_t* WEXP = (const bf16_t*)(p.ws + WS_WEXP1); bf16_t* PROJ = (bf16_t*)(p.ws + WS_PROJ); const bf16_t* MIX = (const bf16_t*)(p.ws + WS_MIX); (void)A; (void)MOD; (void)WEXP; (void)PROJ; (void)MIX; rowpass_a<1, true>(p, lds); }
}

extern "C" void kernel_launch(void* const* d_in, const int* in_sizes, int n_in, void* d_out, int out_size,
                              void* d_ws, size_t ws_size, hipStream_t stream) {
  static int grid_blocks = 0;
  if (!grid_blocks) {
    int dev = 0, cus = 0, per_cu = 0;
    (void)hipGetDevice(&dev);
    (void)hipDeviceGetAttribute(&cus, hipDeviceAttributeMultiprocessorCount, dev);
    (void)hipFuncSetAttribute((const void*)fwd_megakernel, hipFuncAttributeMaxDynamicSharedMemorySize, LDS_BYTES);
    (void)hipOccupancyMaxActiveBlocksPerMultiprocessor(&per_cu, fwd_megakernel, NT, LDS_BYTES);
    if (per_cu > 1) per_cu = 1;
    grid_blocks = cus * per_cu;
    if (ws_size < WS_END || n_in != 24 || per_cu < 1 || (grid_blocks & 7)) { fprintf(stderr, "kernel_launch: unexpected setup (ws %zu need %zu, n_in %d, per_cu %d, grid %d)\n", ws_size, (size_t)WS_END, n_in, per_cu, grid_blocks); grid_blocks = -1; }
  }
  if (grid_blocks < 0) return;
  Params p{};
  const float** pp = (const float**)&p;
  for (int i = 0; i < 24; ++i) pp[i] = (const float*)d_in[i];
  p.out = (float*)d_out; p.ws = (unsigned char*)d_ws;
  void* args[] = {&p};
  (void)hipMemsetAsync((char*)d_ws + WS_CTL + 16384, 0, XCD_BAR_WORDS * 4, stream);
  hipError_t e = hipLaunchCooperativeKernel((void*)fwd_megakernel, dim3(grid_blocks), dim3(NT), args, LDS_BYTES, stream);
  if (e != hipSuccess) fprintf(stderr, "cooperative launch failed: %s (grid %d)\n", hipGetErrorString(e), grid_blocks);
}
```

```cpp
#include <hip/hip_runtime.h>
#include <hip/hip_cooperative_groups.h>
#include <cstdio>
#include <cstdint>
namespace cg = cooperative_groups;

typedef unsigned short bf16_t;
typedef short bf16x8 __attribute__((ext_vector_type(8)));
typedef float f32x2 __attribute__((ext_vector_type(2)));
typedef float f32x4 __attribute__((ext_vector_type(4)));
typedef float f32x16 __attribute__((ext_vector_type(16)));
typedef unsigned u32x2 __attribute__((ext_vector_type(2)));
typedef unsigned u32x4 __attribute__((ext_vector_type(4)));
typedef __bf16 bf16x2_t __attribute__((ext_vector_type(2)));

constexpr int NT = 512, NWV = 8;
constexpr int LDS_BYTES = 155648;
constexpr int DM = 1024, SEQ = 8192, NCTX = 256;
constexpr int MLAT = 2 * SEQ;
constexpr int NR = MLAT + 2 * NCTX;
constexpr int PROJ_LD = 3072;
constexpr int NKEY = NCTX + SEQ;
constexpr int SLOTS = 2112;
constexpr int NCHUNK = NR / 64;
constexpr float LOG2E = 1.4426950408889634f;
constexpr float EPS = 1e-6f;

constexpr size_t MB = 1u << 20;
constexpr size_t WS_CTL = 0;
constexpr size_t WS_MOD = 64 * 1024;
constexpr size_t WS_ROPE = 1 * MB;
constexpr size_t WS_AFF = 3 * MB;
constexpr size_t WS_INV = 5 * MB;
constexpr size_t WS_IDX = 7 * MB;
constexpr size_t WS_GATEV = 7 * MB + 512 * 1024;
constexpr size_t WS_GATES = 8 * MB;
constexpr size_t WS_EGDEC = 11 * MB;
constexpr size_t WS_HC = 14 * MB;
constexpr size_t WS_WEI = 16 * MB;
constexpr size_t WS_WEO = 23 * MB;
constexpr size_t WS_WOI = 25 * MB;
constexpr size_t WS_WOO = 32 * MB;
constexpr size_t WS_WEXP = 34 * MB;
constexpr size_t WS_A = 136 * MB;
constexpr size_t WS_R = 172 * MB;
constexpr size_t WS_PROJ = WS_R;
constexpr size_t WS_MIX = WS_R + 104 * MB;
constexpr size_t WS_O1 = WS_R + 139 * MB;
constexpr size_t WS_QB = WS_R + 157 * MB;
constexpr size_t WS_KB = WS_R + 175 * MB;
constexpr size_t WS_VT = WS_R + 180 * MB;
constexpr size_t WS_QN = WS_R + 185 * MB;
constexpr size_t WS_KNT = WS_R + 203 * MB;
constexpr size_t WS_WUA = WS_R + 221 * MB;
constexpr size_t WS_WEXP1 = WS_R + (221ull << 20);
constexpr size_t WS_XS = WS_R;
constexpr size_t WS_HIDL = WS_R + 64 * MB;
constexpr size_t WS_YL = WS_R + 128 * MB;
constexpr size_t WS_HIDC = WS_R + 192 * MB;
constexpr size_t WS_YC = WS_R + 194 * MB;
constexpr size_t WS_END = WS_R + 326 * MB;
constexpr size_t EXPW = (size_t)3072 * 1024;

struct Params {
  const float* x; const float* c; const float* ctx; const float* c_ctx; const float* ada_w; const float* ada_b;
  const float* ln1_g; const float* ln2_g; const float* even_w_in; const float* even_conv_w; const float* even_a_log;
  const float* even_dt_bias; const float* even_out_norm_g; const float* even_q_norm_g; const float* even_k_norm_g;
  const float* even_w_out; const float* odd_w_in; const float* odd_rpb; const float* odd_w_out; const float* router_w;
  const float* w_gate; const float* w_up; const float* w_down; const float* final_g;
  float* out; unsigned char* ws;
};

__device__ __forceinline__ unsigned pk2(float lo, float hi) { f32x2 v = {lo, hi}; bf16x2_t b = __builtin_convertvector(v, bf16x2_t); return __builtin_bit_cast(unsigned, b); }
__device__ __forceinline__ float bflo(unsigned u) { return __uint_as_float(u << 16); }
__device__ __forceinline__ float bfhi(unsigned u) { return __uint_as_float(u & 0xffff0000u); }
__device__ __forceinline__ float bf1(bf16_t b) { return __uint_as_float(((unsigned)b) << 16); }
__device__ __forceinline__ bf16_t f2bf(float f) { return (bf16_t)(pk2(f, 0.f) & 0xffffu); }
__device__ __forceinline__ float wave_sum(float v) {
  v += __int_as_float(__builtin_amdgcn_mov_dpp(__float_as_int(v), 0xB1, 0xF, 0xF, true));
  v += __int_as_float(__builtin_amdgcn_mov_dpp(__float_as_int(v), 0x4E, 0xF, 0xF, true));
  v += __int_as_float(__builtin_amdgcn_mov_dpp(__float_as_int(v), 0x141, 0xF, 0xF, true));
  v += __int_as_float(__builtin_amdgcn_mov_dpp(__float_as_int(v), 0x140, 0xF, 0xF, true));
  const float r0 = __int_as_float(__builtin_amdgcn_readlane(__float_as_int(v), 0)), r1 = __int_as_float(__builtin_amdgcn_readlane(__float_as_int(v), 16));
  const float r2 = __int_as_float(__builtin_amdgcn_readlane(__float_as_int(v), 32)), r3 = __int_as_float(__builtin_amdgcn_readlane(__float_as_int(v), 48));
  return (r0 + r1) + (r2 + r3);
}
__device__ __forceinline__ float silu_f(float v) { return v * __builtin_amdgcn_rcpf(1.f + __expf(-v)); }
__device__ __forceinline__ float sigmoid_f(float v) { return __builtin_amdgcn_rcpf(1.f + __expf(-v)); }
__device__ __forceinline__ float softplus_f(float v) { return fmaxf(v, 0.f) + log1pf(__expf(-fabsf(v))); }
__device__ __forceinline__ int row_sel(int r) { return r >= MLAT ? 2 : (r >> 13); }
__device__ __forceinline__ float* hrow_ptr(const Params& p, int r) { return r < MLAT ? p.out + (size_t)r * DM : (float*)(p.ws + WS_HC) + (size_t)(r - MLAT) * DM; }

__device__ __forceinline__ void sincos_d(float af, float& sn, float& cs) {
  const double a = (double)af;
  const double k = rint(a * 0.63661977236758134308);
  const double r = (a - k * 1.57079632679489655800) - k * 6.12323399573676603587e-17;
  const double r2 = r * r;
  double s = r * (1.0 + r2 * (-1.0 / 6 + r2 * (1.0 / 120 + r2 * (-1.0 / 5040 + r2 * (1.0 / 362880 + r2 * (-1.0 / 39916800 + r2 * (1.0 / 6227020800.0)))))));
  double c = 1.0 + r2 * (-0.5 + r2 * (1.0 / 24 + r2 * (-1.0 / 720 + r2 * (1.0 / 40320 + r2 * (-1.0 / 3628800 + r2 * (1.0 / 479001600.0 + r2 * (-1.0 / 87178291200.0)))))));
  const int q = ((int)k) & 3;
  double ss = (q & 1) ? c : s, cc = (q & 1) ? s : c;
  if (q == 1) cc = -cc; else if (q == 2) { ss = -ss; cc = -cc; } else if (q == 3) ss = -ss;
  sn = (float)ss; cs = (float)cc;
}

__device__ __forceinline__ float dpp_xor1(float v) { return __int_as_float(__builtin_amdgcn_mov_dpp(__float_as_int(v), 0xB1, 0xF, 0xF, true)); }
__device__ __forceinline__ float dpp_xor2(float v) { return __int_as_float(__builtin_amdgcn_mov_dpp(__float_as_int(v), 0x4E, 0xF, 0xF, true)); }
__device__ __forceinline__ float dpp_xor4(float v) { int t = __builtin_amdgcn_mov_dpp(__float_as_int(v), 0x141, 0xF, 0xF, true); t = __builtin_amdgcn_mov_dpp(t, 0x1B, 0xF, 0xF, true); return __int_as_float(t); }
__device__ __forceinline__ float dpp_xor8(float v) { int t = __builtin_amdgcn_mov_dpp(__float_as_int(v), 0x140, 0xF, 0xF, true); t = __builtin_amdgcn_mov_dpp(t, 0x141, 0xF, 0xF, true); return __int_as_float(t); }
typedef unsigned u32x2s __attribute__((ext_vector_type(2)));
__device__ __forceinline__ float swap16_sum(float x, float y) { const u32x2s r = __builtin_amdgcn_permlane16_swap(__float_as_uint(x), __float_as_uint(y), false, false); return __uint_as_float(r.x) + __uint_as_float(r.y); }
__device__ __forceinline__ float swap32_sum(float x, float y) { const u32x2s r = __builtin_amdgcn_permlane32_swap(__float_as_uint(x), __float_as_uint(y), false, false); return __uint_as_float(r.x) + __uint_as_float(r.y); }
__device__ __forceinline__ float swap16_max(float x) { const u32x2s r = __builtin_amdgcn_permlane16_swap(__float_as_uint(x), __float_as_uint(x), false, false); return fmaxf(__uint_as_float(r.x), __uint_as_float(r.y)); }
__device__ __forceinline__ float swap32_max(float x) { const u32x2s r = __builtin_amdgcn_permlane32_swap(__float_as_uint(x), __float_as_uint(x), false, false); return fmaxf(__uint_as_float(r.x), __uint_as_float(r.y)); }
__device__ __forceinline__ unsigned wave_incl_scan_u(unsigned v, int lane) {
#pragma unroll
  for (int o = 1; o < 64; o <<= 1) { const unsigned t = __shfl_up(v, o); if (lane >= o) v += t; }
  return v;
}
__device__ __forceinline__ float wave_incl_scan_f(float v, int lane) {
#pragma unroll
  for (int o = 1; o < 64; o <<= 1) { const float t = __shfl_up(v, o); if (lane >= o) v += t; }
  return v;
}

__device__ __forceinline__ int ltid() { int t = threadIdx.x; asm volatile("" : "+v"(t)); return t; }

__device__ __forceinline__ float tred32(float (&a)[32], int lane) {
  float b[16], c[8], d[4], e[2];
  const bool h5 = lane & 32, h4 = lane & 16, h3 = lane & 8, h2 = lane & 4, h1 = lane & 2;
#pragma unroll
  for (int j = 0; j < 16; ++j) { const float keep = h5 ? a[16 + j] : a[j], send = h5 ? a[j] : a[16 + j]; b[j] = keep + __shfl_xor(send, 32); }
#pragma unroll
  for (int j = 0; j < 8; ++j) { const float keep = h4 ? b[8 + j] : b[j], send = h4 ? b[j] : b[8 + j]; c[j] = keep + __shfl_xor(send, 16); }
#pragma unroll
  for (int j = 0; j < 4; ++j) { const float keep = h3 ? c[4 + j] : c[j], send = h3 ? c[j] : c[4 + j]; d[j] = keep + __shfl_xor(send, 8); }
#pragma unroll
  for (int j = 0; j < 2; ++j) { const float keep = h2 ? d[2 + j] : d[j], send = h2 ? d[j] : d[2 + j]; e[j] = keep + __shfl_xor(send, 4); }
  const float keep = h1 ? e[1] : e[0], send = h1 ? e[0] : e[1];
  float v = keep + __shfl_xor(send, 2);
  v += __shfl_xor(v, 1);
  return v;
}
__device__ __forceinline__ float tred16(float (&a)[16], int lane) {
  float c[8], d[4], e[2];
  const bool h3 = lane & 8, h2 = lane & 4;
#pragma unroll
  for (int j = 0; j < 8; ++j) c[j] = swap32_sum(a[j], a[8 + j]);
#pragma unroll
  for (int j = 0; j < 4; ++j) d[j] = swap16_sum(c[j], c[4 + j]);
#pragma unroll
  for (int j = 0; j < 2; ++j) { const float keep = h3 ? d[2 + j] : d[j], send = h3 ? d[j] : d[2 + j]; e[j] = keep + dpp_xor8(send); }
  const float keep = h2 ? e[1] : e[0], send = h2 ? e[0] : e[1];
  float v = keep + dpp_xor4(send);
  v += dpp_xor2(v); v += dpp_xor1(v);
  return v;
}
namespace pg8 {
#define PG8_LAS __attribute__((address_space(3)))
typedef unsigned short bf16_t;
typedef short bf16x8 __attribute__((ext_vector_type(8)));
typedef float f32x4 __attribute__((ext_vector_type(4)));
typedef unsigned u32x4 __attribute__((ext_vector_type(4)));
constexpr int BM = 256, BK = 64, HALF = 128, HTB = HALF * BK * 2  , STAGE_BYTES = 8 * HTB, NXCD = 8, WGM = 8;

__host__ __device__ __forceinline__ int lds_byte(int r, int c) { const int st = (r >> 4) * 2 + (c >> 5), rr = r & 15, cc = c & 31, ob = rr * 64 + cc * 2; return st * 1024 + (ob ^ (((ob >> 9) & 1) << 5)); }
__host__ __device__ __forceinline__ void stage_rc(int b, int& R, int& C) { const int st = b / 1024, sb = b % 1024, swz = sb ^ (((sb >> 9) & 1) << 5); R = (st >> 1) * 16 + swz / 64; C = (st & 1) * 32 + (swz % 64) / 2; }
__host__ __device__ __forceinline__ int perm32(int rho) { const int n = rho >> 4, i = rho & 15; return 8 * (i >> 2) + 4 * n + (i & 3); }

struct Unit { int pm, pn; };
struct Gemm { const bf16_t* A; const bf16_t* Bt; int M, N, K; int mpe; size_t bgroup; };

struct StaticOrder {
    int nM, nN, nwg, G, c;
    __host__ __device__ void init(int M, int N, int G_, int c_) { nM = M / BM; nN = N / BM; nwg = nM * nN; G = G_; c = c_; }
    __host__ __device__ bool next(int i, Unit& u) const {
        const long L = (long)i * G + c; if (L >= nwg) return false;
        int wgid = (int)L; { const int q = nwg / NXCD, r = nwg % NXCD, xcd = wgid % NXCD, off = wgid / NXCD; wgid = (xcd < r ? xcd * (q + 1) : r * (q + 1) + (xcd - r) * q) + off; }
        const int nig = WGM * nN, gid = wgid / nig, fm = gid * WGM, gsz = (nM - fm) < WGM ? (nM - fm) : WGM;
        u.pm = fm + ((wgid % nig) % gsz); u.pn = (wgid % nig) / gsz; return true;
    }
    __device__ __forceinline__ void a_ready(const Unit&) const {}
    __device__ __forceinline__ void done(const Unit&) const {}
};


template <class Epi, class Sched, bool ALIGN_EPI = false, bool SP2 = false, bool GATHER = false>
__device__ __forceinline__ void gemm_phase(PG8_LAS unsigned char* lds, const Gemm g, const Sched& S, const Epi& E, const PG8_LAS unsigned* gtab = nullptr) {
    const int tid = threadIdx.x, wid = __builtin_amdgcn_readfirstlane(tid >> 6), lane = tid & 63, wr = wid >> 2, wc = wid & 3, fr = lane & 15, fq = lane >> 4;
    const int K = g.K, nt = K / BK;
    unsigned voffA[2], voffB[2];
#pragma unroll
    for (int i = 0; i < 2; ++i) { int R, C; stage_rc(tid * 16 + i * 8192, R, C); const int Rb = Epi::PERM ? ((R & ~31) + perm32(R & 31)) : R;
        voffA[i] = (unsigned)(R * K + C) * 2u; voffB[i] = (unsigned)(Rb * K + C) * 2u; }
    int gR0; unsigned gC; { int R, C; stage_rc(tid * 16, R, C); gR0 = R; gC = (unsigned)C * 2u; }
    unsigned go[2][2], ngo[2][2];
    const size_t kstep = (size_t)(BK * 2);
    const size_t hstep = (size_t)HALF * K * 2;
    const size_t tstep = 2 * hstep;
    const unsigned ldsw = (unsigned)wid * 1024u;
    const int aoff = lds_byte(wr * 64 + fr, fq * 8), boff = lds_byte(wc * 32 + fr, fq * 8);
#define PG8_SA(b, h) (((b) * 2 + (h)) * HTB)
#define PG8_SB(b, h) ((4 + (b) * 2 + (h)) * HTB)
#define PG8_STAGE(bufoff, gbase, voff) do { _Pragma("unroll") for (int _i = 0; _i < 2; ++_i) \
        __builtin_amdgcn_global_load_lds((const unsigned*)((const char*)(gbase) + (voff)[_i]), (PG8_LAS unsigned*)(lds + (bufoff) + ldsw + _i * 8192), 16, 0, 0); } while (0)
#define PG8_STAGE_A(bufoff, ptr_ng, kb, h, OFFS) do { if constexpr (GATHER) { PG8_STAGE(bufoff, (const char*)g.A + (kb), OFFS[h]); } else { PG8_STAGE(bufoff, (ptr_ng) + (h) * hstep, voffA); } } while (0)
#define PG8_LDA(dst, b, h) do { _Pragma("unroll") for (int m = 0; m < 4; ++m) _Pragma("unroll") for (int k = 0; k < 2; ++k) dst[m][k] = *(const PG8_LAS bf16x8*)(lds + PG8_SA(b, h) + aoff + m * 2048 + k * 1024); } while (0)
#define PG8_LDB(dst, b, h) do { _Pragma("unroll") for (int n = 0; n < 2; ++n) _Pragma("unroll") for (int k = 0; k < 2; ++k) dst[n][k] = *(const PG8_LAS bf16x8*)(lds + PG8_SB(b, h) + boff + n * 2048 + k * 1024); } while (0)
#define PG8_MMA(ai, bj, At, Bt) do { __builtin_amdgcn_s_setprio(1); _Pragma("unroll") for (int m = 0; m < 4; ++m) _Pragma("unroll") for (int n = 0; n < 2; ++n) _Pragma("unroll") for (int k = 0; k < 2; ++k) \
        acc[ai][bj][m][n] = __builtin_amdgcn_mfma_f32_16x16x32_bf16(Bt[n][k], At[m][k], acc[ai][bj][m][n], 0, 0, 0); __builtin_amdgcn_s_setprio(0); } while (0)
#define PG8_WAIT_V(n) asm volatile("s_waitcnt vmcnt(" #n ")" ::: "memory")
#define PG8_WAIT_L(n) asm volatile("s_waitcnt lgkmcnt(" #n ")" ::: "memory")
#define PG8_BAR __builtin_amdgcn_s_barrier()
#define PG8_SCHED __builtin_amdgcn_sched_barrier(0)
    Unit cur, nxt; int ui = 0;
    if (!S.next(0, cur)) return;
    f32x4 acc[2][2][4][2];
#pragma unroll
    for (int a = 0; a < 2; ++a)
#pragma unroll
        for (int b = 0; b < 2; ++b)
#pragma unroll
            for (int m = 0; m < 4; ++m)
#pragma unroll
                for (int n = 0; n < 2; ++n) acc[a][b][m][n] = (f32x4){0.f, 0.f, 0.f, 0.f};
    bf16x8 At[4][2], B0[2][2], B1[2][2];
    const char* cA = (const char*)g.A + (size_t)cur.pm * tstep; const char* cB = (const char*)g.Bt + (g.mpe ? (size_t)(cur.pm / g.mpe) * g.bgroup : (size_t)0) + (size_t)cur.pn * tstep;
    S.a_ready(cur);
    if constexpr (GATHER) {
#pragma unroll
        for (int h = 0; h < 2; ++h)
#pragma unroll
            for (int i = 0; i < 2; ++i) go[h][i] = gtab[h * 128 + gR0 + 64 * i] + gC;
    }
    if constexpr (SP2) {
        PG8_STAGE(PG8_SB(0, 0), cB, voffB); PG8_STAGE(PG8_SB(0, 1), cB + hstep, voffB); PG8_STAGE_A(PG8_SA(0, 0), cA, 0, 0, go); PG8_STAGE_A(PG8_SA(0, 1), cA, 0, 1, go);
        if (wr == 1) PG8_BAR;
        PG8_WAIT_V(2); PG8_BAR;
        PG8_STAGE(PG8_SB(1, 0), cB + kstep, voffB); PG8_STAGE_A(PG8_SA(1, 0), cA + kstep, kstep, 0, go); PG8_STAGE(PG8_SB(1, 1), cB + hstep + kstep, voffB);
        PG8_WAIT_V(6); PG8_BAR;
    } else {
        PG8_STAGE(PG8_SB(0, 0), cB, voffB); PG8_STAGE(PG8_SA(0, 0), cA, voffA); PG8_STAGE(PG8_SB(0, 1), cB + hstep, voffB); PG8_STAGE(PG8_SA(0, 1), cA + hstep, voffA);
        if (wr == 1) PG8_BAR;
        PG8_WAIT_V(4); PG8_BAR;
        PG8_STAGE(PG8_SB(1, 0), cB + kstep, voffB); PG8_STAGE(PG8_SA(1, 0), cA + kstep, voffA); PG8_STAGE(PG8_SB(1, 1), cB + hstep + kstep, voffB);
        PG8_WAIT_V(6); PG8_BAR;
    }
    for (;;) {
        const bool has_next = S.next(ui + 1, nxt);
        if constexpr (GATHER) {
#pragma unroll
            for (int h = 0; h < 2; ++h)
#pragma unroll
                for (int i = 0; i < 2; ++i) ngo[h][i] = has_next ? gtab[(ui + 1) * 256 + h * 128 + gR0 + 64 * i] + gC : go[h][i];
        }
        const char* nA = has_next ? (const char*)g.A + (size_t)nxt.pm * tstep : cA; const char* nB = has_next ? (const char*)g.Bt + (g.mpe ? (size_t)(nxt.pm / g.mpe) * g.bgroup : (size_t)0) + (size_t)nxt.pn * tstep : cB;
        for (int t = 0; t < nt; t += 2) {
            const bool last = (t == nt - 2);
            const char* a1 = cA + (size_t)(t + 1) * kstep;
            const char* a2 = last ? nA : cA + (size_t)(t + 2) * kstep; const char* b2 = last ? nB : cB + (size_t)(t + 2) * kstep;
            const char* a3 = a2 + kstep; const char* b3 = b2 + kstep;
            if (last && has_next) S.a_ready(nxt);
            unsigned s2[2][2]; size_t kb1 = 0, kb2 = 0;
            if constexpr (GATHER) {
#pragma unroll
                for (int h = 0; h < 2; ++h)
#pragma unroll
                    for (int i = 0; i < 2; ++i) s2[h][i] = last ? ngo[h][i] : go[h][i];
                kb1 = (size_t)(t + 1) * kstep; kb2 = last ? (size_t)0 : (size_t)(t + 2) * kstep;
            }
            if constexpr (SP2) {
            PG8_LDB(B0, 0, 0); PG8_LDB(B1, 0, 1); PG8_SCHED; PG8_LDA(At, 0, 0); PG8_STAGE_A(PG8_SA(1, 1), a1, kb1, 1, go);
            PG8_WAIT_V(8); PG8_WAIT_L(0); PG8_BAR; PG8_MMA(0, 0, At, B0); PG8_MMA(0, 1, At, B1); PG8_BAR; PG8_SCHED;
            PG8_LDA(At, 0, 1); PG8_STAGE(PG8_SB(0, 0), b2, voffB); PG8_STAGE(PG8_SB(0, 1), b2 + hstep, voffB); PG8_STAGE_A(PG8_SA(0, 0), a2, kb2, 0, s2);
            PG8_WAIT_V(8); PG8_WAIT_L(0); PG8_BAR; PG8_MMA(1, 0, At, B0); PG8_MMA(1, 1, At, B1); PG8_BAR; PG8_SCHED;
            PG8_LDB(B0, 1, 0); PG8_LDB(B1, 1, 1); PG8_SCHED; PG8_LDA(At, 1, 0); PG8_STAGE_A(PG8_SA(0, 1), a2, kb2, 1, s2);
            PG8_WAIT_V(8); PG8_WAIT_L(0); PG8_BAR; PG8_MMA(0, 0, At, B0); PG8_MMA(0, 1, At, B1); PG8_BAR; PG8_SCHED;
            PG8_LDA(At, 1, 1); PG8_STAGE(PG8_SB(1, 0), b3, voffB); PG8_STAGE(PG8_SB(1, 1), b3 + hstep, voffB); PG8_STAGE_A(PG8_SA(1, 0), a3, kb2 + kstep, 0, s2);
            PG8_WAIT_V(8); PG8_WAIT_L(0); PG8_BAR; PG8_MMA(1, 0, At, B0); PG8_MMA(1, 1, At, B1); PG8_BAR; PG8_SCHED;
            } else {
            PG8_LDB(B0, 0, 0); PG8_SCHED; PG8_LDA(At, 0, 0); PG8_STAGE(PG8_SA(1, 1), a1 + hstep, voffA);
            PG8_WAIT_L(8); PG8_BAR; PG8_WAIT_L(0); PG8_MMA(0, 0, At, B0); PG8_BAR; PG8_SCHED;
            PG8_LDB(B1, 0, 1); PG8_STAGE(PG8_SB(0, 0), b2, voffB);
            PG8_BAR; PG8_WAIT_L(0); PG8_MMA(0, 1, At, B1); PG8_BAR;
            PG8_LDA(At, 0, 1); PG8_STAGE(PG8_SA(0, 0), a2, voffA);
            PG8_BAR; PG8_WAIT_L(0); PG8_MMA(1, 0, At, B0); PG8_BAR; PG8_SCHED;
            PG8_STAGE(PG8_SB(0, 1), b2 + hstep, voffB);
            PG8_WAIT_V(6); PG8_BAR; PG8_MMA(1, 1, At, B1); PG8_BAR;
            PG8_LDB(B0, 1, 0); PG8_SCHED; PG8_LDA(At, 1, 0); PG8_STAGE(PG8_SA(0, 1), a2 + hstep, voffA);
            PG8_WAIT_L(8); PG8_BAR; PG8_WAIT_L(0); PG8_MMA(0, 0, At, B0); PG8_BAR; PG8_SCHED;
            PG8_LDB(B1, 1, 1); PG8_STAGE(PG8_SB(1, 0), b3, voffB);
            PG8_BAR; PG8_WAIT_L(0); PG8_MMA(0, 1, At, B1); PG8_BAR;
            PG8_LDA(At, 1, 1); PG8_STAGE(PG8_SA(1, 0), a3, voffA);
            PG8_BAR; PG8_WAIT_L(0); PG8_MMA(1, 0, At, B0); PG8_BAR; PG8_SCHED;
            PG8_STAGE(PG8_SB(1, 1), b3 + hstep, voffB);
            PG8_WAIT_V(6); PG8_BAR; PG8_MMA(1, 1, At, B1); PG8_BAR;
            }
        }
        if constexpr (ALIGN_EPI) { if (wr == 0) PG8_BAR; }
        if constexpr (!Epi::AFTER_DRAIN) { E(acc, cur, wr, wc, fr, fq); S.done(cur); }
        if (!has_next) break;
#pragma unroll
        for (int a = 0; a < 2; ++a)
#pragma unroll
            for (int b = 0; b < 2; ++b)
#pragma unroll
                for (int m = 0; m < 4; ++m)
#pragma unroll
                    for (int n = 0; n < 2; ++n) acc[a][b][m][n] = (f32x4){0.f, 0.f, 0.f, 0.f};
        cur = nxt; cA = nA; cB = nB; ++ui;
        if constexpr (GATHER) {
#pragma unroll
            for (int h = 0; h < 2; ++h)
#pragma unroll
                for (int i = 0; i < 2; ++i) go[h][i] = ngo[h][i];
        }
        if constexpr (ALIGN_EPI) { if (wr == 1) PG8_BAR; }
    }
    PG8_WAIT_V(0);
    if constexpr (!ALIGN_EPI) { if (wr == 0) PG8_BAR; }
    PG8_BAR;
    if constexpr (Epi::AFTER_DRAIN) { E.fused(acc, cur, wr, wc, fr, fq, lds, wid, lane); S.done(cur); }
#undef PG8_SA
#undef PG8_SB
#undef PG8_STAGE
#undef PG8_STAGE_A
#undef PG8_LDA
#undef PG8_LDB
#undef PG8_MMA
#undef PG8_WAIT_V
#undef PG8_WAIT_L
#undef PG8_BAR
#undef PG8_SCHED
}
}

using pg8::Unit;
struct EpiStoreBf16 {
  static constexpr bool PERM = true, AFTER_DRAIN = false;
  bf16_t* O; int ldc; const float* rowscale;
  __device__ __forceinline__ void operator()(const f32x4 (&acc)[2][2][4][2], const Unit& u, int wr, int wc, int fr, int fq) const {
    const int row0 = u.pm * 256 + wr * 64 + fr, col0 = u.pn * 256 + wc * 32 + 8 * fq;
    float scv[2][4];
#pragma unroll
    for (int ai = 0; ai < 2; ++ai)
#pragma unroll
      for (int m = 0; m < 4; ++m) { const int row = row0 + ai * 128 + m * 16; scv[ai][m] = rowscale ? rowscale[(row >> 11) * SLOTS + (row & 2047)] : 1.f; }
#pragma unroll
    for (int ai = 0; ai < 2; ++ai)
#pragma unroll
      for (int m = 0; m < 4; ++m) {
        const int row = row0 + ai * 128 + m * 16;
        const float sc = scv[ai][m];
#pragma unroll
        for (int bj = 0; bj < 2; ++bj) {
          const f32x4 v0 = acc[ai][bj][m][0] * sc, v1 = acc[ai][bj][m][1] * sc;
          u32x4 w; w.x = pk2(v0.x, v0.y); w.y = pk2(v0.z, v0.w); w.z = pk2(v1.x, v1.y); w.w = pk2(v1.z, v1.w);
          *(u32x4*)(O + (size_t)row * ldc + col0 + bj * 128) = w;
        }
      }
  }
};
struct EpiResid {
  static constexpr bool PERM = true, AFTER_DRAIN = false;
  const float* Hin; float* H; const float* G1;
  __device__ __forceinline__ void operator()(const f32x4 (&acc)[2][2][4][2], const Unit& u, int wr, int wc, int fr, int fq) const {
    const int row0 = u.pm * 256 + wr * 64 + fr, col0 = u.pn * 256 + wc * 32 + 8 * fq;
    const float* g1 = G1 + ((u.pm * 256) >> 13) * 6144;
#pragma unroll
    for (int bj = 0; bj < 2; ++bj) {
      const int col = col0 + bj * 128;
      const f32x4 g0 = *(const f32x4*)(g1 + col), g4 = *(const f32x4*)(g1 + col + 4);
#pragma unroll
      for (int ai = 0; ai < 2; ++ai) {
        f32x4 h0[4], h1[4];
#pragma unroll
        for (int m = 0; m < 4; ++m) { const size_t ho = (size_t)(row0 + ai * 128 + m * 16) * DM + col; if (Hin != H) { h0[m] = __builtin_nontemporal_load((const f32x4*)(Hin + ho)); h1[m] = __builtin_nontemporal_load((const f32x4*)(Hin + ho + 4)); } else { h0[m] = *(const f32x4*)(Hin + ho); h1[m] = *(const f32x4*)(Hin + ho + 4); } }
#pragma unroll
        for (int m = 0; m < 4; ++m) {
          const size_t ho = (size_t)(row0 + ai * 128 + m * 16) * DM + col;
          h0[m] += g0 * acc[ai][bj][m][0]; h1[m] += g4 * acc[ai][bj][m][1];
          *(f32x4*)(H + ho) = h0[m]; *(f32x4*)(H + ho + 4) = h1[m];
        }
      }
    }
  }
};
struct EpiMoe1 {
  static constexpr bool PERM = true, AFTER_DRAIN = false;
  bf16_t* HID;
  __device__ __forceinline__ void operator()(const f32x4 (&acc)[2][2][4][2], const Unit& u, int wr, int wc, int fr, int fq) const {
    const int row0 = u.pm * 256 + wr * 64 + fr, f0 = u.pn * 128 + wc * 32 + 8 * fq;
#pragma unroll
    for (int ai = 0; ai < 2; ++ai)
#pragma unroll
      for (int m = 0; m < 4; ++m) {
        const f32x4 g0 = acc[ai][0][m][0], g1 = acc[ai][0][m][1], u0 = acc[ai][1][m][0], u1 = acc[ai][1][m][1];
        u32x4 o; o.x = pk2(silu_f(g0.x) * u0.x, silu_f(g0.y) * u0.y); o.y = pk2(silu_f(g0.z) * u0.z, silu_f(g0.w) * u0.w);
        o.z = pk2(silu_f(g1.x) * u1.x, silu_f(g1.y) * u1.y); o.w = pk2(silu_f(g1.z) * u1.z, silu_f(g1.w) * u1.w);
        *(u32x4*)(HID + (size_t)(row0 + ai * 128 + m * 16) * DM + f0) = o;
      }
  }
};
template <class Epi>
__device__ __forceinline__ void big_gemm(char* lds, const bf16_t* A, const bf16_t* Bt, int M, int N, int mpe, size_t bgroup, const Epi& E) {
  pg8::Gemm g{A, Bt, M, N, DM, mpe, bgroup};
  pg8::StaticOrder S; S.init(M, N, (int)gridDim.x, (int)blockIdx.x);
  pg8::gemm_phase<Epi, pg8::StaticOrder, true, true>((PG8_LAS unsigned char*)lds, g, S, E);
}

template <class Epi>
__device__ __forceinline__ void big_gemm_gather(char* lds, const bf16_t* A, const int* IDX, const bf16_t* Bt, int M, int N, int mpe, size_t bgroup, const Epi& E) {
  pg8::Gemm g{A, Bt, M, N, DM, mpe, bgroup};
  pg8::StaticOrder S; S.init(M, N, (int)gridDim.x, (int)blockIdx.x);
  unsigned* gtab = (unsigned*)(lds + pg8::STAGE_BYTES);
  for (int i = ltid(); i < 1024; i += NT) {
    pg8::Unit u;
    if (S.next(i >> 8, u)) { const int r = u.pm * 256 + (i & 255); gtab[i] = (unsigned)IDX[(r >> 11) * SLOTS + (r & 2047)] * (unsigned)(DM * 2); }
  }
  __syncthreads();
  pg8::gemm_phase<Epi, pg8::StaticOrder, true, true, true>((PG8_LAS unsigned char*)lds, g, S, E, (const PG8_LAS unsigned*)(lds + pg8::STAGE_BYTES));
}

template <class Op>
__device__ __forceinline__ void gemm_tile_h(const Op& op, int tile, char* lds_all) {
  const int half = ltid() >> 8;
  char* lds = lds_all + half * 65536;
  const int tid = ltid() & 255, lane = tid & 63, wid = tid >> 6, wr = wid >> 1, wc = wid & 1, fr = lane & 15, fq = lane >> 4;
  const int lrow = tid >> 3, lc = tid & 7;
  const bf16_t* ap[4]; const bf16_t* bp[4];
#pragma unroll
  for (int i = 0; i < 4; ++i) { ap[i] = op.arow(tile, lrow + 32 * i) + lc * 8 + half * 512; bp[i] = op.brow(tile, lrow + 32 * i) + lc * 8 + half * 512; }
  const int woff = lrow * 128 + ((lc ^ ((lrow >> 1) & 7)) << 4);
  char* As = lds; char* Bs = lds + 32768;
  f32x4 acc[4][4];
#pragma unroll
  for (int m = 0; m < 4; ++m)
#pragma unroll
    for (int n = 0; n < 4; ++n) acc[m][n] = (f32x4){0.f, 0.f, 0.f, 0.f};
  u32x4 ra0[4], rb0[4], ra1[4], rb1[4], ra2[4], rb2[4];
#define GT_LOAD(R, KT) do { _Pragma("unroll") for (int i = 0; i < 4; ++i) { ra##R[i] = *(const u32x4*)(ap[i] + (KT) * 64); rb##R[i] = *(const u32x4*)(bp[i] + (KT) * 64); } } while (0)
#define GT_STORE(R, BUF) do { const int nb_ = (BUF) * 16384; _Pragma("unroll") for (int i = 0; i < 4; ++i) { *(u32x4*)(As + nb_ + woff + i * 4096) = ra##R[i]; *(u32x4*)(Bs + nb_ + woff + i * 4096) = rb##R[i]; } } while (0)
#define GT_COMPUTE(BUF) do { const char* A_ = As + (BUF) * 16384; const char* B_ = Bs + (BUF) * 16384; \
    _Pragma("unroll") for (int ks = 0; ks < 2; ++ks) { bf16x8 af[4], bfr[4]; const int co = ((ks * 4 + fq) ^ sw) << 4; \
      _Pragma("unroll") for (int m = 0; m < 4; ++m) af[m] = *(const bf16x8*)(A_ + arow0 + m * 2048 + co); \
      _Pragma("unroll") for (int n = 0; n < 4; ++n) bfr[n] = *(const bf16x8*)(B_ + brow0 + n * 2048 + co); \
      _Pragma("unroll") for (int m = 0; m < 4; ++m) _Pragma("unroll") for (int n = 0; n < 4; ++n) acc[m][n] = __builtin_amdgcn_mfma_f32_16x16x32_bf16(bfr[n], af[m], acc[m][n], 0, 0, 0); } } while (0)
  const int sw = (fr >> 1) & 7;
  const int arow0 = (wr * 64 + fr) * 128, brow0 = (wc * 64 + fr) * 128;
  GT_LOAD(0, 0); GT_LOAD(1, 1); GT_LOAD(2, 2);
  __syncthreads();
  GT_STORE(0, 0);
  GT_LOAD(0, 3);
  __syncthreads();
  GT_COMPUTE(0); GT_STORE(1, 1); GT_LOAD(1, 4); __syncthreads();
  GT_COMPUTE(1); GT_STORE(2, 0); GT_LOAD(2, 5); __syncthreads();
  GT_COMPUTE(0); GT_STORE(0, 1); GT_LOAD(0, 6); __syncthreads();
  GT_COMPUTE(1); GT_STORE(1, 0); GT_LOAD(1, 7); __syncthreads();
  GT_COMPUTE(0); GT_STORE(2, 1); __syncthreads();
  GT_COMPUTE(1); GT_STORE(0, 0); __syncthreads();
  GT_COMPUTE(0); GT_STORE(1, 1); __syncthreads();
  GT_COMPUTE(1); __syncthreads();
#undef GT_LOAD
#undef GT_STORE
#undef GT_COMPUTE
  f32x4* red = (f32x4*)(lds_all + 65536) + tid;
  if (half == 1) {
#pragma unroll
    for (int m = 0; m < 4; ++m)
#pragma unroll
      for (int n = 0; n < 4; ++n) red[(m * 4 + n) * 256] = acc[m][n];
  }
  __syncthreads();
  if (half == 0) {
#pragma unroll
    for (int m = 0; m < 4; ++m)
#pragma unroll
      for (int n = 0; n < 4; ++n) acc[m][n] += red[(m * 4 + n) * 256];
    op.epilogue(tile, acc, wr, wc, fr, fq);
  }
}
template <class Op>
__device__ __forceinline__ void gemm_small_phase(const Op& op, char* lds) {
  for (int t = (int)gridDim.x - 1 - (int)blockIdx.x; t < op.ntiles; t += gridDim.x) gemm_tile_h(op, t, lds);
}
template <int LAYER>
struct OpInProjCtx {
  const bf16_t* A; const bf16_t* W; bf16_t* PROJ; int ntiles;
  static constexpr int NTN = (LAYER == 0) ? 23 : 16, NOFF = (LAYER == 0) ? 0 : 8;
  __device__ __forceinline__ const bf16_t* arow(int t, int i) const { return A + (size_t)(MLAT + (t / NTN) * 128 + i) * DM; }
  __device__ __forceinline__ const bf16_t* brow(int t, int i) const { return W + (size_t)((t % NTN + NOFF) * 128 + i) * DM; }
  __device__ __forceinline__ void epilogue(int t, const f32x4 (&acc)[4][4], int wr, int wc, int fr, int fq) const {
    const int row0 = MLAT + (t / NTN) * 128 + wr * 64 + fr, col0 = (t % NTN + NOFF) * 128 + wc * 64 + fq * 4;
#pragma unroll
    for (int m = 0; m < 4; ++m)
#pragma unroll
      for (int n = 0; n < 4; ++n) { const f32x4 v = acc[m][n]; u32x2 o; o.x = pk2(v.x, v.y); o.y = pk2(v.z, v.w); *(u32x2*)(PROJ + (size_t)(row0 + m * 16) * PROJ_LD + col0 + n * 16) = o; }
  }
};
struct OpOutProjCtx {
  const bf16_t* MIX; const bf16_t* W; const float* G1; float* hc; int ntiles;
  __device__ __forceinline__ const bf16_t* arow(int t, int i) const { return MIX + (size_t)(MLAT + (t >> 3) * 128 + i) * DM; }
  __device__ __forceinline__ const bf16_t* brow(int t, int i) const { return W + (size_t)((t & 7) * 128 + i) * DM; }
  __device__ __forceinline__ void epilogue(int t, const f32x4 (&acc)[4][4], int wr, int wc, int fr, int fq) const {
    const int row0 = (t >> 3) * 128 + wr * 64 + fr, col0 = (t & 7) * 128 + wc * 64 + fq * 4;
    f32x4 hh[4][4];
#pragma unroll
    for (int m = 0; m < 4; ++m)
#pragma unroll
      for (int n = 0; n < 4; ++n) hh[m][n] = *(const f32x4*)(hc + (size_t)(row0 + m * 16) * DM + col0 + n * 16);
#pragma unroll
    for (int m = 0; m < 4; ++m)
#pragma unroll
      for (int n = 0; n < 4; ++n) { const int col = col0 + n * 16; const f32x4 g = *(const f32x4*)(G1 + col); *(f32x4*)(hc + (size_t)(row0 + m * 16) * DM + col) = hh[m][n] + g * acc[m][n]; }
  }
};
__device__ __forceinline__ int gu_row(int f, int which) { return 256 * (f >> 7) + 128 * which + (f & 127); }
struct OpMoe1Ctx {
  const bf16_t* A; const bf16_t* WEXP; const int* IDX; bf16_t* HIDC; int ntiles;
  __device__ __forceinline__ const bf16_t* arow(int t, int i) const { const int e = t >> 4; const int row = (i < 64) ? IDX[e * SLOTS + 2048 + i] : MLAT; return A + (size_t)row * DM; }
  __device__ __forceinline__ const bf16_t* brow(int t, int i) const {
    const int e = t >> 4, nt = t & 15, wc = i >> 6, n = (i >> 4) & 3, fr = i & 15;
    const int f = nt * 64 + wc * 32 + (n & 1) * 16 + fr;
    return WEXP + (size_t)e * EXPW + (size_t)gu_row(f, n >> 1) * DM;
  }
  __device__ __forceinline__ void epilogue(int t, const f32x4 (&acc)[4][4], int wr, int wc, int fr, int fq) const {
    const int e = t >> 4, nt = t & 15;
    if (wr == 0) {
#pragma unroll
      for (int m = 0; m < 4; ++m) {
        const int slot = m * 16 + fr;
#pragma unroll
        for (int nn = 0; nn < 2; ++nn) {
          const f32x4 g = acc[m][nn], u = acc[m][nn + 2]; const int f = nt * 64 + wc * 32 + nn * 16 + fq * 4;
          u32x2 o; o.x = pk2(silu_f(g.x) * u.x, silu_f(g.y) * u.y); o.y = pk2(silu_f(g.z) * u.z, silu_f(g.w) * u.w);
          *(u32x2*)(HIDC + (size_t)(e * 64 + slot) * DM + f) = o;
        }
      }
    }
  }
};
struct OpMoe2Ctx {
  const bf16_t* HIDC; const bf16_t* WEXP; const float* GATEV; bf16_t* YC; int ntiles;
  __device__ __forceinline__ const bf16_t* arow(int t, int i) const { const int e = t >> 3; return HIDC + (size_t)(e * 64 + (i & 63)) * DM; }
  __device__ __forceinline__ const bf16_t* brow(int t, int i) const { const int e = t >> 3, nt = t & 7; return WEXP + (size_t)e * EXPW + (size_t)(2048 + nt * 128 + i) * DM; }
  __device__ __forceinline__ void epilogue(int t, const f32x4 (&acc)[4][4], int wr, int wc, int fr, int fq) const {
    const int e = t >> 3, nt = t & 7;
    if (wr == 0) {
      float gvv[4];
#pragma unroll
      for (int m = 0; m < 4; ++m) gvv[m] = GATEV[e * SLOTS + 2048 + m * 16 + fr];
#pragma unroll
      for (int m = 0; m < 4; ++m) {
        const int slot = m * 16 + fr; const float gv = gvv[m];
#pragma unroll
        for (int n = 0; n < 4; ++n) { const f32x4 v = acc[m][n] * gv; u32x2 o; o.x = pk2(v.x, v.y); o.y = pk2(v.z, v.w); *(u32x2*)(YC + (size_t)(e * 64 + slot) * DM + nt * 128 + wc * 64 + n * 16 + fq * 4) = o; }
      }
    }
  }
};

__device__ __forceinline__ void transpose_item(const float* W, int N, int k0, int n0, bf16_t* dst, int drow0, float* scr, int lane) {
  f32x4 tv[8];
#pragma unroll
  for (int i = 0; i < 8; ++i) { const int kk = 8 * i + (lane >> 3); tv[i] = __builtin_nontemporal_load((const f32x4*)(W + (size_t)(k0 + kk) * N + n0 + 4 * (lane & 7))); }
#pragma unroll
  for (int i = 0; i < 8; ++i) { const int kk = 8 * i + (lane >> 3); float* d = scr + kk * 33 + 4 * (lane & 7); d[0] = tv[i].x; d[1] = tv[i].y; d[2] = tv[i].z; d[3] = tv[i].w; }
  __builtin_amdgcn_s_waitcnt(0); __builtin_amdgcn_wave_barrier();
  const int c = lane & 7;
#pragma unroll
  for (int j = 0; j < 4; ++j) {
    const int n = (lane >> 3) + 8 * j; const float* s = scr + (8 * c) * 33 + n;
    u32x4 o; o.x = pk2(s[0], s[33]); o.y = pk2(s[66], s[99]); o.z = pk2(s[132], s[165]); o.w = pk2(s[198], s[231]);
    *(u32x4*)(dst + (size_t)(drow0 + n) * 1024 + k0 + 8 * c) = o;
  }
  __builtin_amdgcn_s_waitcnt(0); __builtin_amdgcn_wave_barrier();
}
__device__ __forceinline__ int even_col_map(int c) {
  if (c < 2048) return c;
  if (c < 2080) return 2816 + (c - 2048);
  if (c < 2592) return 2048 + (c - 2080);
  if (c < 2720) return 2560 + (c - 2592);
  return 2688 + (c - 2720);
}
__device__ __forceinline__ void convert_experts(const Params& p, int layer, char* lds, bf16_t* dstb, int it0, int it1, int gw, int ngw) {
  const int lane = ltid() & 63, wave = ltid() >> 6;
  float* scr = (float*)lds + wave * (64 * 33);
  constexpr int SPM = 16 * 8;
  for (int it = it0 + gw; it < it1; it += ngw) {
    const int mat = it / SPM, r = it % SPM, e = mat / 3, which = mat % 3;
    const float* src = (which == 0 ? p.w_gate : which == 1 ? p.w_up : p.w_down) + ((size_t)layer * 16 + e) * 1024 * 1024;
    const int k0 = (r >> 3) * 64, ns = (r & 7) * 128;
    bf16_t* dst = dstb + (size_t)e * EXPW;
    f32x4 tv[4][8];
#pragma unroll
    for (int sb = 0; sb < 4; ++sb)
#pragma unroll
      for (int i = 0; i < 8; ++i) { const int kk = 8 * i + (lane >> 3); tv[sb][i] = __builtin_nontemporal_load((const f32x4*)(src + (size_t)(k0 + kk) * 1024 + ns + sb * 32 + 4 * (lane & 7))); }
#pragma unroll
    for (int sb = 0; sb < 4; ++sb) {
      const int n0 = ns + sb * 32;
      const int drow = (which == 2) ? 2048 + n0 : gu_row(n0, which);
#pragma unroll
      for (int i = 0; i < 8; ++i) { const int kk = 8 * i + (lane >> 3); float* d = scr + kk * 33 + 4 * (lane & 7); d[0] = tv[sb][i].x; d[1] = tv[sb][i].y; d[2] = tv[sb][i].z; d[3] = tv[sb][i].w; }
      __builtin_amdgcn_s_waitcnt(0xc07f); __builtin_amdgcn_wave_barrier();
      const int c = lane & 7;
#pragma unroll
      for (int j = 0; j < 4; ++j) {
        const int n = (lane >> 3) + 8 * j; const float* sp = scr + (8 * c) * 33 + n;
        u32x4 o; o.x = pk2(sp[0], sp[33]); o.y = pk2(sp[66], sp[99]); o.z = pk2(sp[132], sp[165]); o.w = pk2(sp[198], sp[231]);
        *(u32x4*)(dst + (size_t)(drow + n) * 1024 + k0 + 8 * c) = o;
      }
      __builtin_amdgcn_s_waitcnt(0xc07f); __builtin_amdgcn_wave_barrier();
    }
  }
}
__device__ __forceinline__ void phase0(const Params& p, char* lds) {
  const int tid = ltid(), lane = tid & 63, wave = tid >> 6;
  const int gw = blockIdx.x * NWV + wave, ngw = gridDim.x * NWV;
  const int gt = blockIdx.x * NT + tid, ngt = gridDim.x * NT;
  if (blockIdx.x == 0 && tid < 64) ((unsigned*)(p.ws + WS_CTL))[tid] = 0u;
  {
    float* rc = (float*)(p.ws + WS_ROPE); float* rs = rc + 8192 * 32;
    for (int i = gt; i < 8192 * 32; i += ngt) {
      const int t = i >> 5, f = i & 31;
      const float pos = (f < 16) ? (float)(t >> 6) : (float)(t & 63);
      const float inv = powf(10000.f, -(float)(f & 15) * (1.f / 16.f));
      float sn, cs; sincos_d(pos * inv, sn, cs);
      rc[i] = cs; rs[i] = sn;
    }
  }
  if (blockIdx.x < 192) {
    float* sv = (float*)lds;
    float* red = sv + 3072;
    for (int i = tid; i < 3072; i += NT) { const int v = i >> 10, k = i & 1023; const float cv = (v < 2) ? p.c[v * 1024 + k] : p.c_ctx[k]; sv[i] = silu_f(cv); }
    __syncthreads();
    for (int task = blockIdx.x; task < 192; task += gridDim.x) {
      const int l = task / 96, col = (task % 96) * 64 + lane;
      const int kq = lane >> 4, c4 = 4 * (lane & 15), kb = wave * 128;
      const float* W = p.ada_w + (size_t)l * 1024 * 6144 + (task % 96) * 64 + c4 + (size_t)(kb + kq) * 6144;
      f32x4 wv[32];
#pragma unroll
      for (int j = 0; j < 32; ++j) wv[j] = __builtin_nontemporal_load((const f32x4*)(W + (size_t)(4 * j) * 6144));
      f32x4 b0 = (f32x4){0.f, 0.f, 0.f, 0.f}, b1 = b0, b2 = b0;
#pragma unroll
      for (int j = 0; j < 32; ++j) { const int k = kb + 4 * j + kq; b0 += wv[j] * sv[k]; b1 += wv[j] * sv[1024 + k]; b2 += wv[j] * sv[2048 + k]; }
#pragma unroll
      for (int i = 0; i < 4; ++i) { b0[i] = swap32_sum(swap16_sum(b0[i], b0[i]), swap16_sum(b0[i], b0[i])); b1[i] = swap32_sum(swap16_sum(b1[i], b1[i]), swap16_sum(b1[i], b1[i])); b2[i] = swap32_sum(swap16_sum(b2[i], b2[i]), swap16_sum(b2[i], b2[i])); }
      if (kq == 0) { *(f32x4*)(red + (wave * 3 + 0) * 64 + c4) = b0; *(f32x4*)(red + (wave * 3 + 1) * 64 + c4) = b1; *(f32x4*)(red + (wave * 3 + 2) * 64 + c4) = b2; }
      __syncthreads();
      if (wave < 3) {
        float s = 0.f;
#pragma unroll
        for (int w8 = 0; w8 < 8; ++w8) s += red[(w8 * 3 + wave) * 64 + lane];
        ((float*)(p.ws + WS_MOD))[(l * 3 + wave) * 6144 + col] = s + p.ada_b[l * 6144 + col];
      }
      __syncthreads();
    }
  }
  __syncthreads();
  {
    float* scr = (float*)lds + wave * (64 * 33);
    constexpr int N0 = 16 * 89, N1 = N0 + 16 * 32, N2 = N1 + 16 * 96, N3 = N2 + 16 * 32;
    for (int j = ngw - 1 - gw; j < N3; j += ngw) {
      if (j < N0) { const int it = j, kb = it / 89, nb = it % 89; transpose_item(p.even_w_in, 2848, kb * 64, nb * 32, (bf16_t*)(p.ws + WS_WEI), even_col_map(nb * 32), scr, lane); }
      else if (j < N1) { const int it = j - N0; transpose_item(p.even_w_out, 1024, (it / 32) * 64, (it % 32) * 32, (bf16_t*)(p.ws + WS_WEO), (it % 32) * 32, scr, lane); }
      else if (j < N2) { const int it = j - N1; transpose_item(p.odd_w_in, 3072, (it / 96) * 64, (it % 96) * 32, (bf16_t*)(p.ws + WS_WOI), (it % 96) * 32, scr, lane); }
      else { const int it = j - N2; transpose_item(p.odd_w_out, 1024, (it / 32) * 64, (it % 32) * 32, (bf16_t*)(p.ws + WS_WOO), (it % 32) * 32, scr, lane); }
    }
    for (int i = gt; i < 224 * 1024 / 8; i += ngt) ((u32x4*)((bf16_t*)(p.ws + WS_WEI) + (size_t)2848 * 1024))[i] = (u32x4){0u, 0u, 0u, 0u};
  }
}

template <int LAYER, bool FINAL>
__device__ __forceinline__ void rowpass_a(const Params& p, char* lds) {
  const int tid = ltid(), lane = tid & 63, wave = tid >> 6;
  const int gw = blockIdx.x * NWV + wave, ngw = gridDim.x * NWV;
  const float* MOD = (const float*)(p.ws + WS_MOD);
  const int* INV = (const int*)(p.ws + WS_INV);
  const bf16_t* YL = (const bf16_t*)(p.ws + WS_YL);
  const bf16_t* YC = (const bf16_t*)(p.ws + WS_YC);
  bf16_t* A = (bf16_t*)(p.ws + WS_A);
  float* GATES = (float*)(p.ws + WS_GATES);
  float* wg = (float*)lds;
  const int nrows = FINAL ? MLAT : NR;
  auto srcrow = [&](int r) -> const float* {
    if (LAYER == 0 && !FINAL) return (r < MLAT) ? p.x + (size_t)r * DM : p.ctx + (size_t)(r - MLAT) * DM;
    return hrow_ptr(p, r);
  };
  int vcur = -1, vcur2 = -1; f32x4 mg[4], ms[4], mg2[4], fg[4];
#pragma unroll
  for (int j = 0; j < 4; ++j) { mg[j] = (f32x4){0.f, 0.f, 0.f, 0.f}; ms[j] = mg[j]; mg2[j] = mg[j]; fg[j] = FINAL ? ((const f32x4*)p.final_g)[lane + 64 * j] : mg[j]; }
  constexpr bool COMB = !(LAYER == 0 && !FINAL);
  constexpr int PL = FINAL ? 1 : (LAYER > 0 ? LAYER - 1 : 0);
  f32x4 nx[4]; int cinv = -1, ainv = -1; u32x2 ny[4][4]; float nw[4] = {0.f, 0.f, 0.f, 0.f}; unsigned nrest = 0u;
#pragma unroll
  for (int k = 0; k < 4; ++k)
#pragma unroll
    for (int j = 0; j < 4; ++j) ny[k][j] = (u32x2){0u, 0u};
  auto yptr = [&](int e, int sl) -> const bf16_t* { return (sl < 2048) ? YL + ((size_t)e * 2048 + sl) * DM : YC + ((size_t)e * 64 + (sl - 2048)) * DM; };
#define RPA_ISSUE_Y(INVREG) do { unsigned m_ = (unsigned)__ballot((INVREG) >= 0) & 0xFFFFu; const bf16_t* yp_[4]; \
    _Pragma("unroll") for (int k = 0; k < 4; ++k) { \
      if (m_) { const int e_ = __ffs(m_) - 1; m_ &= m_ - 1u; yp_[k] = yptr(e_, __builtin_amdgcn_readlane((INVREG), e_)); nw[k] = 1.f; } \
      else { yp_[k] = k ? yp_[0] : YL; nw[k] = 0.f; } } \
    nrest = m_; \
    _Pragma("unroll") for (int k = 0; k < 4; ++k) _Pragma("unroll") for (int j = 0; j < 4; ++j) ny[k][j] = *(const u32x2*)(yp_[k] + 4 * (lane + 64 * j)); } while (0)
  if (gw < nrows) {
    const float* s0 = srcrow(gw);
#pragma unroll
    for (int j = 0; j < 4; ++j) nx[j] = ((LAYER == 0 && !FINAL) || FINAL) ? __builtin_nontemporal_load((const f32x4*)s0 + lane + 64 * j) : ((const f32x4*)s0)[lane + 64 * j];
    if (COMB) {
      cinv = INV[gw * 16 + (lane & 15)];
      const int r1 = (gw + ngw < nrows) ? gw + ngw : gw;
      ainv = INV[r1 * 16 + (lane & 15)];
      RPA_ISSUE_Y(cinv);
    }
  }
  for (int r = gw; r < nrows; r += ngw) {
    const int v = row_sel(r);
    float* hp = hrow_ptr(p, r);
    f32x4 hv[4]; u32x2 cy[4][4]; float cw[4]; const unsigned crest = nrest; const int myinv = cinv;
#pragma unroll
    for (int j = 0; j < 4; ++j) hv[j] = nx[j];
    if (COMB) {
#pragma unroll
      for (int k = 0; k < 4; ++k) { cw[k] = nw[k];
#pragma unroll
        for (int j = 0; j < 4; ++j) cy[k][j] = ny[k][j]; }
    }
    {
      const int rn = (r + ngw < nrows) ? r + ngw : r;
      const float* s1 = srcrow(rn);
#pragma unroll
      for (int j = 0; j < 4; ++j) nx[j] = ((LAYER == 0 && !FINAL) || FINAL) ? __builtin_nontemporal_load((const f32x4*)s1 + lane + 64 * j) : ((const f32x4*)s1)[lane + 64 * j];
      if (COMB) {
        const int rn2 = (rn + ngw < nrows) ? rn + ngw : rn;
        cinv = ainv;
        RPA_ISSUE_Y(cinv);
        ainv = INV[rn2 * 16 + (lane & 15)];
      }
    }
    if (!COMB) {
      if (r >= MLAT) {
#pragma unroll
        for (int j = 0; j < 4; ++j) ((f32x4*)hp)[lane + 64 * j] = hv[j];
      }
    } else {
      f32x4 acc[4];
#pragma unroll
      for (int j = 0; j < 4; ++j) acc[j] = (f32x4){0.f, 0.f, 0.f, 0.f};
#pragma unroll
      for (int k = 0; k < 4; ++k)
#pragma unroll
        for (int j = 0; j < 4; ++j) { const u32x2 w = cy[k][j]; acc[j].x += cw[k] * bflo(w.x); acc[j].y += cw[k] * bfhi(w.x); acc[j].z += cw[k] * bflo(w.y); acc[j].w += cw[k] * bfhi(w.y); }
      for (unsigned m = crest; m; m &= m - 1u) {
        const int e = __ffs(m) - 1;
        const bf16_t* yr = yptr(e, __builtin_amdgcn_readlane(myinv, e));
#pragma unroll
        for (int j = 0; j < 4; ++j) { const u32x2 w = *(const u32x2*)(yr + 4 * (lane + 64 * j)); acc[j].x += bflo(w.x); acc[j].y += bfhi(w.x); acc[j].z += bflo(w.y); acc[j].w += bfhi(w.y); }
      }
      if (v != vcur2) {
        vcur2 = v;
        const float* g2 = MOD + (PL * 3 + v) * 6144 + 5 * 1024;
#pragma unroll
        for (int j = 0; j < 4; ++j) mg2[j] = ((const f32x4*)g2)[lane + 64 * j];
      }
#pragma unroll
      for (int j = 0; j < 4; ++j) hv[j] += mg2[j] * acc[j];
      if (!FINAL) {
#pragma unroll
        for (int j = 0; j < 4; ++j) ((f32x4*)hp)[lane + 64 * j] = hv[j];
      }
    }
#undef RPA_ISSUE_Y
    float ss = 0.f;
#pragma unroll
    for (int j = 0; j < 4; ++j) ss += hv[j].x * hv[j].x + hv[j].y * hv[j].y + hv[j].z * hv[j].z + hv[j].w * hv[j].w;
    ss = wave_sum(ss);
    const float rs = rsqrtf(ss * (1.f / DM) + EPS);
    if (FINAL) {
#pragma unroll
      for (int j = 0; j < 4; ++j) __builtin_nontemporal_store(hv[j] * rs * fg[j], (f32x4*)hp + lane + 64 * j);
    } else {
      if (v != vcur) {
        vcur = v;
        const float* lg = p.ln1_g + LAYER * DM;
        const float* sh = MOD + (LAYER * 3 + v) * 6144;
        const float* sc = sh + 1024;
#pragma unroll
        for (int j = 0; j < 4; ++j) { mg[j] = ((const f32x4*)lg)[lane + 64 * j] * (1.f + ((const f32x4*)sc)[lane + 64 * j]); ms[j] = ((const f32x4*)sh)[lane + 64 * j]; }
      }
#pragma unroll
      for (int j = 0; j < 4; ++j) {
        hv[j] = (hv[j] * rs) * mg[j] + ms[j];
        u32x2 o; o.x = pk2(hv[j].x, hv[j].y); o.y = pk2(hv[j].z, hv[j].w);
        *(u32x2*)(A + (size_t)r * DM + 4 * (lane + 64 * j)) = o;
      }
    }
  }
}

template <int LAYER>
__device__ __forceinline__ void rowpass_b(const Params& p, char* lds) {
  const int tid = ltid(), lane = tid & 63, wave = tid >> 6;
  float* wt = (float*)lds;
  float* xt = (float*)(lds + 65536);
  float* red = (float*)(lds + 65536 + 16 * 1028 * 4);
  const float* rw = p.router_w + (size_t)LAYER * 1024 * 16;
  {
    f32x4 rv[8];
#pragma unroll
    for (int u = 0; u < 8; ++u) rv[u] = *(const f32x4*)(rw + 4 * (tid + u * NT));
#pragma unroll
    for (int u = 0; u < 8; ++u) *(f32x4*)(wt + 4 * (tid + u * NT)) = rv[u];
  }
  const float* MOD = (const float*)(p.ws + WS_MOD);
  float* AFF = (float*)(p.ws + WS_AFF);
  int* INV = (int*)(p.ws + WS_INV);
  bf16_t* A = (bf16_t*)(p.ws + WS_A);
  const int nblk = ((LAYER == 0) ? NR : MLAT) / 16;
  f32x4 nxa[4], nxb[4];
  int blk = blockIdx.x;
  if (blk < nblk) {
    const float* s0 = hrow_ptr(p, blk * 16 + 2 * wave); const float* s1 = hrow_ptr(p, blk * 16 + 2 * wave + 1);
#pragma unroll
    for (int j = 0; j < 4; ++j) { nxa[j] = ((const f32x4*)s0)[lane + 64 * j]; nxb[j] = ((const f32x4*)s1)[lane + 64 * j]; }
  }
  int vcur = -1; f32x4 mg[4], ms[4];
#pragma unroll
  for (int j = 0; j < 4; ++j) { mg[j] = (f32x4){0.f, 0.f, 0.f, 0.f}; ms[j] = mg[j]; }
  __syncthreads();
  for (; blk < nblk; blk += gridDim.x) {
    const int rbase = blk * 16, ra = rbase + 2 * wave;
    f32x4 ha[4], hb[4];
#pragma unroll
    for (int j = 0; j < 4; ++j) { ha[j] = nxa[j]; hb[j] = nxb[j]; }
    {
      const int nb = (blk + (int)gridDim.x < nblk) ? blk + (int)gridDim.x : blk;
      const float* s0 = hrow_ptr(p, nb * 16 + 2 * wave); const float* s1 = hrow_ptr(p, nb * 16 + 2 * wave + 1);
#pragma unroll
      for (int j = 0; j < 4; ++j) { nxa[j] = ((const f32x4*)s0)[lane + 64 * j]; nxb[j] = ((const f32x4*)s1)[lane + 64 * j]; }
    }
    const int v = row_sel(rbase);
    if (v != vcur) {
      vcur = v;
      const float* lg = p.ln2_g + LAYER * DM;
      const float* sh = MOD + (LAYER * 3 + v) * 6144 + 3 * 1024;
      const float* sc = sh + 1024;
#pragma unroll
      for (int j = 0; j < 4; ++j) { mg[j] = ((const f32x4*)lg)[lane + 64 * j] * (1.f + ((const f32x4*)sc)[lane + 64 * j]); ms[j] = ((const f32x4*)sh)[lane + 64 * j]; }
    }
    {
      float ssa = 0.f, ssb = 0.f;
#pragma unroll
      for (int j = 0; j < 4; ++j) { ssa += ha[j].x * ha[j].x + ha[j].y * ha[j].y + ha[j].z * ha[j].z + ha[j].w * ha[j].w; ssb += hb[j].x * hb[j].x + hb[j].y * hb[j].y + hb[j].z * hb[j].z + hb[j].w * hb[j].w; }
      ssa = wave_sum(ssa); ssb = wave_sum(ssb);
      const float rsa = rsqrtf(ssa * (1.f / DM) + EPS), rsb = rsqrtf(ssb * (1.f / DM) + EPS);
#pragma unroll
      for (int j = 0; j < 4; ++j) {
        ha[j] = (ha[j] * rsa) * mg[j] + ms[j]; hb[j] = (hb[j] * rsb) * mg[j] + ms[j];
        u32x2 o; o.x = pk2(ha[j].x, ha[j].y); o.y = pk2(ha[j].z, ha[j].w);
        *(u32x2*)(A + (size_t)ra * DM + 4 * (lane + 64 * j)) = o;
        u32x2 o2; o2.x = pk2(hb[j].x, hb[j].y); o2.y = pk2(hb[j].z, hb[j].w);
        *(u32x2*)(A + (size_t)(ra + 1) * DM + 4 * (lane + 64 * j)) = o2;
        *(f32x4*)(xt + (2 * wave) * 1028 + 4 * (lane + 64 * j)) = ha[j];
        *(f32x4*)(xt + (2 * wave + 1) * 1028 + 4 * (lane + 64 * j)) = hb[j];
      }
    }
    __syncthreads();
    {
      const int m = lane & 15, g = lane >> 4;
      const float* xa = xt + m * 1028 + 128 * wave + g;
      const float* wb = wt + (128 * wave + g) * 16 + m;
      f32x4 acc = (f32x4){0.f, 0.f, 0.f, 0.f};
#pragma unroll 8
      for (int kk = 0; kk < 32; ++kk) acc = __builtin_amdgcn_mfma_f32_16x16x4f32(xa[4 * kk], wb[64 * kk], acc, 0, 0, 0);
      float* rd = red + wave * 256 + (4 * g) * 16 + m;
      rd[0] = acc.x; rd[16] = acc.y; rd[32] = acc.z; rd[48] = acc.w;
    }
    __syncthreads();
    if (tid < 256) {
      float lg = 0.f;
#pragma unroll
      for (int w8 = 0; w8 < 8; ++w8) lg += red[w8 * 256 + tid];
      float mx = lg;
      mx = fmaxf(mx, dpp_xor1(mx)); mx = fmaxf(mx, dpp_xor2(mx)); mx = fmaxf(mx, dpp_xor4(mx)); mx = fmaxf(mx, dpp_xor8(mx));
      const float ex = expf(lg - mx);
      float sum = ex;
      sum += dpp_xor1(sum); sum += dpp_xor2(sum); sum += dpp_xor4(sum); sum += dpp_xor8(sum);
      const float mine = ex / sum;
      const int row = rbase + (tid >> 4), e = tid & 15;
      AFF[(size_t)e * NR + row] = mine; INV[row * 16 + e] = -1;
    }
    __syncthreads();
  }
}

__device__ __forceinline__ unsigned block_incl_scan(unsigned v, unsigned* tmp, unsigned& total) {
  const int lane = ltid() & 63, wave = ltid() >> 6;
  const unsigned inc = wave_incl_scan_u(v, lane);
  __syncthreads();
  if (lane == 63) tmp[wave] = inc;
  __syncthreads();
  unsigned off = 0u, tot = 0u;
#pragma unroll
  for (int w = 0; w < 8; ++w) { const unsigned t = tmp[w]; off += (w < wave) ? t : 0u; tot += t; }
  total = tot;
  return inc + off;
}
template <int LAYER>
__device__ __forceinline__ void topk_phase(const Params& p, char* lds) {
  const int tid = ltid(), lane = tid & 63, wave = tid >> 6;
  unsigned* keys = (unsigned*)lds;
  unsigned* hist = keys + 8192;
  unsigned* misc = hist + 256;
  unsigned* tmp = misc + 8;
  int* srow = (int*)(tmp + 8);
  const float* AFF = (const float*)(p.ws + WS_AFF);
  int* INV = (int*)(p.ws + WS_INV);
  int* IDX = (int*)(p.ws + WS_IDX);
  float* GATEV = (float*)(p.ws + WS_GATEV);
  const bf16_t* A = (const bf16_t*)(p.ws + WS_A);
  bf16_t* XS = (bf16_t*)(p.ws + WS_XS);
  const int ntask = (LAYER == 0) ? 64 : 32;
  for (int task = blockIdx.x; task < ntask; task += gridDim.x) {
    const bool isctx = task >= 32;
    const int be = task & 31, b = be >> 4, e = be & 15;
    const int n = isctx ? NCTX : SEQ, cap = isctx ? 32 : 1024;
    const int base = isctx ? MLAT + b * NCTX : b * SEQ;
    const int slotbase = isctx ? 2048 + b * 32 : b * 1024;
    __syncthreads();
    {
      unsigned kv[16];
#pragma unroll
      for (int u = 0; u < 16; ++u) { const int i = tid + u * NT; kv[u] = (i < n) ? __float_as_uint(AFF[(size_t)e * NR + base + i]) : 0u; }
#pragma unroll
      for (int u = 0; u < 16; ++u) { const int i = tid + u * NT; if (i < n) keys[i] = kv[u]; }
    }
    if (tid == 0) { misc[0] = 0u; misc[1] = 0u; misc[2] = (unsigned)cap; }
    __syncthreads();
    for (int pass = 3; pass >= 0; --pass) {
      if (tid < 256) hist[tid] = 0u;
      __syncthreads();
      const unsigned prefix = misc[0], mask = misc[1], kk = misc[2];
      for (int i = tid; i < n; i += NT) { const unsigned k = keys[i]; if ((k & mask) == prefix) atomicAdd(&hist[(k >> (8 * pass)) & 255u], 1u); }
      __syncthreads();
      const unsigned hc = (tid < 256) ? hist[tid] : 0u;
      unsigned total; const unsigned inc = block_incl_scan(hc, tmp, total);
      const unsigned above = total - inc;
      if (tid < 256 && hc > 0u && above < kk && kk <= above + hc) { misc[0] = prefix | ((unsigned)tid << (8 * pass)); misc[1] = mask | (255u << (8 * pass)); misc[2] = kk - above; }
      __syncthreads();
    }
    const unsigned T = misc[0]; const unsigned need = misc[2];
    const unsigned ngt_total = (unsigned)cap - need;
    const int per = (n + NT - 1) / NT, i0 = tid * per;
    unsigned cg_ = 0u, ce_ = 0u;
    for (int i = 0; i < per; ++i) { if (i0 + i < n) { const unsigned k = keys[i0 + i]; cg_ += (k > T) ? 1u : 0u; ce_ += (k == T) ? 1u : 0u; } }
    unsigned tg, te;
    const unsigned ig = block_incl_scan(cg_, tmp, tg);
    const unsigned ie = block_incl_scan(ce_, tmp, te);
    unsigned og = ig - cg_, oe = ie - ce_;
    for (int i = 0; i < per; ++i) {
      if (i0 + i < n) {
        const unsigned k = keys[i0 + i]; int slot = -1;
        if (k > T) slot = (int)(og++);
        else if (k == T) { if (oe < need) slot = (int)(ngt_total + oe); ++oe; }
        if (slot >= 0) {
          const int row = base + i0 + i;
          IDX[e * SLOTS + slotbase + slot] = row; GATEV[e * SLOTS + slotbase + slot] = __uint_as_float(k); INV[(size_t)row * 16 + e] = slotbase + slot;
        }
      }
    }
  }
}
__device__ __forceinline__ void gather_phase(const Params& p) {
  const int lane = ltid() & 63, wave = ltid() >> 6;
  const int gw = blockIdx.x * NWV + wave, ngw = gridDim.x * NWV;
  const int* IDX = (const int*)(p.ws + WS_IDX);
  const bf16_t* A = (const bf16_t*)(p.ws + WS_A);
  bf16_t* XS = (bf16_t*)(p.ws + WS_XS);
  for (int s = gw * 4; s < 16 * 2048; s += ngw * 4) {
    const int e = s >> 11, sl = s & 2047;
    u32x4 v0[4], v1[4];
#pragma unroll
    for (int j = 0; j < 4; ++j) { const u32x4* src = (const u32x4*)(A + (size_t)IDX[e * SLOTS + sl + j] * DM); v0[j] = src[lane]; v1[j] = src[lane + 64]; }
#pragma unroll
    for (int j = 0; j < 4; ++j) { u32x4* dst = (u32x4*)(XS + (size_t)(s + j) * DM); dst[lane] = v0[j]; dst[lane + 64] = v1[j]; }
  }
}

__device__ __forceinline__ int cperm(int c) { return (c & 32) + 8 * ((c & 15) >> 2) + 4 * ((c >> 4) & 1) + (c & 3); }
__device__ __forceinline__ bool seq_start(int r) { return r < MLAT ? ((r & (SEQ - 1)) == 0) : (((r - MLAT) & (NCTX - 1)) == 0); }

constexpr int CONVW_OFF = 147456;
struct ConvIn { u32x4 xm[4], xl[4], xr[4]; float a_in, b_in; };
__device__ __forceinline__ void dn_conv_w(const Params& p, int h, char* lds_all) {
  const int tid = ltid();
  if (tid < 24 * 6) {
    const int sc24 = tid / 6, part = tid % 6, seg = sc24 >> 3, ch = sc24 & 7;
    *(f32x4*)(lds_all + CONVW_OFF + (sc24 * 24 + part * 4) * 4) = *(const f32x4*)(p.even_conv_w + (part >> 1) * 1536 + seg * 512 + h * 64 + ch * 8 + (part & 1) * 4);
  }
}
__device__ __forceinline__ void dn_conv_load(const Params& p, int cid, int h, ConvIn& R) {
  const int tid = ltid(), dir = tid >> 8, lt = tid & 255, lane = lt & 63;
  const bf16_t* PROJ = (const bf16_t*)(p.ws + WS_PROJ);
  const int r0 = cid * 64;
  if (lt < 192) {
    const int sc24 = lt % 24, tg = lt / 24, seg = sc24 >> 3, ch = sc24 & 7;
    const int col = seg * 512 + h * 64 + ch * 8;
#pragma unroll
    for (int k4 = 0; k4 < 4; ++k4) {
      const int i = tg + 8 * (4 * dir + k4), r = r0 + i;
      const bool hasl = !seq_start(r), hasr = (r + 1 < NR) && !seq_start(r + 1);
      const u32x4 z4 = (u32x4){0u, 0u, 0u, 0u};
      R.xm[k4] = *(const u32x4*)(PROJ + (size_t)r * PROJ_LD + col);
      R.xl[k4] = hasl ? *(const u32x4*)(PROJ + (size_t)(r - 1) * PROJ_LD + col) : z4;
      R.xr[k4] = hasr ? *(const u32x4*)(PROJ + (size_t)(r + 1) * PROJ_LD + col) : z4;
    }
  } else {
    const int i = dir ? 63 - lane : lane;
    R.a_in = bf1(PROJ[(size_t)(r0 + i) * PROJ_LD + 2816 + dir * 16 + h]); R.b_in = bf1(PROJ[(size_t)(r0 + i) * PROJ_LD + 2816 + dir * 16 + 8 + h]);
  }
}
__device__ __forceinline__ void dn_prep_task(const Params& p, int cid, int h, char* lds_all, ConvIn& R, int ncid, int nh) {
  const int tid = ltid(), dir = tid >> 8, lt = tid & 255, lane = lt & 63, wv = lt >> 6;
  char* lds = lds_all + dir * 73728;
  float* Qf = (float*)lds;
  float* Kf = Qf + 64 * 72;
  float* Vf = Kf + 64 * 72;
  char* Qb = lds + 55296;
  char* Kb = Qb + 8192;
  float* G = (float*)(lds + 71680);
  float* BE = G + 64;
  float* SC = BE + 64;
  float* MP = Qf;
  const bf16_t* PROJ = (const bf16_t*)(p.ws + WS_PROJ);
  const float* GATES = (const float*)(p.ws + WS_GATES);
  const int r0 = cid * 64;
  __syncthreads();
  if (lt < 192) {
    const int sc24 = lt % 24, tg = lt / 24, seg = sc24 >> 3, ch = sc24 & 7;
    const f32x4* cwt = (const f32x4*)(lds_all + CONVW_OFF + sc24 * 96);
    const f32x4 w0a = cwt[0], w0b = cwt[1], w1a = cwt[2], w1b = cwt[3], w2a = cwt[4], w2b = cwt[5];
    const float wl[8] = {w0a.x, w0a.y, w0a.z, w0a.w, w0b.x, w0b.y, w0b.z, w0b.w}, wm[8] = {w1a.x, w1a.y, w1a.z, w1a.w, w1b.x, w1b.y, w1b.z, w1b.w}, wr_[8] = {w2a.x, w2a.y, w2a.z, w2a.w, w2b.x, w2b.y, w2b.z, w2b.w};
    float* dbase = (float*)lds_all + seg * (64 * 72) + ch * 8;
#pragma unroll
    for (int k4 = 0; k4 < 4; ++k4) {
      const int i = tg + 8 * (4 * dir + k4);
      const u32x4 xm = R.xm[k4], xl = R.xl[k4], xr = R.xr[k4];
      const unsigned xmv[4] = {xm.x, xm.y, xm.z, xm.w}, xlv[4] = {xl.x, xl.y, xl.z, xl.w}, xrv[4] = {xr.x, xr.y, xr.z, xr.w};
      float y[8];
#pragma unroll
      for (int q = 0; q < 4; ++q) {
        y[2 * q] = silu_f(wl[2 * q] * bflo(xlv[q]) + wm[2 * q] * bflo(xmv[q]) + wr_[2 * q] * bflo(xrv[q]));
        y[2 * q + 1] = silu_f(wl[2 * q + 1] * bfhi(xlv[q]) + wm[2 * q + 1] * bfhi(xmv[q]) + wr_[2 * q + 1] * bfhi(xrv[q]));
      }
      float ssq = 0.f;
#pragma unroll
      for (int q = 0; q < 8; ++q) ssq += y[q] * y[q];
      ssq += dpp_xor1(ssq); ssq += dpp_xor2(ssq); ssq += dpp_xor4(ssq);
      const float scl = seg == 2 ? 1.f : rsqrtf(ssq + EPS) * (seg == 0 ? 0.125f : 1.f);
#pragma unroll
      for (int q = 0; q < 8; ++q) y[q] *= scl;
      if (seg != 0) {
        float* dst = dbase + i * 72;
        *(f32x4*)dst = (f32x4){y[0], y[1], y[2], y[3]}; *(f32x4*)(dst + 4) = (f32x4){y[4], y[5], y[6], y[7]};
        *(f32x4*)(dst + 73728 / 4) = (f32x4){y[0], y[1], y[2], y[3]}; *(f32x4*)(dst + 73728 / 4 + 4) = (f32x4){y[4], y[5], y[6], y[7]};
      }
      if (seg != 2) {
        u32x4 w; w.x = pk2(y[0], y[1]); w.y = pk2(y[2], y[3]); w.z = pk2(y[4], y[5]); w.w = pk2(y[6], y[7]);
        char* tb = lds_all + 55296 + seg * 8192 + i * 128 + ((ch ^ ((i >> 1) & 7)) << 4);
        *(u32x4*)tb = w; *(u32x4*)(tb + 73728) = w;
        if (seg == 0) { bf16_t* QN = (bf16_t*)(p.ws + WS_QN) + (size_t)(cid * 8 + h) * 4096; *(u32x2*)(QN + i * 64 + cperm(ch * 8)) = (u32x2){w.x, w.y}; *(u32x2*)(QN + i * 64 + cperm(ch * 8 + 4)) = (u32x2){w.z, w.w}; }
      }
    }
  } else {
    const int i = dir ? 63 - lane : lane;
    const float a_in = R.a_in, b_in = R.b_in;
    float v = -__expf(p.even_a_log[dir * 8 + h]) * softplus_f(a_in + p.even_dt_bias[dir * 8 + h]);
    v = wave_incl_scan_f(v, lane);
    G[i] = v;
    BE[i] = sigmoid_f(b_in);
  }
  __syncthreads();
  if (nh != h) dn_conv_w(p, nh, lds_all);
  dn_conv_load(p, ncid, nh, R);
  {
    float* EGD = (float*)(p.ws + WS_EGDEC);
    if (lt < 64) {
      const float gl = dir ? G[0] : G[63];
      float* o = EGD + ((size_t)((cid * 8 + h) * 2 + dir)) * 128;
      o[lt] = __expf(G[lt]); o[64 + lt] = __expf(gl - G[lt]);
    }
    if (dir == 0) {
      bf16_t* KNT = (bf16_t*)(p.ws + WS_KNT) + (size_t)(cid * 8 + h) * 4096;
      for (int u = lt; u < 64 * 16; u += 256) {
        const int i = u >> 4, c4 = (u & 15) * 4;
        u32x2 o2; o2.x = pk2(Kf[c4 * 72 + i], Kf[(c4 + 1) * 72 + i]); o2.y = pk2(Kf[(c4 + 2) * 72 + i], Kf[(c4 + 3) * 72 + i]);
        *(u32x2*)(KNT + i * 64 + cperm(c4)) = o2;
      }
    }
    const int fr = lane & 15, fq = lane >> 4, sw = (fr >> 1) & 7;
    f32x4 kk[4], qk[4];
#pragma unroll
    for (int n = 0; n < 4; ++n) { kk[n] = (f32x4){0.f, 0.f, 0.f, 0.f}; qk[n] = kk[n]; }
#pragma unroll
    for (int ks = 0; ks < 2; ++ks) {
      const int co = ((ks * 4 + fq) ^ sw) << 4;
      const bf16x8 ak = *(const bf16x8*)(Kb + (16 * wv + fr) * 128 + co), aq = *(const bf16x8*)(Qb + (16 * wv + fr) * 128 + co);
#pragma unroll
      for (int n = 0; n < 4; ++n) {
        const bf16x8 bk = *(const bf16x8*)(Kb + (16 * n + fr) * 128 + co);
        kk[n] = __builtin_amdgcn_mfma_f32_16x16x32_bf16(bk, ak, kk[n], 0, 0, 0);
        qk[n] = __builtin_amdgcn_mfma_f32_16x16x32_bf16(bk, aq, qk[n], 0, 0, 0);
      }
    }
    __syncthreads();
    char* Mb = Qb;
    bf16_t* AQ = (bf16_t*)(p.ws + WS_WUA) + ((size_t)((cid * 8 + h) * 2 + dir) * 3 + 1) * 4096;
    const int i = 16 * wv + fr; const float gi = G[i], bei = BE[i];
    const int ppi = dir ? 63 - i : i;
#pragma unroll
    for (int n = 0; n < 4; ++n) {
      float v0[4], mv[4];
#pragma unroll
      for (int q = 0; q < 4; ++q) {
        const int j = 16 * n + 4 * fq + q;
        const float e0 = __expf(fminf(gi - G[j], 0.f));
        const bool inc = dir ? (j >= i) : (j <= i);
        v0[q] = inc ? qk[n][q] * e0 : 0.f;
        const bool strict = dir ? (j > i) : (j < i);
        mv[q] = strict ? bei * kk[n][q] * e0 : 0.f;
        if (strict && n == wv) { const int pq = dir ? 63 - j : j; MP[((ppi >> 2) * 64 + pq) * 4 + (ppi & 3)] = mv[q]; }
      }
      u32x2 o; o.x = pk2(v0[0], v0[1]); o.y = pk2(v0[2], v0[3]); *(u32x2*)(AQ + i * 64 + cperm(16 * n + 4 * fq)) = o;
      {
        const int pq0 = dir ? 60 - 16 * n - 4 * fq : 16 * n + 4 * fq;
        u32x2 mo; mo.x = dir ? pk2(mv[3], mv[2]) : pk2(mv[0], mv[1]); mo.y = dir ? pk2(mv[1], mv[0]) : pk2(mv[2], mv[3]);
        *(u32x2*)(Mb + ppi * 128 + (((pq0 >> 3) ^ ((ppi >> 1) & 7)) << 4) + (pq0 & 7) * 2) = mo;
      }
    }
  }
  __syncthreads();
  for (int u = lt; u < 64 * 16; u += 256) {
    const int a = u >> 4, c4 = (u & 15) * 4; const float be = BE[a], bk = be * __expf(G[a]);
    *(f32x4*)(Vf + a * 72 + c4) = *(const f32x4*)(Vf + a * 72 + c4) * be; *(f32x4*)(Kf + a * 72 + c4) = *(const f32x4*)(Kf + a * 72 + c4) * bk;
  }
  float* TL = (float*)Kb;
  {
    const int j = lane & 15, g = lane >> 4;
    const f32x4* mblk = (const f32x4*)MP + (4 * wv) * 64 + 16 * wv;
    float t[16];
#pragma unroll
    for (int i = 0; i < 16; ++i) {
      float sacc = (i == j) ? 1.f : 0.f;
#pragma unroll
      for (int k = 0; k < i; ++k) { const f32x4 m4 = mblk[(i >> 2) * 64 + k]; const float mik = (i & 3) == 0 ? m4.x : (i & 3) == 1 ? m4.y : (i & 3) == 2 ? m4.z : m4.w; sacc -= mik * t[k]; }
      t[i] = sacc;
    }
#pragma unroll
    for (int i = 0; i < 16; ++i) if ((i & 3) == g) TL[wv * 256 + i * 16 + j] = t[i];
  }
  __syncthreads();
  {
    const char* Mb = Qb;
    const int fr = lane & 15, fq = lane >> 4;
    unsigned xb[2][4][2];
#pragma unroll
    for (int I = 0; I < 4; ++I) {
      const int mrow = 16 * I + fr, msw = (mrow >> 1) & 7;
      u32x2 m0lo = (u32x2){0u, 0u}, m0hi = m0lo, m1lo = m0lo;
      if (I >= 1) m0lo = *(const u32x2*)(Mb + mrow * 128 + (((0 + (fq >> 1)) ^ msw) << 4) + (fq & 1) * 8);
      if (I >= 2) m0hi = *(const u32x2*)(Mb + mrow * 128 + (((2 + (fq >> 1)) ^ msw) << 4) + (fq & 1) * 8);
      if (I >= 3) m1lo = *(const u32x2*)(Mb + mrow * 128 + (((4 + (fq >> 1)) ^ msw) << 4) + (fq & 1) * 8);
      const f32x4 tq = *(const f32x4*)(TL + I * 256 + fr * 16 + 4 * fq);
#pragma unroll
      for (int tsel = 0; tsel < 2; ++tsel) {
        float* Xa = (tsel ? Kf : Vf) + 16 * wv + fr;
        f32x4 acc = (f32x4){0.f, 0.f, 0.f, 0.f};
        if (I >= 1) {
          const bf16x8 af = __builtin_bit_cast(bf16x8, (u32x4){m0lo.x, m0lo.y, m0hi.x, m0hi.y});
          const bf16x8 bfv = __builtin_bit_cast(bf16x8, (u32x4){xb[tsel][0][0], xb[tsel][0][1], I >= 2 ? xb[tsel][1][0] : 0u, I >= 2 ? xb[tsel][1][1] : 0u});
          acc = __builtin_amdgcn_mfma_f32_16x16x32_bf16(af, bfv, acc, 0, 0, 0);
        }
        if (I >= 3) {
          const bf16x8 af = __builtin_bit_cast(bf16x8, (u32x4){m1lo.x, m1lo.y, 0u, 0u});
          const bf16x8 bfv = __builtin_bit_cast(bf16x8, (u32x4){xb[tsel][2][0], xb[tsel][2][1], 0u, 0u});
          acc = __builtin_amdgcn_mfma_f32_16x16x32_bf16(af, bfv, acc, 0, 0, 0);
        }
        float z[4];
#pragma unroll
        for (int r4 = 0; r4 < 4; ++r4) { const int pp = 16 * I + 4 * fq + r4; z[r4] = Xa[(dir ? 63 - pp : pp) * 72]; }
        z[0] -= acc.x; z[1] -= acc.y; z[2] -= acc.z; z[3] -= acc.w;
        f32x4 x = (f32x4){0.f, 0.f, 0.f, 0.f};
        x = __builtin_amdgcn_mfma_f32_16x16x4f32(tq.x, z[0], x, 0, 0, 0);
        x = __builtin_amdgcn_mfma_f32_16x16x4f32(tq.y, z[1], x, 0, 0, 0);
        x = __builtin_amdgcn_mfma_f32_16x16x4f32(tq.z, z[2], x, 0, 0, 0);
        x = __builtin_amdgcn_mfma_f32_16x16x4f32(tq.w, z[3], x, 0, 0, 0);
        const float xv[4] = {x.x, x.y, x.z, x.w};
#pragma unroll
        for (int r4 = 0; r4 < 4; ++r4) { const int pp = 16 * I + 4 * fq + r4; Xa[(dir ? 63 - pp : pp) * 72] = xv[r4]; }
        xb[tsel][I][0] = pk2(xv[0], xv[1]); xb[tsel][I][1] = pk2(xv[2], xv[3]);
      }
    }
  }
  __syncthreads();
  {
    bf16_t* WUA = (bf16_t*)(p.ws + WS_WUA) + (size_t)((cid * 8 + h) * 2 + dir) * 3 * 4096;
    for (int u = lt; u < 64 * 16; u += 256) {
      const int i = u >> 4, c4 = (u & 15) * 4;
      const f32x4 kv = *(const f32x4*)(Kf + i * 72 + c4);
      u32x2 o; o.x = pk2(kv.x, kv.y); o.y = pk2(kv.z, kv.w);
      *(u32x2*)(WUA + i * 64 + cperm(c4)) = o;
      u32x2 o2; o2.x = pk2(Vf[c4 * 72 + i], Vf[(c4 + 1) * 72 + i]); o2.y = pk2(Vf[(c4 + 2) * 72 + i], Vf[(c4 + 3) * 72 + i]);
      *(u32x2*)(WUA + 2 * 4096 + i * 64 + 16 * ((c4 & 15) >> 2) + 4 * (c4 >> 4)) = o2;
    }
  }
}

__device__ __forceinline__ void gqa_prep_task(const Params& p, int cid, char* lds) {
  const int tid = ltid(), lane = tid & 63, wave = tid >> 6;
  const bf16_t* PROJ = (const bf16_t*)(p.ws + WS_PROJ);
  bf16_t* QB = (bf16_t*)(p.ws + WS_QB);
  bf16_t* KB = (bf16_t*)(p.ws + WS_KB);
  bf16_t* VT = (bf16_t*)(p.ws + WS_VT);
  const float* rc = (const float*)(p.ws + WS_ROPE); const float* rsn = rc + 8192 * 32;
  const int r0 = cid * 64;
  const bool isctx = r0 >= MLAT;
  const int b = isctx ? (r0 - MLAT) / NCTX : r0 / SEQ;
  const int key0 = isctx ? (r0 - MLAT) % NCTX : NCTX + (r0 % SEQ);
  bf16_t* vt_lds = (bf16_t*)lds;
  __syncthreads();
  for (int u = tid; u < 64 * 16; u += NT) {
    const int i = u >> 4, ch = u & 15;
    const u32x4 v = *(const u32x4*)(PROJ + (size_t)(r0 + i) * PROJ_LD + 2688 + ch * 8);
    unsigned* d = (unsigned*)(vt_lds + i * 130 + ch * 8);
    d[0] = v.x; d[1] = v.y; d[2] = v.z; d[3] = v.w;
  }
  {
    const int d0 = 8 * (lane & 7), f0 = 8 * (lane & 3);
    const bool lowhalf = (lane & 7) < 4;
    float gqv[8], gkv[8];
    { const f32x4 a0 = *(const f32x4*)(p.even_q_norm_g + d0), a1 = *(const f32x4*)(p.even_q_norm_g + d0 + 4), b0 = *(const f32x4*)(p.even_k_norm_g + d0), b1 = *(const f32x4*)(p.even_k_norm_g + d0 + 4);
      gqv[0] = a0.x; gqv[1] = a0.y; gqv[2] = a0.z; gqv[3] = a0.w; gqv[4] = a1.x; gqv[5] = a1.y; gqv[6] = a1.z; gqv[7] = a1.w;
      gkv[0] = b0.x; gkv[1] = b0.y; gkv[2] = b0.z; gkv[3] = b0.w; gkv[4] = b1.x; gkv[5] = b1.y; gkv[6] = b1.z; gkv[7] = b1.w; }
#pragma unroll 1
    for (int ib = 0; ib < 2; ++ib) {
      u32x4 rawq[4], rawk[4]; f32x4 c0[4], c1[4], s0[4], s1[4];
#pragma unroll
      for (int u = 0; u < 4; ++u) {
        const int i = wave * 8 + ib * 4 + u, r = r0 + i, t = r & (SEQ - 1);
        rawq[u] = *(const u32x4*)(PROJ + (size_t)r * PROJ_LD + 2048 + lane * 8);
        rawk[u] = *(const u32x4*)(PROJ + (size_t)r * PROJ_LD + 2560 + (lane & 15) * 8);
        c0[u] = (f32x4){1.f, 1.f, 1.f, 1.f}; c1[u] = c0[u]; s0[u] = (f32x4){0.f, 0.f, 0.f, 0.f}; s1[u] = s0[u];
        if (!isctx) { c0[u] = *(const f32x4*)(rc + t * 32 + f0); c1[u] = *(const f32x4*)(rc + t * 32 + f0 + 4); s0[u] = *(const f32x4*)(rsn + t * 32 + f0); s1[u] = *(const f32x4*)(rsn + t * 32 + f0 + 4); }
      }
#pragma unroll
      for (int u = 0; u < 4; ++u) {
        const int i = wave * 8 + ib * 4 + u, r = r0 + i;
        const float cs[8] = {c0[u].x, c0[u].y, c0[u].z, c0[u].w, c1[u].x, c1[u].y, c1[u].z, c1[u].w}, sn[8] = {s0[u].x, s0[u].y, s0[u].z, s0[u].w, s1[u].x, s1[u].y, s1[u].z, s1[u].w};
#pragma unroll
        for (int pass = 0; pass < 2; ++pass) {
          const u32x4 raw = pass == 0 ? rawq[u] : rawk[u];
          float xv[8] = {bflo(raw.x), bfhi(raw.x), bflo(raw.y), bfhi(raw.y), bflo(raw.z), bfhi(raw.z), bflo(raw.w), bfhi(raw.w)};
          float ss = 0.f;
#pragma unroll
          for (int q = 0; q < 8; ++q) ss += xv[q] * xv[q];
          ss += dpp_xor1(ss); ss += dpp_xor2(ss); ss += dpp_xor4(ss);
          const float rs = rsqrtf(ss * (1.f / 64.f) + EPS) * (pass == 0 ? 0.125f * LOG2E : 1.f);
          float o[8];
#pragma unroll
          for (int q = 0; q < 8; ++q) {
            const float mine = xv[q] * rs * (pass == 0 ? gqv[q] : gkv[q]);
            const float other = dpp_xor4(mine);
            o[q] = lowhalf ? (mine * cs[q] - other * sn[q]) : (other * sn[q] + mine * cs[q]);
          }
          u32x4 w; w.x = pk2(o[0], o[1]); w.y = pk2(o[2], o[3]); w.z = pk2(o[4], o[5]); w.w = pk2(o[6], o[7]);
          if (pass == 0) *(u32x4*)(QB + (size_t)r * 512 + lane * 8) = w;
          else if (lane < 16) *(u32x4*)(KB + ((size_t)(b * 2 + (lane >> 3)) * NKEY + key0 + i) * 64 + d0) = w;
        }
      }
    }
  }
  __syncthreads();
  {
    const int d = tid >> 2, kh = (tid & 3) * 16;
    bf16_t* dst = VT + ((size_t)(b * 2 + (d >> 6)) * 64 + (d & 63)) * NKEY + key0 + kh;
#pragma unroll
    for (int c8 = 0; c8 < 2; ++c8) {
      unsigned w[4];
#pragma unroll
      for (int q = 0; q < 4; ++q) { const unsigned lo = vt_lds[(kh + c8 * 8 + 2 * q) * 130 + d], hi = vt_lds[(kh + c8 * 8 + 2 * q + 1) * 130 + d]; w[q] = lo | (hi << 16); }
      *(u32x4*)(dst + c8 * 8) = (u32x4){w[0], w[1], w[2], w[3]};
    }
  }
}
__device__ __forceinline__ void prep_even(const Params& p, char* lds) {
  {
    ConvIn R;
    int t = blockIdx.x;
    __syncthreads();
    dn_conv_w(p, t & 7, lds);
    dn_conv_load(p, (t < NCHUNK * 8) ? t >> 3 : 0, t & 7, R);
    for (; t < NCHUNK * 8; t += gridDim.x) {
      const int tn = (t + (int)gridDim.x < NCHUNK * 8) ? t + (int)gridDim.x : t;
      dn_prep_task(p, t >> 3, t & 7, lds, R, tn >> 3, tn & 7);
    }
  }
  const int nb = (NCHUNK * 8) % (int)gridDim.x;
  if ((int)blockIdx.x >= nb) for (int g = (int)blockIdx.x - nb; g < NCHUNK; g += (int)gridDim.x - nb) gqa_prep_task(p, g, lds);
}

__device__ __forceinline__ bf16x8 ldfrag136(const char* tile, int row, int s, int q) {
  const char* a = tile + row * 136 + (32 * s + 4 * q) * 2;
  const u32x2 lo = *(const u32x2*)a, hi = *(const u32x2*)(a + 32);
  return __builtin_bit_cast(bf16x8, (u32x4){lo.x, lo.y, hi.x, hi.y});
}
__device__ __forceinline__ bf16x8 pack_acc2(const f32x4& a, const f32x4& b) {
  return __builtin_bit_cast(bf16x8, (u32x4){pk2(a.x, a.y), pk2(a.z, a.w), pk2(b.x, b.y), pk2(b.z, b.w)});
}
#define SCAN_LOAD(B, ST) do { const int cid_ = step_cid(ST); const size_t cd_ = (size_t)((cid_ * 8 + h) * 2 + dir); const bf16_t* wua_ = WUA + cd_ * 3 * 4096; \
    _Pragma("unroll") for (int mt = 0; mt < 4; ++mt) _Pragma("unroll") for (int s2 = 0; s2 < 2; ++s2) Wf##B[mt][s2] = *(const bf16x8*)(wua_ + foff + mt * 1024 + s2 * 32); \
    Uf##B[0] = *(const u32x4*)(wua_ + 8192 + uoff); Uf##B[1] = *(const u32x4*)(wua_ + 8192 + uoff + 8); } while (0)
#define SCAN_LOADK(ST) do { const int cid_ = step_cid(ST); const size_t cd_ = (size_t)((cid_ * 8 + h) * 2 + dir); const bf16_t* kn_ = KNT + (size_t)(cid_ * 8 + h) * 4096; const float* eg_ = EGD + cd_ * 128; \
    _Pragma("unroll") for (int mt = 0; mt < 4; ++mt) _Pragma("unroll") for (int s2 = 0; s2 < 2; ++s2) Kf[mt][s2] = *(const bf16x8*)(kn_ + foff + mt * 1024 + s2 * 32); \
    _Pragma("unroll") for (int mt = 0; mt < 4; ++mt) dc[mt] = *(const f32x4*)(eg_ + 64 + 16 * mt + 4 * q); \
    gl = eg_[dir ? 0 : 63]; } while (0)
#define SCAN_STEP(B, ST) do { const int cid_ = step_cid(ST); const size_t cd_ = (size_t)((cid_ * 8 + h) * 2 + dir); \
    const u32x4 sa_ = (u32x4){pk2(S[0].x, S[0].y), pk2(S[0].z, S[0].w), pk2(S[1].x, S[1].y), pk2(S[1].z, S[1].w)}, sb_ = (u32x4){pk2(S[2].x, S[2].y), pk2(S[2].z, S[2].w), pk2(S[3].x, S[3].y), pk2(S[3].z, S[3].w)}; \
    *(u32x4*)(SC + cd_ * 4096 + uoff) = sa_; *(u32x4*)(SC + cd_ * 4096 + uoff + 8) = sb_; \
    const bf16x8 bS0_ = __builtin_bit_cast(bf16x8, sa_), bS1_ = __builtin_bit_cast(bf16x8, sb_); \
    const unsigned uw_[8] = {Uf##B[0].x, Uf##B[0].y, Uf##B[0].z, Uf##B[0].w, Uf##B[1].x, Uf##B[1].y, Uf##B[1].z, Uf##B[1].w}; \
    f32x4 vn_[4]; \
    _Pragma("unroll") for (int mt = 0; mt < 4; ++mt) { f32x4 pacc_ = (f32x4){0.f, 0.f, 0.f, 0.f}; \
      pacc_ = __builtin_amdgcn_mfma_f32_16x16x32_bf16(Wf##B[mt][0], bS0_, pacc_, 0, 0, 0); pacc_ = __builtin_amdgcn_mfma_f32_16x16x32_bf16(Wf##B[mt][1], bS1_, pacc_, 0, 0, 0); \
      vn_[mt] = (f32x4){bflo(uw_[2 * mt]), bfhi(uw_[2 * mt]), bflo(uw_[2 * mt + 1]), bfhi(uw_[2 * mt + 1])} - pacc_; } \
    SCAN_LOAD(B, (ST) + 2); \
    const u32x4 va_ = (u32x4){pk2(vn_[0].x, vn_[0].y), pk2(vn_[0].z, vn_[0].w), pk2(vn_[1].x, vn_[1].y), pk2(vn_[1].z, vn_[1].w)}, vb_ = (u32x4){pk2(vn_[2].x, vn_[2].y), pk2(vn_[2].z, vn_[2].w), pk2(vn_[3].x, vn_[3].y), pk2(vn_[3].z, vn_[3].w)}; \
    bf16_t* ut_ = (bf16_t*)WUA + cd_ * 3 * 4096 + 8192 + uoff; *(u32x4*)ut_ = va_; *(u32x4*)(ut_ + 8) = vb_; \
    const bf16x8 bD0_ = pack_acc2(vn_[0] * dc[0], vn_[1] * dc[1]), bD1_ = pack_acc2(vn_[2] * dc[2], vn_[3] * dc[3]); \
    _Pragma("unroll") for (int t = 0; t < 4; ++t) { f32x4 sacc_ = S[t] * gl; \
      sacc_ = __builtin_amdgcn_mfma_f32_16x16x32_bf16(Kf[t][0], bD0_, sacc_, 0, 0, 0); sacc_ = __builtin_amdgcn_mfma_f32_16x16x32_bf16(Kf[t][1], bD1_, sacc_, 0, 0, 0); S[t] = sacc_; } \
    SCAN_LOADK((ST) + 1); } while (0)
__device__ __forceinline__ void scan_wave(const Params& p, int task) {
  const int lane = ltid() & 63, c = lane & 15, q = lane >> 4;
  const int w = task & 3, dir = (task >> 2) & 1, h = (task >> 3) & 7, b = task >> 6;
  const bf16_t* KNT = (const bf16_t*)(p.ws + WS_KNT);
  const bf16_t* WUA = (const bf16_t*)(p.ws + WS_WUA);
  const float* EGD = (const float*)(p.ws + WS_EGDEC);
  bf16_t* SC = (bf16_t*)(p.ws + WS_A);
  const int foff = c * 64 + 8 * q;
  const int uoff = (16 * w + c) * 64 + 16 * q;
  auto step_cid = [&](int st) -> int {
    if (st >= 132) st = 131;
    if (st < 4) return 256 + b * 4 + (dir ? 3 - st : st);
    const int cc = st - 4; return b * 128 + (dir ? 127 - cc : cc);
  };
  f32x4 S[4];
#pragma unroll
  for (int t = 0; t < 4; ++t) S[t] = (f32x4){0.f, 0.f, 0.f, 0.f};
  bf16x8 Wf0[4][2], Wf1[4][2], Kf[4][2]; u32x4 Uf0[2], Uf1[2]; f32x4 dc[4]; float gl;
  SCAN_LOAD(0, 0); SCAN_LOAD(1, 1); SCAN_LOADK(0);
  for (int st = 0; st < 132; st += 2) {
    SCAN_STEP(0, st);
    SCAN_STEP(1, st + 1);
  }
}

struct AttnState { f32x16 o0, o1; float m, l; };
__device__ __forceinline__ void attn_scores(const char* Kt, const bf16x8 (&qf)[4], int r32, int hh, f32x16& s0, f32x16& s1) {
  const int sw = (r32 >> 1) & 7;
#pragma unroll
  for (int s = 0; s < 4; ++s) {
    const int co = ((2 * s + hh) ^ sw) << 4;
    const bf16x8 k0 = *(const bf16x8*)(Kt + r32 * 128 + co);
    const bf16x8 k1 = *(const bf16x8*)(Kt + (32 + r32) * 128 + co);
    s0 = __builtin_amdgcn_mfma_f32_32x32x16_bf16(k0, qf[s], s0, 0, 0, 0);
    s1 = __builtin_amdgcn_mfma_f32_32x32x16_bf16(k1, qf[s], s1, 0, 0, 0);
  }
}
__device__ __forceinline__ void attn_update(AttnState& st, f32x16& s0, f32x16& s1, const char* Vt, int r32, int hh) {
  float mx = s0[0];
#pragma unroll
  for (int i = 1; i < 16; ++i) mx = fmaxf(mx, s0[i]);
#pragma unroll
  for (int i = 0; i < 16; ++i) mx = fmaxf(mx, s1[i]);
  mx = swap32_max(mx);
  if (!__all(mx - st.m <= 8.f)) {
    const float mnew = fmaxf(st.m, mx);
    const float alpha = __builtin_amdgcn_exp2f(st.m - mnew);
    st.m = mnew; st.l *= alpha; st.o0 *= alpha; st.o1 *= alpha;
  }
  const float mcur = st.m;
  float ls = 0.f;
#pragma unroll
  for (int i = 0; i < 16; ++i) { s0[i] = __builtin_amdgcn_exp2f(s0[i] - mcur); ls += s0[i]; }
#pragma unroll
  for (int i = 0; i < 16; ++i) { s1[i] = __builtin_amdgcn_exp2f(s1[i] - mcur); ls += s1[i]; }
  st.l += ls;
  bf16x8 pf[2][2];
#pragma unroll
  for (int sp = 0; sp < 2; ++sp) {
    pf[0][sp] = __builtin_bit_cast(bf16x8, (u32x4){pk2(s0[8 * sp], s0[8 * sp + 1]), pk2(s0[8 * sp + 2], s0[8 * sp + 3]), pk2(s0[8 * sp + 4], s0[8 * sp + 5]), pk2(s0[8 * sp + 6], s0[8 * sp + 7])});
    pf[1][sp] = __builtin_bit_cast(bf16x8, (u32x4){pk2(s1[8 * sp], s1[8 * sp + 1]), pk2(s1[8 * sp + 2], s1[8 * sp + 3]), pk2(s1[8 * sp + 4], s1[8 * sp + 5]), pk2(s1[8 * sp + 6], s1[8 * sp + 7])});
  }
#pragma unroll
  for (int u = 0; u < 2; ++u)
#pragma unroll
    for (int sp = 0; sp < 2; ++sp) {
      const int ko = (32 * u + 16 * sp + 4 * hh) * 2;
      const char* a0 = Vt + r32 * 136 + ko; const char* a1 = Vt + (32 + r32) * 136 + ko;
      const u32x2 x0 = *(const u32x2*)a0, x1 = *(const u32x2*)(a0 + 16), y0 = *(const u32x2*)a1, y1 = *(const u32x2*)(a1 + 16);
      const bf16x8 v0 = __builtin_bit_cast(bf16x8, (u32x4){x0.x, x0.y, x1.x, x1.y}), v1 = __builtin_bit_cast(bf16x8, (u32x4){y0.x, y0.y, y1.x, y1.y});
      st.o0 = __builtin_amdgcn_mfma_f32_32x32x16_bf16(v0, pf[u][sp], st.o0, 0, 0, 0);
      st.o1 = __builtin_amdgcn_mfma_f32_32x32x16_bf16(v1, pf[u][sp], st.o1, 0, 0, 0);
    }
}
__device__ __forceinline__ void attn_update_bounded(AttnState& st, f32x16& s0, f32x16& s1, const char* Vt, int r32, int hh) {
  float ls = 0.f;
#pragma unroll
  for (int i = 0; i < 16; ++i) { s0[i] = __builtin_amdgcn_exp2f(s0[i]); ls += s0[i]; }
#pragma unroll
  for (int i = 0; i < 16; ++i) { s1[i] = __builtin_amdgcn_exp2f(s1[i]); ls += s1[i]; }
  st.l += ls;
  bf16x8 pf[2][2];
#pragma unroll
  for (int sp = 0; sp < 2; ++sp) {
    pf[0][sp] = __builtin_bit_cast(bf16x8, (u32x4){pk2(s0[8 * sp], s0[8 * sp + 1]), pk2(s0[8 * sp + 2], s0[8 * sp + 3]), pk2(s0[8 * sp + 4], s0[8 * sp + 5]), pk2(s0[8 * sp + 6], s0[8 * sp + 7])});
    pf[1][sp] = __builtin_bit_cast(bf16x8, (u32x4){pk2(s1[8 * sp], s1[8 * sp + 1]), pk2(s1[8 * sp + 2], s1[8 * sp + 3]), pk2(s1[8 * sp + 4], s1[8 * sp + 5]), pk2(s1[8 * sp + 6], s1[8 * sp + 7])});
  }
#pragma unroll
  for (int u = 0; u < 2; ++u)
#pragma unroll
    for (int sp = 0; sp < 2; ++sp) {
      const int ko = (32 * u + 16 * sp + 4 * hh) * 2;
      const char* a0 = Vt + r32 * 136 + ko; const char* a1 = Vt + (32 + r32) * 136 + ko;
      const u32x2 x0 = *(const u32x2*)a0, x1 = *(const u32x2*)(a0 + 16), y0 = *(const u32x2*)a1, y1 = *(const u32x2*)(a1 + 16);
      const bf16x8 v0 = __builtin_bit_cast(bf16x8, (u32x4){x0.x, x0.y, x1.x, x1.y}), v1 = __builtin_bit_cast(bf16x8, (u32x4){y0.x, y0.y, y1.x, y1.y});
      st.o0 = __builtin_amdgcn_mfma_f32_32x32x16_bf16(v0, pf[u][sp], st.o0, 0, 0, 0);
      st.o1 = __builtin_amdgcn_mfma_f32_32x32x16_bf16(v1, pf[u][sp], st.o1, 0, 0, 0);
    }
}
__device__ __forceinline__ void attn_tile_bounded(AttnState& st, const f32x16& negsh, const char* Kt, const char* Vt, const bf16x8 (&qf)[4], int r32, int hh) {
  const int sw = (r32 >> 1) & 7;
  bf16x8 kf[8];
#pragma unroll
  for (int s = 0; s < 4; ++s) { const int co = ((2 * s + hh) ^ sw) << 4; kf[2 * s] = *(const bf16x8*)(Kt + r32 * 128 + co); kf[2 * s + 1] = *(const bf16x8*)(Kt + (32 + r32) * 128 + co); }
  __builtin_amdgcn_sched_barrier(0);
  f32x16 s0 = negsh, s1 = negsh;
#pragma unroll
  for (int s = 0; s < 4; ++s) { s0 = __builtin_amdgcn_mfma_f32_32x32x16_bf16(kf[2 * s], qf[s], s0, 0, 0, 0); s1 = __builtin_amdgcn_mfma_f32_32x32x16_bf16(kf[2 * s + 1], qf[s], s1, 0, 0, 0); }
  bf16x8 vf[2][2][2];
#pragma unroll
  for (int u = 0; u < 2; ++u)
#pragma unroll
    for (int sp = 0; sp < 2; ++sp) {
      const int ko = (32 * u + 16 * sp + 4 * hh) * 2;
      const char* a0 = Vt + r32 * 136 + ko; const char* a1 = Vt + (32 + r32) * 136 + ko;
      const u32x2 x0 = *(const u32x2*)a0, x1 = *(const u32x2*)(a0 + 16), y0 = *(const u32x2*)a1, y1 = *(const u32x2*)(a1 + 16);
      vf[u][sp][0] = __builtin_bit_cast(bf16x8, (u32x4){x0.x, x0.y, x1.x, x1.y}); vf[u][sp][1] = __builtin_bit_cast(bf16x8, (u32x4){y0.x, y0.y, y1.x, y1.y});
    }
  __builtin_amdgcn_sched_barrier(0);
  float ls = 0.f;
#pragma unroll
  for (int i = 0; i < 16; ++i) { s0[i] = __builtin_amdgcn_exp2f(s0[i]); ls += s0[i]; }
#pragma unroll
  for (int i = 0; i < 16; ++i) { s1[i] = __builtin_amdgcn_exp2f(s1[i]); ls += s1[i]; }
  st.l += ls;
  bf16x8 pf[2][2];
#pragma unroll
  for (int sp = 0; sp < 2; ++sp) {
    pf[0][sp] = __builtin_bit_cast(bf16x8, (u32x4){pk2(s0[8 * sp], s0[8 * sp + 1]), pk2(s0[8 * sp + 2], s0[8 * sp + 3]), pk2(s0[8 * sp + 4], s0[8 * sp + 5]), pk2(s0[8 * sp + 6], s0[8 * sp + 7])});
    pf[1][sp] = __builtin_bit_cast(bf16x8, (u32x4){pk2(s1[8 * sp], s1[8 * sp + 1]), pk2(s1[8 * sp + 2], s1[8 * sp + 3]), pk2(s1[8 * sp + 4], s1[8 * sp + 5]), pk2(s1[8 * sp + 6], s1[8 * sp + 7])});
  }
#pragma unroll
  for (int u = 0; u < 2; ++u)
#pragma unroll
    for (int sp = 0; sp < 2; ++sp) {
      st.o0 = __builtin_amdgcn_mfma_f32_32x32x16_bf16(vf[u][sp][0], pf[u][sp], st.o0, 0, 0, 0);
      st.o1 = __builtin_amdgcn_mfma_f32_32x32x16_bf16(vf[u][sp][1], pf[u][sp], st.o1, 0, 0, 0);
    }
}
__device__ __forceinline__ void attn_tile_pipe(AttnState& st, f32x16& sc0, f32x16& sc1, float nsh, const char* Kn, const char* Vc, const bf16x8 (&qf)[4], int r32, int hh) {
  const int sw = (r32 >> 1) & 7;
  bf16x8 kf[8];
#pragma unroll
  for (int s = 0; s < 4; ++s) { const int co = ((2 * s + hh) ^ sw) << 4; kf[2 * s] = *(const bf16x8*)(Kn + r32 * 128 + co); kf[2 * s + 1] = *(const bf16x8*)(Kn + (32 + r32) * 128 + co); }
  f32x16 n0, n1;
#pragma unroll
  for (int i = 0; i < 16; ++i) { n0[i] = nsh; n1[i] = nsh; }
  __builtin_amdgcn_sched_barrier(0);
  float ls = 0.f;
#pragma unroll
  for (int s = 0; s < 4; ++s) {
    n0 = __builtin_amdgcn_mfma_f32_32x32x16_bf16(kf[2 * s], qf[s], n0, 0, 0, 0);
    __builtin_amdgcn_sched_barrier(0);
#pragma unroll
    for (int i = 4 * s; i < 4 * s + 4; ++i) { sc0[i] = __builtin_amdgcn_exp2f(sc0[i]); ls += sc0[i]; }
    __builtin_amdgcn_sched_barrier(0);
    n1 = __builtin_amdgcn_mfma_f32_32x32x16_bf16(kf[2 * s + 1], qf[s], n1, 0, 0, 0);
    __builtin_amdgcn_sched_barrier(0);
#pragma unroll
    for (int i = 4 * s; i < 4 * s + 4; ++i) { sc1[i] = __builtin_amdgcn_exp2f(sc1[i]); ls += sc1[i]; }
    __builtin_amdgcn_sched_barrier(0);
  }
  st.l += ls;
  bf16x8 vf[2][2][2];
#pragma unroll
  for (int u = 0; u < 2; ++u)
#pragma unroll
    for (int sp = 0; sp < 2; ++sp) {
      const int ko = (32 * u + 16 * sp + 4 * hh) * 2;
      const char* a0 = Vc + r32 * 136 + ko; const char* a1 = Vc + (32 + r32) * 136 + ko;
      const u32x2 x0 = *(const u32x2*)a0, x1 = *(const u32x2*)(a0 + 16), y0 = *(const u32x2*)a1, y1 = *(const u32x2*)(a1 + 16);
      vf[u][sp][0] = __builtin_bit_cast(bf16x8, (u32x4){x0.x, x0.y, x1.x, x1.y}); vf[u][sp][1] = __builtin_bit_cast(bf16x8, (u32x4){y0.x, y0.y, y1.x, y1.y});
    }
#pragma unroll
  for (int u = 0; u < 2; ++u)
#pragma unroll
    for (int sp = 0; sp < 2; ++sp) {
      const f32x16& sc = u ? sc1 : sc0;
      const bf16x8 pf = __builtin_bit_cast(bf16x8, (u32x4){pk2(sc[8 * sp], sc[8 * sp + 1]), pk2(sc[8 * sp + 2], sc[8 * sp + 3]), pk2(sc[8 * sp + 4], sc[8 * sp + 5]), pk2(sc[8 * sp + 6], sc[8 * sp + 7])});
      st.o0 = __builtin_amdgcn_mfma_f32_32x32x16_bf16(vf[u][sp][0], pf, st.o0, 0, 0, 0);
      st.o1 = __builtin_amdgcn_mfma_f32_32x32x16_bf16(vf[u][sp][1], pf, st.o1, 0, 0, 0);
    }
  sc0 = n0; sc1 = n1;
}
__device__ __forceinline__ void attn_store(const AttnState& st, bf16_t* orow, int hh) {
  const float l = swap32_sum(st.l, st.l);
  const float il = 1.f / l;
#pragma unroll
  for (int g = 0; g < 4; ++g) {
    u32x2 a; a.x = pk2(st.o0[4 * g] * il, st.o0[4 * g + 1] * il); a.y = pk2(st.o0[4 * g + 2] * il, st.o0[4 * g + 3] * il);
    *(u32x2*)(orow + 8 * g + 4 * hh) = a;
    u32x2 bq; bq.x = pk2(st.o1[4 * g] * il, st.o1[4 * g + 1] * il); bq.y = pk2(st.o1[4 * g + 2] * il, st.o1[4 * g + 3] * il);
    *(u32x2*)(orow + 32 + 8 * g + 4 * hh) = bq;
  }
}

__device__ __forceinline__ void gqa_item(const Params& p, int item, char* lds) {
  const int tid = ltid(), lane = tid & 63, w = tid >> 6, r32 = lane & 31, hh = lane >> 5;
  const bf16_t* QB = (const bf16_t*)(p.ws + WS_QB);
  const bf16_t* KB = (const bf16_t*)(p.ws + WS_KB);
  const bf16_t* VT = (const bf16_t*)(p.ws + WS_VT);
  bf16_t* MIX = (bf16_t*)(p.ws + WS_MIX);
  int b, hkv, row0, ntile, t0; const int khalf = item & 1;
  { const int it2 = item >> 1;
    if (it2 < 512) { b = it2 >> 8; hkv = (it2 >> 7) & 1; row0 = b * SEQ + (it2 & 127) * 64; ntile = NKEY / 128; t0 = khalf * ntile; }
    else { const int it = it2 - 512; b = it >> 3; hkv = (it >> 2) & 1; row0 = MLAT + b * NCTX + (it & 3) * 64; ntile = NCTX / 128; t0 = khalf * ntile; } }
  const int qh = hkv * 4 + (w & 3);
  const int qrow = row0 + 32 * (w >> 2) + r32;
  const bf16_t* kb = KB + (size_t)(b * 2 + hkv) * NKEY * 64;
  const bf16_t* vt = VT + (size_t)(b * 2 + hkv) * 64 * NKEY;
  bf16x8 qf[4];
#pragma unroll
  for (int s = 0; s < 4; ++s) qf[s] = *(const bf16x8*)(QB + (size_t)qrow * 512 + qh * 64 + 16 * s + 8 * hh);
  AttnState st; st.o0 = (f32x16){}; st.o1 = (f32x16){}; st.m = 0.f; st.l = 0.f;
  float gq = fabsf(p.even_q_norm_g[lane]), gk = fabsf(p.even_k_norm_g[lane]);
  { gq = fmaxf(gq, dpp_xor1(gq)); gq = fmaxf(gq, dpp_xor2(gq)); gq = fmaxf(gq, dpp_xor4(gq)); gq = fmaxf(gq, dpp_xor8(gq)); gq = swap16_max(gq); gq = swap32_max(gq);
    gk = fmaxf(gk, dpp_xor1(gk)); gk = fmaxf(gk, dpp_xor2(gk)); gk = fmaxf(gk, dpp_xor4(gk)); gk = fmaxf(gk, dpp_xor8(gk)); gk = swap16_max(gk); gk = swap32_max(gk); }
  const float nsh = __builtin_amdgcn_readfirstlane(-(8.f * gq * gk * LOG2E * 1.02f));
  char* Kt = lds; char* Vt = lds + 24576;
  const int lrow = tid >> 3, lch = tid & 7;
  const int tend = t0 + ntile - 1;
  u32x4 rk0, rk1, rv0, rv1;
#define GQA_GK(R, T) do { int t_ = (T); t_ = t_ < tend ? t_ : tend; rk##R = *(const u32x4*)(kb + (size_t)t_ * 4096 + tid * 8); } while (0)
#define GQA_GV(R, T) do { int t_ = (T); t_ = t_ < tend ? t_ : tend; rv##R = *(const u32x4*)(vt + (size_t)lrow * NKEY + t_ * 64 + lch * 8); } while (0)
#define GQA_SK(R, SLOT) do { *(u32x4*)(Kt + (SLOT) * 8192 + lrow * 128 + ((lch ^ ((lrow >> 1) & 7)) << 4)) = rk##R; } while (0)
#define GQA_SV(R, SLOT) do { char* d_ = Vt + (SLOT) * 8704 + lrow * 136 + lch * 16; *(u32x2*)d_ = (u32x2){rv##R.x, rv##R.y}; *(u32x2*)(d_ + 8) = (u32x2){rv##R.z, rv##R.w}; } while (0)
  __syncthreads();
  GQA_GK(0, t0); GQA_GK(1, t0 + 1); GQA_GV(0, t0);
  GQA_SK(0, 0); GQA_SK(1, 1); GQA_SV(0, 0);
  GQA_GK(0, t0 + 2); GQA_GV(1, t0 + 1);
  __syncthreads();
  f32x16 sc0, sc1;
#pragma unroll
  for (int i = 0; i < 16; ++i) { sc0[i] = nsh; sc1[i] = nsh; }
  {
    const int sw = (r32 >> 1) & 7;
#pragma unroll
    for (int s2 = 0; s2 < 4; ++s2) {
      const int co = ((2 * s2 + hh) ^ sw) << 4;
      sc0 = __builtin_amdgcn_mfma_f32_32x32x16_bf16(*(const bf16x8*)(Kt + r32 * 128 + co), qf[s2], sc0, 0, 0, 0);
      sc1 = __builtin_amdgcn_mfma_f32_32x32x16_bf16(*(const bf16x8*)(Kt + (32 + r32) * 128 + co), qf[s2], sc1, 0, 0, 0);
    }
  }
  int k1 = 1, k2 = 2, k0 = 0;
  for (int t = 0; t < ntile; t += 2) {
    GQA_GK(1, t0 + t + 3); GQA_GV(0, t0 + t + 2);
    attn_tile_pipe(st, sc0, sc1, nsh, Kt + k1 * 8192, Vt + k0 * 8704, qf, r32, hh);
    GQA_SK(0, k2); GQA_SV(1, k1);
    __syncthreads();
    GQA_GK(0, t0 + t + 4); GQA_GV(1, t0 + t + 3);
    attn_tile_pipe(st, sc0, sc1, nsh, Kt + k2 * 8192, Vt + k1 * 8704, qf, r32, hh);
    GQA_SK(1, k0); GQA_SV(0, k2);
    __syncthreads();
    const int tk = k0; k0 = k2; k2 = k1; k1 = tk;
  }
#undef GQA_GK
#undef GQA_GV
#undef GQA_SK
#undef GQA_SV
  {
    const float l = swap32_sum(st.l, st.l);
    if (hh == 0) ((float*)(p.ws + WS_AFF))[((size_t)khalf * NR + qrow) * 8 + qh] = l;
    st.l = 0.5f;
    attn_store(st, khalf ? MIX + (size_t)qrow * DM + 512 + qh * 64 : (bf16_t*)(p.ws + WS_O1) + (size_t)qrow * 512 + qh * 64, hh);
  }
}

__device__ __forceinline__ void dn_out_task(const Params& p, int tsk, int lane, const f32x4 (&ong)[4]) {
  const int c = lane & 15, q = lane >> 4;
  bf16_t* MIX = (bf16_t*)(p.ws + WS_MIX);
  const bf16_t* PROJ = (const bf16_t*)(p.ws + WS_PROJ);
  const bf16_t* QN = (const bf16_t*)(p.ws + WS_QN);
  const bf16_t* WUA = (const bf16_t*)(p.ws + WS_WUA);
  const bf16_t* SC = (const bf16_t*)(p.ws + WS_A);
  const float* EGD = (const float*)(p.ws + WS_EGDEC);
    const int mtw = tsk & 3, h = (tsk >> 2) & 7, cid = tsk >> 5;
    const int roff = (16 * mtw + c) * 64 + 8 * q;
    const bf16_t* qn = QN + (size_t)(cid * 8 + h) * 4096;
    const bf16x8 q0 = *(const bf16x8*)(qn + roff), q1 = *(const bf16x8*)(qn + roff + 32);
    f32x4 oacc[4];
#pragma unroll
    for (int d = 0; d < 4; ++d) oacc[d] = (f32x4){0.f, 0.f, 0.f, 0.f};
#pragma unroll
    for (int dir = 0; dir < 2; ++dir) {
      const size_t cd = (size_t)((cid * 8 + h) * 2 + dir);
      const bf16_t* wua = WUA + cd * 3 * 4096; const bf16_t* sc = SC + cd * 4096;
      const float eg = EGD[cd * 128 + 16 * mtw + c];
      const bf16x8 a0 = *(const bf16x8*)(wua + 4096 + roff), a1 = *(const bf16x8*)(wua + 4096 + roff + 32);
#pragma unroll
      for (int d = 0; d < 4; ++d) {
        const int so = (16 * d + c) * 64 + 16 * q;
        const bf16x8 s0 = *(const bf16x8*)(sc + so), s1 = *(const bf16x8*)(sc + so + 8), v0 = *(const bf16x8*)(wua + 8192 + so), v1 = *(const bf16x8*)(wua + 8192 + so + 8);
        f32x4 t = (f32x4){0.f, 0.f, 0.f, 0.f};
        t = __builtin_amdgcn_mfma_f32_16x16x32_bf16(s0, q0, t, 0, 0, 0);
        t = __builtin_amdgcn_mfma_f32_16x16x32_bf16(s1, q1, t, 0, 0, 0);
        f32x4 o = oacc[d] + t * eg;
        o = __builtin_amdgcn_mfma_f32_16x16x32_bf16(v0, a0, o, 0, 0, 0);
        o = __builtin_amdgcn_mfma_f32_16x16x32_bf16(v1, a1, o, 0, 0, 0);
        oacc[d] = o;
      }
    }
    float ss = 0.f;
#pragma unroll
    for (int d = 0; d < 4; ++d) ss += oacc[d].x * oacc[d].x + oacc[d].y * oacc[d].y + oacc[d].z * oacc[d].z + oacc[d].w * oacc[d].w;
    ss = swap16_sum(ss, ss); ss = swap32_sum(ss, ss);
    const float rs = rsqrtf(ss * (1.f / 64.f) + EPS);
    const int row = cid * 64 + 16 * mtw + c;
#pragma unroll
    for (int d = 0; d < 4; ++d) {
      const int dv = 16 * d + 4 * q;
      const u32x2 z = *(const u32x2*)(PROJ + (size_t)row * PROJ_LD + 1536 + h * 64 + dv);
      const f32x4 o = oacc[d] * rs * ong[d];
      u32x2 ow; ow.x = pk2(o.x * silu_f(bflo(z.x)), o.y * silu_f(bfhi(z.x))); ow.y = pk2(o.z * silu_f(bflo(z.y)), o.w * silu_f(bfhi(z.y)));
      *(u32x2*)(MIX + (size_t)row * DM + h * 64 + dv) = ow;
    }
}
__device__ __forceinline__ void mix_even(const Params& p, char* lds) {
  unsigned* ctr = (unsigned*)(p.ws + WS_CTL);
  int* sh_item = (int*)(lds + 100000);
  if (blockIdx.x < 64) {
    if ((ltid() >> 6) < 2) {
      __builtin_amdgcn_s_setprio(3);
      scan_wave(p, blockIdx.x * 2 + (ltid() >> 6));
      __builtin_amdgcn_s_setprio(0);
      __builtin_amdgcn_fence(__ATOMIC_RELEASE, "agent");
      if ((ltid() & 63) == 0) __hip_atomic_fetch_add(ctr + 16, 1u, __ATOMIC_RELAXED, __HIP_MEMORY_SCOPE_AGENT);
    }
    else convert_experts(p, 0, lds, (bf16_t*)(p.ws + WS_WEXP), 0, 16 * 3 * 128, (int)blockIdx.x * 6 + (ltid() >> 6) - 2, 64 * 6);
  }
  for (;;) {
    __syncthreads();
    if (ltid() == 0) *sh_item = (int)atomicAdd(ctr, 1u);
    __syncthreads();
    const int item = *sh_item;
    if (item >= 2 * (512 + 16)) break;
    gqa_item(p, item, lds);
  }
  if (ltid() == 0) {
    unsigned sp = 0u;
    while (__hip_atomic_load(ctr + 16, __ATOMIC_RELAXED, __HIP_MEMORY_SCOPE_AGENT) < 128u) { __builtin_amdgcn_s_sleep(2); if (++sp > (1u << 24)) break; }
    __builtin_amdgcn_fence(__ATOMIC_ACQUIRE, "agent");
  }
  __syncthreads();
  {
    const int lane = ltid() & 63, wave = ltid() >> 6, q = lane >> 4;
    f32x4 ong[4];
#pragma unroll
    for (int d = 0; d < 4; ++d) ong[d] = *(const f32x4*)(p.even_out_norm_g + 16 * d + 4 * q);
    for (;;) {
      __syncthreads();
      if (ltid() == 0) *sh_item = (int)atomicAdd(ctr + 32, 1u);
      __syncthreads();
      const int it = *sh_item;
      if (it >= NCHUNK * 4) break;
      dn_out_task(p, it * 8 + wave, lane, ong);
    }
  }
}

__device__ __forceinline__ void gate_phase(const Params& p) {
  const int lane = ltid() & 63, wave = ltid() >> 6, c = lane & 15, q = lane >> 4;
  const int gw = blockIdx.x * NWV + wave, ngw = gridDim.x * NWV;
  bf16_t* MIX = (bf16_t*)(p.ws + WS_MIX);
  const bf16_t* PROJ = (const bf16_t*)(p.ws + WS_PROJ);
  const bf16_t* QN = (const bf16_t*)(p.ws + WS_QN);
  const bf16_t* WUA = (const bf16_t*)(p.ws + WS_WUA);
  const bf16_t* SC = (const bf16_t*)(p.ws + WS_A);
  const float* EGD = (const float*)(p.ws + WS_EGDEC);
  {
    const bf16_t* O1 = (const bf16_t*)(p.ws + WS_O1); const float* LP = (const float*)(p.ws + WS_AFF);
    const int hd = lane >> 3;
    for (int r0 = gw; r0 < NR; r0 += 4 * ngw) {
      float l0[4], l1[4]; u32x4 a[4], b2[4];
#pragma unroll
      for (int u = 0; u < 4; ++u) {
        const int r = (r0 + u * ngw < NR) ? r0 + u * ngw : r0;
        l0[u] = LP[(size_t)r * 8 + hd]; l1[u] = LP[((size_t)NR + r) * 8 + hd];
        a[u] = *(const u32x4*)(O1 + (size_t)r * 512 + lane * 8); b2[u] = *(const u32x4*)(MIX + (size_t)r * DM + 512 + lane * 8);
      }
#pragma unroll
      for (int u = 0; u < 4; ++u) {
        const int r = r0 + u * ngw;
        if (r < NR) {
          const float il = 1.f / (l0[u] + l1[u]);
          u32x4 o; o.x = pk2((bflo(a[u].x) + bflo(b2[u].x)) * il, (bfhi(a[u].x) + bfhi(b2[u].x)) * il); o.y = pk2((bflo(a[u].y) + bflo(b2[u].y)) * il, (bfhi(a[u].y) + bfhi(b2[u].y)) * il);
          o.z = pk2((bflo(a[u].z) + bflo(b2[u].z)) * il, (bfhi(a[u].z) + bfhi(b2[u].z)) * il); o.w = pk2((bflo(a[u].w) + bflo(b2[u].w)) * il, (bfhi(a[u].w) + bfhi(b2[u].w)) * il);
          *(u32x4*)(MIX + (size_t)r * DM + 512 + lane * 8) = o;
        }
      }
    }
  }
}

__device__ __forceinline__ void na_item(const Params& p, int item, char* lds_all) {
  const int tid = ltid(), half = tid >> 8, lt = tid & 255, lane = lt & 63, w = lt >> 6, r32 = lane & 31, hh = lane >> 5;
  char* lds = lds_all + half * 53248;
  const bf16_t* PROJ = (const bf16_t*)(p.ws + WS_PROJ);
  bf16_t* MIX = (bf16_t*)(p.ws + WS_MIX);
  const int head = 2 * (item & 7) + half, rp = (item >> 3) & 63, b = item >> 9;
  const int QR = 2 * rp + (w >> 1), colh = w & 1;
  const int qc = 32 * colh + r32;
  const int qrow = b * SEQ + QR * 64 + qc;
  int rs_w = QR - 4; rs_w = rs_w < 0 ? 0 : (rs_w > 120 ? 120 : rs_w);
  int rlo = 2 * rp - 4; rlo = rlo < 0 ? 0 : (rlo > 120 ? 120 : rlo);
  int rhi = 2 * rp + 1 - 4; rhi = rhi < 0 ? 0 : (rhi > 120 ? 120 : rhi); rhi += 7;
  const int ntile = 4 + (rhi - rlo + 1);
  char* Kt = lds; char* Vt = lds + 24576; float* bias = (float*)(lds + 24576 + 3 * 8704);
  __syncthreads();
  for (int i = lt; i < 15 * 32; i += 256) { const int br = i >> 5, bc = i & 31; bias[i] = (bc < 31) ? p.odd_rpb[(size_t)head * 465 + br * 31 + bc] * LOG2E : -1e30f; }
  bf16x8 qf[4];
#pragma unroll
  for (int s = 0; s < 4; ++s) qf[s] = *(const bf16x8*)(PROJ + (size_t)qrow * PROJ_LD + head * 64 + 16 * s + 8 * hh);
  AttnState st; st.o0 = (f32x16){}; st.o1 = (f32x16){}; st.m = -1e30f; st.l = 0.f;
  const int lrow0 = lt >> 3, lch = lt & 7;
  auto tile_row0 = [&](int t) -> int { t = t < ntile ? t : ntile - 1; return t < 4 ? MLAT + b * NCTX + t * 64 : b * SEQ + (rlo + t - 4) * 64; };
  u32x4 rk0[2], rv0[2], rk1[2], rv1[2];
  const int vkp = lt & 31, vch = lt >> 5;
#define NA_GLOAD(R, T) do { const int r0_ = tile_row0(T); _Pragma("unroll") for (int i = 0; i < 2; ++i) { \
      rk##R[i] = *(const u32x4*)(PROJ + (size_t)(r0_ + lrow0 + 32 * i) * PROJ_LD + 1024 + head * 64 + lch * 8); \
      rv##R[i] = *(const u32x4*)(PROJ + (size_t)(r0_ + 2 * vkp + i) * PROJ_LD + 2048 + head * 64 + vch * 8); } } while (0)
#define NA_LSTORE(R, BUF) do { _Pragma("unroll") for (int i = 0; i < 2; ++i) { const int row_ = lrow0 + 32 * i; \
      *(u32x4*)(Kt + (BUF) * 8192 + row_ * 128 + ((lch ^ ((row_ >> 1) & 7)) << 4)) = rk##R[i]; } \
    { unsigned* vb_ = (unsigned*)(Vt + (BUF) * 8704) + vkp; const unsigned va_[4] = {rv##R[0].x, rv##R[0].y, rv##R[0].z, rv##R[0].w}, vc_[4] = {rv##R[1].x, rv##R[1].y, rv##R[1].z, rv##R[1].w}; \
      _Pragma("unroll") for (int q2 = 0; q2 < 4; ++q2) { vb_[(vch * 8 + 2 * q2) * 34] = (va_[q2] & 0xffffu) | (vc_[q2] << 16); vb_[(vch * 8 + 2 * q2 + 1) * 34] = (va_[q2] >> 16) | (vc_[q2] & 0xffff0000u); } } } while (0)
  NA_GLOAD(0, 0); NA_GLOAD(1, 1);
  NA_LSTORE(0, 0);
  __syncthreads();
  const float sc = 0.125f * LOG2E;
  int cs = qc - 8; cs = cs < 0 ? 0 : (cs > 48 ? 48 : cs);
#define NA_STEP(T, CUR) do { const int t_ = (T); const int KR = rlo + t_ - 4; \
    const bool active = (t_ < 4) || (KR >= rs_w && KR < rs_w + 8); \
    if (active) { f32x16 s0 = (f32x16){}, s1 = (f32x16){}; \
      attn_scores(Kt + (CUR) * 8192, qf, r32, hh, s0, s1); \
      if (t_ < 4) { _Pragma("unroll") for (int i = 0; i < 16; ++i) { s0[i] *= sc; s1[i] *= sc; } } \
      else { const float* brow = bias + (KR - QR + 7) * 32; _Pragma("unroll") for (int i = 0; i < 16; ++i) { const int kc0 = (i & 3) + 8 * (i >> 2) + 4 * hh, kc1 = kc0 + 32; \
          s0[i] = s0[i] * sc + brow[(kc0 >= cs && kc0 < cs + 16) ? kc0 - qc + 15 : 31]; s1[i] = s1[i] * sc + brow[(kc1 >= cs && kc1 < cs + 16) ? kc1 - qc + 15 : 31]; } } \
      attn_update(st, s0, s1, Vt + (CUR) * 8704, r32, hh); } } while (0)
  int b0 = 0, b1 = 1, b2 = 2;
  for (int t = 0; t < ntile; t += 2) {
    NA_GLOAD(0, t + 2);
    NA_STEP(t, b0);
    NA_LSTORE(1, b1);
    __syncthreads();
    if (t + 1 >= ntile) break;
    NA_GLOAD(1, t + 3);
    NA_STEP(t + 1, b1);
    NA_LSTORE(0, b2);
    __syncthreads();
    const int tb = b0; b0 = b2; b2 = b1; b1 = tb;
  }
#undef NA_GLOAD
#undef NA_LSTORE
#undef NA_STEP
  attn_store(st, MIX + (size_t)qrow * DM + head * 64, hh);
}
__device__ __forceinline__ void mix_odd(const Params& p, char* lds) {
  for (int item = blockIdx.x; item < 1024; item += gridDim.x) na_item(p, item, lds);
}

#define XB_TMO      128
#define XB_XCNT(j)  (256  + 64 * (j))
#define XB_XSUB(j)  (1280 + 64 * (j))
#define XB_XGEN(j)  (2304 + 64 * (j))
#define XB_TOP      3328
#define XB_TOPGEN   3392
#define XCD_BAR_WORDS 3456
#define XB_SPIN_CAP (1u << 22)
#define LAS __attribute__((address_space(3)))
__device__ __forceinline__ unsigned xb_ld(unsigned* p)              { return __hip_atomic_load(p, __ATOMIC_RELAXED, __HIP_MEMORY_SCOPE_AGENT); }
__device__ __forceinline__ unsigned xb_add(unsigned* p, unsigned v) { return __hip_atomic_fetch_add(p, v, __ATOMIC_RELAXED, __HIP_MEMORY_SCOPE_AGENT); }
__device__ __forceinline__ unsigned xb_xcc_id() { return (unsigned)__builtin_amdgcn_s_getreg((3 << 11) | 20) & 0xFu; }
#define XB_SPIN(cond, bar) do { unsigned _sp = 0; while (cond) { __builtin_amdgcn_s_sleep(1); \
    if ((++_sp & 255u) == 0u) { if (xb_ld(&(bar)[XB_TMO])) break; if (_sp > XB_SPIN_CAP) { atomicAdd(&(bar)[XB_TMO], 1u); break; } } } } while (0)
struct XcdBarrier { unsigned* bar; unsigned x; volatile LAS unsigned* st; };
__device__ __forceinline__ XcdBarrier xcd_barrier_post(unsigned* bar, volatile LAS unsigned* st) {
    XcdBarrier b; b.bar = bar; b.x = xb_xcc_id(); b.st = st;
    if (threadIdx.x == 0) (void)xb_add(&bar[XB_XCNT(b.x)], 1u);
    return b;
}
__device__ __forceinline__ void xcd_barrier_complete(unsigned* bar, unsigned x, unsigned& nloc, unsigned& nx) {
    const unsigned G = gridDim.x * gridDim.y * gridDim.z;
    unsigned sum, cnt, mine, sp = 0u;
    for (;;) {
        sum = 0u; cnt = 0u; mine = 0u;
#pragma unroll
        for (unsigned j = 0; j < 16; ++j) { const unsigned c = xb_ld(&bar[XB_XCNT(j)]); sum += c; cnt += (c > 0u) ? 1u : 0u; mine = (j == x) ? c : mine; }
        if (sum == G) break;
        __builtin_amdgcn_s_sleep(1);
        if ((++sp & 255u) == 0u) { if (xb_ld(&bar[XB_TMO])) break; if (sp > XB_SPIN_CAP) { atomicAdd(&bar[XB_TMO], 1u); break; } }
    }
    nloc = mine > 0u ? mine : 1u; nx = cnt > 0u ? cnt : 1u;
}
__device__ __forceinline__ void xcd_barrier(const XcdBarrier& b) {
    asm volatile("s_waitcnt vmcnt(0)" ::: "memory");
    __syncthreads();
    if (threadIdx.x == 0) {
        unsigned* bar = b.bar;
        __builtin_amdgcn_s_waitcnt(0);
        unsigned nloc = b.st[0], nx = b.st[1];
        if (nloc == 0u) { xcd_barrier_complete(bar, b.x, nloc, nx); b.st[0] = nloc; b.st[1] = nx; }
        const unsigned old = xb_add(&bar[XB_XSUB(b.x)], 1u);
        const unsigned gen = old / nloc;
        if (old + 1u == (gen + 1u) * nloc) {
            __builtin_amdgcn_fence(__ATOMIC_RELEASE, "agent");
            asm volatile("s_waitcnt vmcnt(0)" ::: "memory");
            (void)xb_add(&bar[XB_TOP], 1u);
        }
        XB_SPIN(xb_ld(&bar[XB_TOP]) < (gen + 1u) * nx, bar);
        __builtin_amdgcn_fence(__ATOMIC_ACQUIRE, "agent");
        asm volatile("s_waitcnt vmcnt(0)" ::: "memory");
    }
    __syncthreads();
}
#define GSYNC() xcd_barrier(xbar)

constexpr int PT_OFF = LDS_BYTES - 16 - 256;
template <class T> __device__ __forceinline__ T* ldptr(const char* lds, int i) {
  const volatile unsigned* q = (const volatile unsigned*)(lds + PT_OFF + 8 * i);
  const unsigned lo = __builtin_amdgcn_readfirstlane(q[0]), hi = __builtin_amdgcn_readfirstlane(q[1]);
  typedef __attribute__((address_space(1))) T* gptr_t;
  return (T*)(gptr_t)(((unsigned long long)hi << 32) | (unsigned long long)lo);
}
__device__ __forceinline__ Params fresh(const char* lds) {
  Params p;
  p.x = ldptr<const float>(lds, 0); p.c = ldptr<const float>(lds, 1); p.ctx = ldptr<const float>(lds, 2); p.c_ctx = ldptr<const float>(lds, 3); p.ada_w = ldptr<const float>(lds, 4); p.ada_b = ldptr<const float>(lds, 5);
  p.ln1_g = ldptr<const float>(lds, 6); p.ln2_g = ldptr<const float>(lds, 7); p.even_w_in = ldptr<const float>(lds, 8); p.even_conv_w = ldptr<const float>(lds, 9); p.even_a_log = ldptr<const float>(lds, 10);
  p.even_dt_bias = ldptr<const float>(lds, 11); p.even_out_norm_g = ldptr<const float>(lds, 12); p.even_q_norm_g = ldptr<const float>(lds, 13); p.even_k_norm_g = ldptr<const float>(lds, 14);
  p.even_w_out = ldptr<const float>(lds, 15); p.odd_w_in = ldptr<const float>(lds, 16); p.odd_rpb = ldptr<const float>(lds, 17); p.odd_w_out = ldptr<const float>(lds, 18); p.router_w = ldptr<const float>(lds, 19);
  p.w_gate = ldptr<const float>(lds, 20); p.w_up = ldptr<const float>(lds, 21); p.w_down = ldptr<const float>(lds, 22); p.final_g = ldptr<const float>(lds, 23);
  p.out = ldptr<float>(lds, 24); p.ws = ldptr<unsigned char>(lds, 25);
  return p;
}
__global__ void __launch_bounds__(NT, 2) fwd_megakernel(Params p0) {
  cg::grid_group grid = cg::this_grid();
  extern __shared__ __attribute__((aligned(16))) char lds[];
  volatile LAS unsigned* xb_st = (volatile LAS unsigned*)(lds + LDS_BYTES - 16);
  if (threadIdx.x < 4) xb_st[threadIdx.x] = 0u;
  if (threadIdx.x == 0) {
    unsigned long long* tab = (unsigned long long*)(lds + PT_OFF);
    tab[0] = (unsigned long long)p0.x; tab[1] = (unsigned long long)p0.c; tab[2] = (unsigned long long)p0.ctx; tab[3] = (unsigned long long)p0.c_ctx; tab[4] = (unsigned long long)p0.ada_w; tab[5] = (unsigned long long)p0.ada_b;
    tab[6] = (unsigned long long)p0.ln1_g; tab[7] = (unsigned long long)p0.ln2_g; tab[8] = (unsigned long long)p0.even_w_in; tab[9] = (unsigned long long)p0.even_conv_w; tab[10] = (unsigned long long)p0.even_a_log;
    tab[11] = (unsigned long long)p0.even_dt_bias; tab[12] = (unsigned long long)p0.even_out_norm_g; tab[13] = (unsigned long long)p0.even_q_norm_g; tab[14] = (unsigned long long)p0.even_k_norm_g;
    tab[15] = (unsigned long long)p0.even_w_out; tab[16] = (unsigned long long)p0.odd_w_in; tab[17] = (unsigned long long)p0.odd_rpb; tab[18] = (unsigned long long)p0.odd_w_out; tab[19] = (unsigned long long)p0.router_w;
    tab[20] = (unsigned long long)p0.w_gate; tab[21] = (unsigned long long)p0.w_up; tab[22] = (unsigned long long)p0.w_down; tab[23] = (unsigned long long)p0.final_g;
    tab[24] = (unsigned long long)p0.out; tab[25] = (unsigned long long)p0.ws;
  }
  __syncthreads();
  XcdBarrier xbar = xcd_barrier_post((unsigned*)(ldptr<unsigned char>(lds, 25) + WS_CTL + 16384), xb_st);
  grid.sync();

  { const Params p = fresh(lds); const bf16_t* A = (const bf16_t*)(p.ws + WS_A); const float* MOD = (const float*)(p.ws + WS_MOD); const bf16_t* WEXP = (const bf16_t*)(p.ws + WS_WEXP); bf16_t* PROJ = (bf16_t*)(p.ws + WS_PROJ); const bf16_t* MIX = (const bf16_t*)(p.ws + WS_MIX); (void)A; (void)MOD; (void)WEXP; (void)PROJ; (void)MIX; phase0(p, lds); }
  GSYNC();
  { const Params p = fresh(lds); const bf16_t* A = (const bf16_t*)(p.ws + WS_A); const float* MOD = (const float*)(p.ws + WS_MOD); const bf16_t* WEXP = (const bf16_t*)(p.ws + WS_WEXP); bf16_t* PROJ = (bf16_t*)(p.ws + WS_PROJ); const bf16_t* MIX = (const bf16_t*)(p.ws + WS_MIX); (void)A; (void)MOD; (void)WEXP; (void)PROJ; (void)MIX; rowpass_a<0, false>(p, lds); }
  GSYNC();
  { const Params p = fresh(lds); const bf16_t* A = (const bf16_t*)(p.ws + WS_A); const float* MOD = (const float*)(p.ws + WS_MOD); const bf16_t* WEXP = (const bf16_t*)(p.ws + WS_WEXP); bf16_t* PROJ = (bf16_t*)(p.ws + WS_PROJ); const bf16_t* MIX = (const bf16_t*)(p.ws + WS_MIX); (void)A; (void)MOD; (void)WEXP; (void)PROJ; (void)MIX;  EpiStoreBf16 E{PROJ, PROJ_LD, nullptr}; big_gemm(lds, A, (const bf16_t*)(p.ws + WS_WEI), MLAT, 3072, 0, 0, E);  }
  { const Params p = fresh(lds); const bf16_t* A = (const bf16_t*)(p.ws + WS_A); const float* MOD = (const float*)(p.ws + WS_MOD); const bf16_t* WEXP = (const bf16_t*)(p.ws + WS_WEXP); bf16_t* PROJ = (bf16_t*)(p.ws + WS_PROJ); const bf16_t* MIX = (const bf16_t*)(p.ws + WS_MIX); (void)A; (void)MOD; (void)WEXP; (void)PROJ; (void)MIX;  OpInProjCtx<0> op{A, (const bf16_t*)(p.ws + WS_WEI), PROJ, 4 * 23}; gemm_small_phase(op, lds);  }
  GSYNC();
  { const Params p = fresh(lds); const bf16_t* A = (const bf16_t*)(p.ws + WS_A); const float* MOD = (const float*)(p.ws + WS_MOD); const bf16_t* WEXP = (const bf16_t*)(p.ws + WS_WEXP); bf16_t* PROJ = (bf16_t*)(p.ws + WS_PROJ); const bf16_t* MIX = (const bf16_t*)(p.ws + WS_MIX); (void)A; (void)MOD; (void)WEXP; (void)PROJ; (void)MIX; prep_even(p, lds); }
  GSYNC();
  { const Params p = fresh(lds); const bf16_t* A = (const bf16_t*)(p.ws + WS_A); const float* MOD = (const float*)(p.ws + WS_MOD); const bf16_t* WEXP = (const bf16_t*)(p.ws + WS_WEXP); bf16_t* PROJ = (bf16_t*)(p.ws + WS_PROJ); const bf16_t* MIX = (const bf16_t*)(p.ws + WS_MIX); (void)A; (void)MOD; (void)WEXP; (void)PROJ; (void)MIX; mix_even(p, lds); }
  GSYNC();
  { const Params p = fresh(lds); const bf16_t* A = (const bf16_t*)(p.ws + WS_A); const float* MOD = (const float*)(p.ws + WS_MOD); const bf16_t* WEXP = (const bf16_t*)(p.ws + WS_WEXP); bf16_t* PROJ = (bf16_t*)(p.ws + WS_PROJ); const bf16_t* MIX = (const bf16_t*)(p.ws + WS_MIX); (void)A; (void)MOD; (void)WEXP; (void)PROJ; (void)MIX; gate_phase(p); }
  GSYNC();
  { const Params p = fresh(lds); const bf16_t* A = (const bf16_t*)(p.ws + WS_A); const float* MOD = (const float*)(p.ws + WS_MOD); const bf16_t* WEXP = (const bf16_t*)(p.ws + WS_WEXP); bf16_t* PROJ = (bf16_t*)(p.ws + WS_PROJ); const bf16_t* MIX = (const bf16_t*)(p.ws + WS_MIX); (void)A; (void)MOD; (void)WEXP; (void)PROJ; (void)MIX;  EpiResid E{p.x, p.out, MOD + 2 * 1024}; big_gemm(lds, MIX, (const bf16_t*)(p.ws + WS_WEO), MLAT, 1024, 0, 0, E);  }
  { const Params p = fresh(lds); const bf16_t* A = (const bf16_t*)(p.ws + WS_A); const float* MOD = (const float*)(p.ws + WS_MOD); const bf16_t* WEXP = (const bf16_t*)(p.ws + WS_WEXP); bf16_t* PROJ = (bf16_t*)(p.ws + WS_PROJ); const bf16_t* MIX = (const bf16_t*)(p.ws + WS_MIX); (void)A; (void)MOD; (void)WEXP; (void)PROJ; (void)MIX;  OpOutProjCtx op{MIX, (const bf16_t*)(p.ws + WS_WEO), MOD + 2 * 6144 + 2 * 1024, (float*)(p.ws + WS_HC), 4 * 8}; gemm_small_phase(op, lds);  }
  GSYNC();
  { const Params p = fresh(lds); const bf16_t* A = (const bf16_t*)(p.ws + WS_A); const float* MOD = (const float*)(p.ws + WS_MOD); const bf16_t* WEXP = (const bf16_t*)(p.ws + WS_WEXP); bf16_t* PROJ = (bf16_t*)(p.ws + WS_PROJ); const bf16_t* MIX = (const bf16_t*)(p.ws + WS_MIX); (void)A; (void)MOD; (void)WEXP; (void)PROJ; (void)MIX; rowpass_b<0>(p, lds); }
  GSYNC();
  { const Params p = fresh(lds); const bf16_t* A = (const bf16_t*)(p.ws + WS_A); const float* MOD = (const float*)(p.ws + WS_MOD); const bf16_t* WEXP = (const bf16_t*)(p.ws + WS_WEXP); bf16_t* PROJ = (bf16_t*)(p.ws + WS_PROJ); const bf16_t* MIX = (const bf16_t*)(p.ws + WS_MIX); (void)A; (void)MOD; (void)WEXP; (void)PROJ; (void)MIX; topk_phase<0>(p, lds); if (blockIdx.x >= 64) convert_experts(p, 1, lds, (bf16_t*)(p.ws + WS_WEXP1), 0, 3072, ((int)blockIdx.x - 64) * NWV + (ltid() >> 6), ((int)gridDim.x - 64) * NWV); }
  GSYNC();
  { const Params p = fresh(lds); const bf16_t* A = (const bf16_t*)(p.ws + WS_A); const float* MOD = (const float*)(p.ws + WS_MOD); const bf16_t* WEXP = (const bf16_t*)(p.ws + WS_WEXP); bf16_t* PROJ = (bf16_t*)(p.ws + WS_PROJ); const bf16_t* MIX = (const bf16_t*)(p.ws + WS_MIX); (void)A; (void)MOD; (void)WEXP; (void)PROJ; (void)MIX;  EpiMoe1 E{(bf16_t*)(p.ws + WS_HIDL)}; big_gemm_gather(lds, A, (const int*)(p.ws + WS_IDX), WEXP, 16 * 2048, 2048, 8, EXPW * 2, E);  }
  { const Params p = fresh(lds); const bf16_t* A = (const bf16_t*)(p.ws + WS_A); const float* MOD = (const float*)(p.ws + WS_MOD); const bf16_t* WEXP = (const bf16_t*)(p.ws + WS_WEXP); bf16_t* PROJ = (bf16_t*)(p.ws + WS_PROJ); const bf16_t* MIX = (const bf16_t*)(p.ws + WS_MIX); (void)A; (void)MOD; (void)WEXP; (void)PROJ; (void)MIX;  OpMoe1Ctx op{A, WEXP, (const int*)(p.ws + WS_IDX), (bf16_t*)(p.ws + WS_HIDC), 16 * 16}; gemm_small_phase(op, lds);  }
  GSYNC();
  { const Params p = fresh(lds); const bf16_t* A = (const bf16_t*)(p.ws + WS_A); const float* MOD = (const float*)(p.ws + WS_MOD); const bf16_t* WEXP = (const bf16_t*)(p.ws + WS_WEXP); bf16_t* PROJ = (bf16_t*)(p.ws + WS_PROJ); const bf16_t* MIX = (const bf16_t*)(p.ws + WS_MIX); (void)A; (void)MOD; (void)WEXP; (void)PROJ; (void)MIX;  EpiStoreBf16 E{(bf16_t*)(p.ws + WS_YL), DM, (const float*)(p.ws + WS_GATEV)}; big_gemm(lds, (const bf16_t*)(p.ws + WS_HIDL), WEXP + (size_t)2048 * DM, 16 * 2048, 1024, 8, EXPW * 2, E);  }
  { const Params p = fresh(lds); const bf16_t* A = (const bf16_t*)(p.ws + WS_A); const float* MOD = (const float*)(p.ws + WS_MOD); const bf16_t* WEXP = (const bf16_t*)(p.ws + WS_WEXP); bf16_t* PROJ = (bf16_t*)(p.ws + WS_PROJ); const bf16_t* MIX = (const bf16_t*)(p.ws + WS_MIX); (void)A; (void)MOD; (void)WEXP; (void)PROJ; (void)MIX;  OpMoe2Ctx op{(const bf16_t*)(p.ws + WS_HIDC), WEXP, (const float*)(p.ws + WS_GATEV), (bf16_t*)(p.ws + WS_YC), 16 * 8}; gemm_small_phase(op, lds);  }
  GSYNC();
  { const Params p = fresh(lds); const bf16_t* A = (const bf16_t*)(p.ws + WS_A); const float* MOD = (const float*)(p.ws + WS_MOD); const bf16_t* WEXP = (const bf16_t*)(p.ws + WS_WEXP1); bf16_t* PROJ = (bf16_t*)(p.ws + WS_PROJ); const bf16_t* MIX = (const bf16_t*)(p.ws + WS_MIX); (void)A; (void)MOD; (void)WEXP; (void)PROJ; (void)MIX; rowpass_a<1, false>(p, lds); }
  GSYNC();
  { const Params p = fresh(lds); const bf16_t* A = (const bf16_t*)(p.ws + WS_A); const float* MOD = (const float*)(p.ws + WS_MOD); const bf16_t* WEXP = (const bf16_t*)(p.ws + WS_WEXP1); bf16_t* PROJ = (bf16_t*)(p.ws + WS_PROJ); const bf16_t* MIX = (const bf16_t*)(p.ws + WS_MIX); (void)A; (void)MOD; (void)WEXP; (void)PROJ; (void)MIX;  EpiStoreBf16 E{PROJ, PROJ_LD, nullptr}; big_gemm(lds, A, (const bf16_t*)(p.ws + WS_WOI), MLAT, 3072, 0, 0, E);  }
  { const Params p = fresh(lds); const bf16_t* A = (const bf16_t*)(p.ws + WS_A); const float* MOD = (const float*)(p.ws + WS_MOD); const bf16_t* WEXP = (const bf16_t*)(p.ws + WS_WEXP1); bf16_t* PROJ = (bf16_t*)(p.ws + WS_PROJ); const bf16_t* MIX = (const bf16_t*)(p.ws + WS_MIX); (void)A; (void)MOD; (void)WEXP; (void)PROJ; (void)MIX;  OpInProjCtx<1> op{A, (const bf16_t*)(p.ws + WS_WOI), PROJ, 4 * 16}; gemm_small_phase(op, lds);  }
  GSYNC();
  { const Params p = fresh(lds); const bf16_t* A = (const bf16_t*)(p.ws + WS_A); const float* MOD = (const float*)(p.ws + WS_MOD); const bf16_t* WEXP = (const bf16_t*)(p.ws + WS_WEXP1); bf16_t* PROJ = (bf16_t*)(p.ws + WS_PROJ); const bf16_t* MIX = (const bf16_t*)(p.ws + WS_MIX); (void)A; (void)MOD; (void)WEXP; (void)PROJ; (void)MIX; mix_odd(p, lds); }
  GSYNC();
  { const Params p = fresh(lds); const bf16_t* A = (const bf16_t*)(p.ws + WS_A); const float* MOD = (const float*)(p.ws + WS_MOD); const bf16_t* WEXP = (const bf16_t*)(p.ws + WS_WEXP1); bf16_t* PROJ = (bf16_t*)(p.ws + WS_PROJ); const bf16_t* MIX = (const bf16_t*)(p.ws + WS_MIX); (void)A; (void)MOD; (void)WEXP; (void)PROJ; (void)MIX;  EpiResid E{p.out, p.out, MOD + 3 * 6144 + 2 * 1024}; big_gemm(lds, MIX, (const bf16_t*)(p.ws + WS_WOO), MLAT, 1024, 0, 0, E);  }
  GSYNC();
  { const Params p = fresh(lds); const bf16_t* A = (const bf16_t*)(p.ws + WS_A); const float* MOD = (const float*)(p.ws + WS_MOD); const bf16_t* WEXP = (const bf16_t*)(p.ws + WS_WEXP1); bf16_t* PROJ = (bf16_t*)(p.ws + WS_PROJ); const bf16_t* MIX = (const bf16_t*)(p.ws + WS_MIX); (void)A; (void)MOD; (void)WEXP; (void)PROJ; (void)MIX; rowpass_b<1>(p, lds); }
  GSYNC();
  { const Params p = fresh(lds); const bf16_t* A = (const bf16_t*)(p.ws + WS_A); const float* MOD = (const float*)(p.ws + WS_MOD); const bf16_t* WEXP = (const bf16_t*)(p.ws + WS_WEXP1); bf16_t* PROJ = (bf16_t*)(p.ws + WS_PROJ); const bf16_t* MIX = (const bf16_t*)(p.ws + WS_MIX); (void)A; (void)MOD; (void)WEXP; (void)PROJ; (void)MIX; topk_phase<1>(p, lds); if (blockIdx.x >= 32) convert_experts(p, 1, lds, (bf16_t*)(p.ws + WS_WEXP1), 3072, 6144, ((int)blockIdx.x - 32) * NWV + (ltid() >> 6), ((int)gridDim.x - 32) * NWV); }
  GSYNC();
  { const Params p = fresh(lds); const bf16_t* A = (const bf16_t*)(p.ws + WS_A); const float* MOD = (const float*)(p.ws + WS_MOD); const bf16_t* WEXP = (const bf16_t*)(p.ws + WS_WEXP1); bf16_t* PROJ = (bf16_t*)(p.ws + WS_PROJ); const bf16_t* MIX = (const bf16_t*)(p.ws + WS_MIX); (void)A; (void)MOD; (void)WEXP; (void)PROJ; (void)MIX;  EpiMoe1 E{(bf16_t*)(p.ws + WS_HIDL)}; big_gemm_gather(lds, A, (const int*)(p.ws + WS_IDX), WEXP, 16 * 2048, 2048, 8, EXPW * 2, E);  }
  GSYNC();
  { const Params p = fresh(lds); const bf16_t* A = (const bf16_t*)(p.ws + WS_A); const float* MOD = (const float*)(p.ws + WS_MOD); const bf16_t* WEXP = (const bf16_t*)(p.ws + WS_WEXP1); bf16_t* PROJ = (bf16_t*)(p.ws + WS_PROJ); const bf16_t* MIX = (const bf16_t*)(p.ws + WS_MIX); (void)A; (void)MOD; (void)WEXP; (void)PROJ; (void)MIX;  EpiStoreBf16 E{(bf16_t*)(p.ws + WS_YL), DM, (const float*)(p.ws + WS_GATEV)}; big_gemm(lds, (const bf16_t*)(p.ws + WS_HIDL), WEXP + (size_t)2048 * DM, 16 * 2048, 1024, 8, EXPW * 2, E);  }
  GSYNC();
  { const Params p = fresh(lds); const bf16_t* A = (const bf16_t*)(p.ws + WS_A); const float* MOD = (const float*)(p.ws + WS_MOD); const bf16_t* WEXP = (const bf16_t*)(p.ws + WS_WEXP1); bf16_t* PROJ = (bf16_t*)(p.ws + WS_PROJ); const bf16_t* MIX = (const bf16_t*)(p.ws + WS_MIX); (void)A; (void)MOD; (void)WEXP; (void)PROJ; (void)MIX; rowpass_a<1, true>(p, lds); }
}

extern "C" void kernel_launch(void* const* d_in, const int* in_sizes, int n_in, void* d_out, int out_size,
                              void* d_ws, size_t ws_size, hipStream_t stream) {
  static int grid_blocks = 0;
  if (!grid_blocks) {
    int dev = 0, cus = 0, per_cu = 0;
    (void)hipGetDevice(&dev);
    (void)hipDeviceGetAttribute(&cus, hipDeviceAttributeMultiprocessorCount, dev);
    (void)hipFuncSetAttribute((const void*)fwd_megakernel, hipFuncAttributeMaxDynamicSharedMemorySize, LDS_BYTES);
    (void)hipOccupancyMaxActiveBlocksPerMultiprocessor(&per_cu, fwd_megakernel, NT, LDS_BYTES);
    if (per_cu > 1) per_cu = 1;
    grid_blocks = cus * per_cu;
    if (ws_size < WS_END || n_in != 24 || per_cu < 1 || (grid_blocks & 7)) { fprintf(stderr, "kernel_launch: unexpected setup (ws %zu need %zu, n_in %d, per_cu %d, grid %d)\n", ws_size, (size_t)WS_END, n_in, per_cu, grid_blocks); grid_blocks = -1; }
  }
  if (grid_blocks < 0) return;
  Params p{};
  const float** pp = (const float**)&p;
  for (int i = 0; i < 24; ++i) pp[i] = (const float*)d_in[i];
  p.out = (float*)d_out; p.ws = (unsigned char*)d_ws;
  void* args[] = {&p};
  (void)hipMemsetAsync((char*)d_ws + WS_CTL + 16384, 0, XCD_BAR_WORDS * 4, stream);
  hipError_t e = hipLaunchCooperativeKernel((void*)fwd_megakernel, dim3(grid_blocks), dim3(NT), args, LDS_BYTES, stream);
  if (e != hipSuccess) fprintf(stderr, "cooperative launch failed: %s (grid %d)\n", hipGetErrorString(e), grid_blocks);
}
```
